# Optimizing an MI355X kernel written in HIP

```python
import jax, jax.numpy as jnp
from jax import lax
import numpy as np

D_MODEL = 1024
BATCH = 8
SEQ = 2048
DEPTH = 4

MEM_LEN = 256
N_MIXERS = 2
MIX_WIDTH = 3 * D_MODEL // 2
XA_HEADS = 4
XA_HEAD_DIM = D_MODEL // 8
XA_WIDTH = XA_HEADS * XA_HEAD_DIM
IN_WIDTH = 2 * MIX_WIDTH + XA_WIDTH
OUT_WIDTH = MIX_WIDTH + XA_WIDTH
CONV_WIDTH = 4
LRU_BLOCKS = 8
LRU_BS = MIX_WIDTH // LRU_BLOCKS
LRU_C = 8.0
ML_HEADS = 4
ML_HEAD_DIM = MIX_WIDTH // ML_HEADS
ML_QKV_BS = 4
ML_QKV_BLOCKS = MIX_WIDTH // ML_QKV_BS
ML_CHUNK = 64
D_FF = ((8 * D_MODEL // 3 + 127) // 128) * 128
N_A = (DEPTH + 1) // 2
N_B = DEPTH // 2
EPS = 1e-6

kernel_name = 'hybrid_rglru_mlstm_memxattn_macaron'

F32 = jnp.float32


def _rmsnorm(x, g):
    xf = x.astype(F32)
    y = xf * lax.rsqrt(jnp.mean(xf * xf, axis=-1, keepdims=True) + EPS)
    return (y * g.astype(F32)).astype(x.dtype)


def _swiglu(x, w_gate, w_up, w_down):
    return (jax.nn.silu(x @ w_gate) * (x @ w_up)) @ w_down


def _causal_dwconv(x, w, b):
    k_w, s = w.shape[0], x.shape[1]
    xp = jnp.pad(x, ((0, 0), (k_w - 1, 0), (0, 0)))
    y = b + xp[:, 0:s] * w[0]
    for j in range(1, k_w):
        y = y + xp[:, j:j + s] * w[j]
    return y


def _block_diag(x, w):
    b, s, _ = x.shape
    n, bi, bo = w.shape
    y = jnp.einsum('bsni,nio->bsno', x.reshape(b, s, n, bi), w)
    return y.reshape(b, s, n * bo)


def _rg_lru(x, w_r, b_r, w_i, b_i, lam):
    xf = x.astype(F32)
    r = jax.nn.sigmoid((_block_diag(x, w_r) + b_r).astype(F32))
    gi = jax.nn.sigmoid((_block_diag(x, w_i) + b_i).astype(F32))
    log_a = -LRU_C * r * jax.nn.softplus(-lam.astype(F32))
    a = jnp.exp(log_a)
    u = jnp.sqrt(-jnp.expm1(2.0 * log_a)) * (gi * xf)

    def combine(e1, e2):
        a1, b1 = e1
        a2, b2 = e2
        return a1 * a2, a2 * b1 + b2

    _, h = lax.associative_scan(combine, (a, u), axis=1)
    return h.astype(x.dtype)


def _mlstm_chunkwise(q, k, v, log_i, log_f):
    b, s, h, dh = q.shape
    nc = s // ML_CHUNK

    def to_chunks(t):
        return jnp.moveaxis(t.reshape(b, nc, ML_CHUNK, h, dh), (1, 3), (0, 2))

    def gate_chunks(t):
        return t.reshape(b, nc, ML_CHUNK, h).transpose(1, 0, 3, 2)

    causal = jnp.tril(jnp.ones((ML_CHUNK, ML_CHUNK), dtype=bool))

    def step(carry, inp):
        c_s, n_s, m = carry
        qc, kc, vc, ic, fc = inp
        bcum = jnp.cumsum(fc, axis=-1)
        dmat = bcum[..., :, None] - bcum[..., None, :] + ic[..., None, :]
        dmat = jnp.where(causal, dmat, -jnp.inf)
        inter = bcum + m[..., None]
        m_t = jnp.maximum(inter, jnp.max(dmat, axis=-1))
        w_intra = jnp.exp(dmat - m_t[..., None])
        w_inter = jnp.exp(inter - m_t)
        sc = jnp.einsum('bhtd,bhsd->bhts', qc, kc) * w_intra
        num = jnp.einsum('bhts,bhsd->bhtd', sc, vc) + w_inter[..., None] * jnp.einsum('bhvk,bhtk->bhtv', c_s, qc)
        den = jnp.sum(sc, axis=-1) + w_inter * jnp.einsum('bhk,bhtk->bht', n_s, qc)
        h_out = num / jnp.maximum(jnp.abs(den), jnp.exp(-m_t))[..., None]
        b_last = bcum[..., -1]
        g = b_last[..., None] - bcum + ic
        m_new = jnp.maximum(b_last + m, jnp.max(g, axis=-1))
        w_s = jnp.exp(g - m_new[..., None])
        decay = jnp.exp(b_last + m - m_new)
        c_new = decay[..., None, None] * c_s + jnp.einsum('bhsv,bhsk->bhvk', vc * w_s[..., None], kc)
        n_new = decay[..., None] * n_s + jnp.einsum('bhs,bhsk->bhk', w_s, kc)
        return (c_new, n_new, m_new), h_out

    init = (jnp.zeros((b, h, dh, dh), F32), jnp.zeros((b, h, dh), F32), jnp.zeros((b, h), F32))
    _, hs = lax.scan(step, init, (to_chunks(q), to_chunks(k), to_chunks(v), gate_chunks(log_i), gate_chunks(log_f)))
    return hs.transpose(1, 0, 3, 2, 4).reshape(b, s, h, dh)


def _lru_mixer(main, gate, conv_w, conv_b, w_r, b_r, w_i, b_i, lam):
    xc = _causal_dwconv(main, conv_w, conv_b)
    return _rg_lru(xc, w_r, b_r, w_i, b_i, lam) * jax.nn.gelu(gate, approximate=True)


def _mlstm_mixer(main, gate, conv_w, conv_b, w_q, w_k, w_v, w_gates, b_gates, ln_g, skip):
    b, s, _ = main.shape
    xc = jax.nn.silu(_causal_dwconv(main, conv_w, conv_b))
    q = _block_diag(xc, w_q)
    k = _block_diag(xc, w_k)
    v = _block_diag(main, w_v)
    g = (jnp.concatenate([q, k, v], axis=-1) @ w_gates + b_gates).astype(F32)
    log_i = g[..., :ML_HEADS]
    log_f = jax.nn.log_sigmoid(g[..., ML_HEADS:])

    def heads(t):
        return t.astype(F32).reshape(b, s, ML_HEADS, ML_HEAD_DIM)

    h = _mlstm_chunkwise(heads(q), heads(k) * (ML_HEAD_DIM ** -0.5), heads(v), log_i, log_f)
    mu = jnp.mean(h, axis=-1, keepdims=True)
    var = jnp.mean(jnp.square(h - mu), axis=-1, keepdims=True)
    h = ((h - mu) * lax.rsqrt(var + EPS)).reshape(b, s, MIX_WIDTH) * ln_g.astype(F32)
    h = h.astype(main.dtype)
    return (h + skip * xc) * jax.nn.silu(gate)


def _cross_attn(qx, mem_n, w_mem_kv):
    b, s, _ = qx.shape
    k_m, v_m = jnp.split(mem_n @ w_mem_kv, 2, axis=-1)
    q = qx.reshape(b, s, XA_HEADS, XA_HEAD_DIM).astype(F32)
    k_m = k_m.reshape(b, -1, XA_HEADS, XA_HEAD_DIM).astype(F32)
    v_m = v_m.reshape(b, -1, XA_HEADS, XA_HEAD_DIM).astype(F32)
    sc = jnp.einsum('bshd,bmhd->bhsm', q, k_m) * (XA_HEAD_DIM ** -0.5)
    p = jax.nn.softmax(sc, axis=-1)
    o = jnp.einsum('bhsm,bmhd->bshd', p, v_m)
    return o.reshape(b, s, XA_WIDTH).astype(qx.dtype)


def setup_inputs(seed: int = 0) -> dict:
    key = jax.random.key(seed)
    it = iter(jax.random.split(key, 40))

    def normal(shape, fan_in):
        return jax.random.normal(next(it), shape, F32) * (fan_in ** -0.5)

    def gain(shape):
        return 1.0 + 0.02 * jax.random.normal(next(it), shape, F32)

    def bias(shape, scale=0.02):
        return scale * jax.random.normal(next(it), shape, F32)

    u = jax.random.uniform(next(it), (N_A, MIX_WIDTH), F32, minval=0.9, maxval=0.999)
    a0 = u ** (1.0 / LRU_C)
    lru_lambda = jnp.log(a0) - jnp.log1p(-a0)
    b_ig = bias((N_B, ML_HEADS), 0.1)
    b_fg = jnp.linspace(3.0, 6.0, ML_HEADS, dtype=F32)[None, :] + bias((N_B, ML_HEADS), 0.01)

    return {
        'x': normal((BATCH, SEQ, D_MODEL), 1),
        'mem': normal((BATCH, MEM_LEN, D_MODEL), 1),
        'ffn1_norm': gain((DEPTH, D_MODEL)),
        'ffn1_w_gate': normal((DEPTH, D_MODEL, D_FF), D_MODEL),
        'ffn1_w_up': normal((DEPTH, D_MODEL, D_FF), D_MODEL),
        'ffn1_w_down': normal((DEPTH, D_FF, D_MODEL), D_FF),
        'mix_norm': gain((DEPTH, D_MODEL)),
        'w_in': normal((DEPTH, D_MODEL, IN_WIDTH), D_MODEL),
        'mem_norm': gain((DEPTH, D_MODEL)),
        'w_mem_kv': normal((DEPTH, D_MODEL, 2 * XA_WIDTH), D_MODEL),
        'w_out': normal((DEPTH, OUT_WIDTH, D_MODEL), OUT_WIDTH),
        'ffn2_norm': gain((DEPTH, D_MODEL)),
        'ffn2_w_gate': normal((DEPTH, D_MODEL, D_FF), D_MODEL),
        'ffn2_w_up': normal((DEPTH, D_MODEL, D_FF), D_MODEL),
        'ffn2_w_down': normal((DEPTH, D_FF, D_MODEL), D_FF),
        'lru_conv_w': normal((N_A, CONV_WIDTH, MIX_WIDTH), CONV_WIDTH),
        'lru_conv_b': bias((N_A, MIX_WIDTH)),
        'lru_w_r': normal((N_A, LRU_BLOCKS, LRU_BS, LRU_BS), LRU_BS),
        'lru_b_r': bias((N_A, MIX_WIDTH)),
        'lru_w_i': normal((N_A, LRU_BLOCKS, LRU_BS, LRU_BS), LRU_BS),
        'lru_b_i': bias((N_A, MIX_WIDTH)),
        'lru_lambda': lru_lambda,
        'ml_conv_w': normal((N_B, CONV_WIDTH, MIX_WIDTH), CONV_WIDTH),
        'ml_conv_b': bias((N_B, MIX_WIDTH)),
        'ml_w_q': normal((N_B, ML_QKV_BLOCKS, ML_QKV_BS, ML_QKV_BS), ML_QKV_BS),
        'ml_w_k': normal((N_B, ML_QKV_BLOCKS, ML_QKV_BS, ML_QKV_BS), ML_QKV_BS),
        'ml_w_v': normal((N_B, ML_QKV_BLOCKS, ML_QKV_BS, ML_QKV_BS), ML_QKV_BS),
        'ml_w_gates': normal((N_B, 3 * MIX_WIDTH, 2 * ML_HEADS), 3 * MIX_WIDTH),
        'ml_b_gates': jnp.concatenate([b_ig, b_fg], axis=-1),
        'ml_ln_g': gain((N_B, MIX_WIDTH)),
        'ml_skip': gain((N_B, MIX_WIDTH)),
        'final_norm': gain((D_MODEL,)),
    }


def reference(x, mem, ffn1_norm, ffn1_w_gate, ffn1_w_up, ffn1_w_down, mix_norm, w_in, mem_norm, w_mem_kv, w_out,
              ffn2_norm, ffn2_w_gate, ffn2_w_up, ffn2_w_down, lru_conv_w, lru_conv_b, lru_w_r, lru_b_r, lru_w_i,
              lru_b_i, lru_lambda, ml_conv_w, ml_conv_b, ml_w_q, ml_w_k, ml_w_v, ml_w_gates, ml_b_gates, ml_ln_g,
              ml_skip, final_norm):
    h = x
    for l in range(DEPTH):
        h = h + 0.5 * _swiglu(_rmsnorm(h, ffn1_norm[l]), ffn1_w_gate[l], ffn1_w_up[l], ffn1_w_down[l])
        u = _rmsnorm(h, mix_norm[l]) @ w_in[l]
        main = u[..., :MIX_WIDTH]
        gate = u[..., MIX_WIDTH:2 * MIX_WIDTH]
        qx = u[..., 2 * MIX_WIDTH:]
        j = l // N_MIXERS
        if l % N_MIXERS == 0:
            y = _lru_mixer(main, gate, lru_conv_w[j], lru_conv_b[j], lru_w_r[j], lru_b_r[j], lru_w_i[j],
                           lru_b_i[j], lru_lambda[j])
        else:
            y = _mlstm_mixer(main, gate, ml_conv_w[j], ml_conv_b[j], ml_w_q[j], ml_w_k[j], ml_w_v[j],
                             ml_w_gates[j], ml_b_gates[j], ml_ln_g[j], ml_skip[j])
        xa = _cross_attn(qx, _rmsnorm(mem, mem_norm[l]), w_mem_kv[l])
        h = h + jnp.concatenate([y, xa], axis=-1) @ w_out[l]
        h = h + 0.5 * _swiglu(_rmsnorm(h, ffn2_norm[l]), ffn2_w_gate[l], ffn2_w_up[l], ffn2_w_down[l])
    return _rmsnorm(h, final_norm)
```

```cpp
#include <hip/hip_runtime.h>
#include <hip/hip_cooperative_groups.h>
#include <cstdio>
namespace cg = cooperative_groups;

#define PROBE_ML2_REP 1
#define LAS __attribute__((address_space(3)))
typedef unsigned short bf16_t;
typedef short bf16x8 __attribute__((ext_vector_type(8)));
typedef short s16x4 __attribute__((ext_vector_type(4)));
typedef float f32x4 __attribute__((ext_vector_type(4)));
typedef unsigned u32x4 __attribute__((ext_vector_type(4)));
typedef unsigned u32x2 __attribute__((ext_vector_type(2)));
typedef LAS unsigned char* lds_t;

constexpr int T_ = 16384, D_ = 1024, SEQ_ = 2048, NB_ = 8, FF_ = 2816, MIXW = 1536, INW = 3584, OUTW = 2048, MEMT = 2048;
constexpr float EPS_ = 1e-6f;
constexpr int NTHR = 512;
constexpr int LDS_BYTES = 152 * 1024;

constexpr size_t SZ_GU = (size_t)5632 * 1024 * 2, SZ_DN = (size_t)1024 * 2816 * 2, SZ_IN = (size_t)3584 * 1024 * 2, SZ_KV = (size_t)1024 * 1024 * 2, SZ_OUT = (size_t)1024 * 2048 * 2;
constexpr size_t WL_GU1 = 0, WL_D1 = WL_GU1 + SZ_GU, WL_IN = WL_D1 + SZ_DN, WL_KV = WL_IN + SZ_IN, WL_OUT = WL_KV + SZ_KV, WL_GU2 = WL_OUT + SZ_OUT, WL_D2 = WL_GU2 + SZ_GU, WL_LAYER = WL_D2 + SZ_DN;
constexpr size_t WS_WB = 0;
constexpr size_t WS_U = WS_WB + 4 * WL_LAYER;
constexpr size_t WS_XC = WS_U + (size_t)T_ * INW * 2;
constexpr size_t WS_HOUT = WS_XC + (size_t)T_ * MIXW * 2;
constexpr size_t WS_HB = WS_HOUT + (size_t)T_ * MIXW * 2;
constexpr size_t WS_MEMB = WS_HB + (size_t)T_ * D_ * 2;
constexpr size_t WS_KVM = WS_MEMB + (size_t)MEMT * D_ * 2;
constexpr size_t WS_G = WS_KVM + (size_t)MEMT * D_ * 2;
constexpr size_t WS_SS = WS_G + (size_t)T_ * 8 * 4;
constexpr size_t WS_SSM = WS_SS + (size_t)16 * T_ * 4;
constexpr size_t WS_BAR = WS_SSM + (size_t)MEMT * 16 * 4;
constexpr size_t WS_END = WS_BAR + 16384;

struct P {
    const float* in[32];
    float* out;
    unsigned char* ws;
    int ph_lo, ph_hi, coop, pad;
};
typedef const __attribute__((address_space(4))) P CP;

__device__ __forceinline__ unsigned cvt_pk_bf16(float lo, float hi) { unsigned r; asm("v_cvt_pk_bf16_f32 %0, %1, %2" : "=v"(r) : "v"(lo), "v"(hi)); return r; }
__device__ __forceinline__ float bflo(unsigned w) { return __uint_as_float(w << 16); }
__device__ __forceinline__ float bfhi(unsigned w) { return __uint_as_float(w & 0xffff0000u); }
__device__ __forceinline__ float bf2f(bf16_t b) { return __uint_as_float(((unsigned)b) << 16); }
__device__ __forceinline__ float frcp_(float x) { return __builtin_amdgcn_rcpf(x); }
__device__ __forceinline__ float sigmoidf_(float x) { return frcp_(1.0f + __expf(-x)); }
__device__ __forceinline__ float siluf_(float x) { return x * frcp_(1.0f + __expf(-x)); }
__device__ __forceinline__ float gelu_tanh_(float x) { const float u = 1.5957691216f * (x + 0.044715f * x * x * x); return x * frcp_(1.0f + __expf(-u)); }
__device__ __forceinline__ float softplusf_(float x) { return fmaxf(x, 0.f) + log1pf(__expf(-fabsf(x))); }
__device__ __forceinline__ float wave_sum(float v) {
#pragma unroll
    for (int d = 32; d >= 1; d >>= 1) v += __shfl_xor(v, d);
    return v;
}
template <class Tt> __device__ __forceinline__ Tt lds_ld(lds_t L, int off) { return *(const LAS Tt*)(L + off); }
template <class Tt> __device__ __forceinline__ void lds_st(lds_t L, int off, Tt v) { *(LAS Tt*)(L + off) = v; }
__device__ __forceinline__ bf16x8 tr_pair(lds_t L, int off0, int off1) {
    s16x4 a = __builtin_amdgcn_ds_read_tr16_b64_v4i16((LAS s16x4*)(L + off0));
    s16x4 b = __builtin_amdgcn_ds_read_tr16_b64_v4i16((LAS s16x4*)(L + off1));
    return __builtin_shufflevector(a, b, 0, 1, 2, 3, 4, 5, 6, 7);
}
__device__ __forceinline__ bf16x8 pack8(f32x4 a, f32x4 b) {
    u32x4 w; w.x = cvt_pk_bf16(a[0], a[1]); w.y = cvt_pk_bf16(a[2], a[3]); w.z = cvt_pk_bf16(b[0], b[1]); w.w = cvt_pk_bf16(b[2], b[3]);
    return __builtin_bit_cast(bf16x8, w);
}
__device__ __forceinline__ void st16_sc1(void* ptr, u32x4 v) { asm volatile("global_store_dwordx4 %0, %1, off sc1\n\ts_nop 2" :: "v"(ptr), "v"(v) : "memory"); }
#define MFMA16(a, b, c) __builtin_amdgcn_mfma_f32_16x16x32_bf16((a), (b), (c), 0, 0, 0)

#define XB_TMO      128
#define XB_XCNT(j)  (256  + 64 * (j))
#define XB_XSUB(j)  (1280 + 64 * (j))
#define XB_XGEN(j)  (2304 + 64 * (j))
#define XB_TOP      3328
#define XB_TOPGEN   3392
#define XCD_BAR_WORDS 3456
#define XB_SPIN_CAP (1u << 18)

__device__ __forceinline__ unsigned xb_ld(unsigned* p)              { return __hip_atomic_load(p, __ATOMIC_RELAXED, __HIP_MEMORY_SCOPE_AGENT); }
__device__ __forceinline__ unsigned xb_add(unsigned* p, unsigned v) { return __hip_atomic_fetch_add(p, v, __ATOMIC_RELAXED, __HIP_MEMORY_SCOPE_AGENT); }
__device__ __forceinline__ unsigned xb_xcc_id() { return (unsigned)__builtin_amdgcn_s_getreg((3 << 11) | 20) & 0xFu; }
#define XB_SPIN(cond, bar) do { unsigned _sp = 0; while (cond) { __builtin_amdgcn_s_sleep(1); \
    if ((++_sp & 255u) == 0u) { if (xb_ld(&(bar)[XB_TMO])) break; if (_sp > XB_SPIN_CAP) { atomicAdd(&(bar)[XB_TMO], 1u); break; } } } } while (0)

struct XcdBarrier {
    unsigned* bar; unsigned x;
    volatile LAS unsigned* st;
};

__device__ __forceinline__ XcdBarrier xcd_barrier_post(unsigned* bar, volatile LAS unsigned* st) {
    XcdBarrier b; b.bar = bar; b.x = xb_xcc_id(); b.st = st;
    if (threadIdx.x == 0) (void)xb_add(&bar[XB_XCNT(b.x)], 1u);
    return b;
}
__device__ __forceinline__ void xcd_barrier_complete(unsigned* bar, unsigned x, unsigned& nloc, unsigned& nx) {
    const unsigned G = gridDim.x * gridDim.y * gridDim.z;
    unsigned sum, cnt, mine, sp = 0u;
    for (;;) {
        sum = 0u; cnt = 0u; mine = 0u;
#pragma unroll
        for (unsigned j = 0; j < 16; ++j) { const unsigned c = xb_ld(&bar[XB_XCNT(j)]); sum += c; cnt += (c > 0u) ? 1u : 0u; mine = (j == x) ? c : mine; }
        if (sum == G) break;
        __builtin_amdgcn_s_sleep(1);
        if ((++sp & 255u) == 0u) { if (xb_ld(&bar[XB_TMO])) break; if (sp > XB_SPIN_CAP) { atomicAdd(&bar[XB_TMO], 1u); break; } }
    }
    nloc = mine > 0u ? mine : 1u; nx = cnt > 0u ? cnt : 1u;
}

__device__ __forceinline__ void xcd_barrier(const XcdBarrier& b) {
    asm volatile("s_waitcnt vmcnt(0)" ::: "memory");
    __syncthreads();
    if (threadIdx.x == 0) {
        unsigned* bar = b.bar;
        __builtin_amdgcn_s_waitcnt(0);
        unsigned nloc = b.st[0], nx = b.st[1];
        if (nloc == 0u) { xcd_barrier_complete(bar, b.x, nloc, nx); b.st[0] = nloc; b.st[1] = nx; }
        const unsigned old = xb_add(&bar[XB_XSUB(b.x)], 1u);
        const unsigned gen = old / nloc;
        if (old + 1u == (gen + 1u) * nloc) {
            __builtin_amdgcn_fence(__ATOMIC_RELEASE, "agent");
            asm volatile("s_waitcnt vmcnt(0)" ::: "memory");
            const unsigned og = xb_add(&bar[XB_TOP], 1u);
            const unsigned tg = og / nx;
            if (og + 1u == (tg + 1u) * nx) xb_add(&bar[XB_TOPGEN], 1u);
            else XB_SPIN(xb_ld(&bar[XB_TOPGEN]) == tg, bar);
            __builtin_amdgcn_fence(__ATOMIC_ACQUIRE, "agent");
            xb_add(&bar[XB_XGEN(b.x)], 1u);
            asm volatile("s_waitcnt vmcnt(0)" ::: "memory");
        } else {
            XB_SPIN(xb_ld(&bar[XB_XGEN(b.x)]) == gen, bar);
            __builtin_amdgcn_fence(__ATOMIC_ACQUIRE, "agent");
            asm volatile("s_waitcnt vmcnt(0)" ::: "memory");
        }
    }
    __syncthreads();
}


namespace pg8 {
constexpr int BM = 256, BK = 64, HALF = 128, HTB = HALF * BK * 2, NXCD = 8, WGM = 8;
__device__ __forceinline__ int lds_byte(int r, int c) { const int st = (r >> 4) * 2 + (c >> 5), rr = r & 15, cc = c & 31, ob = rr * 64 + cc * 2; return st * 1024 + (ob ^ (((ob >> 9) & 1) << 5)); }
__device__ __forceinline__ void stage_rc(int b, int& R, int& C) { const int st = b / 1024, sb = b % 1024, swz = sb ^ (((sb >> 9) & 1) << 5); R = (st >> 1) * 16 + swz / 64; C = (st & 1) * 32 + (swz % 64) / 2; }
__device__ __forceinline__ int perm32(int rho) { const int n = rho >> 4, i = rho & 15; return 8 * (i >> 2) + 4 * n + (i & 3); }
struct Unit { int pm, pn; };
struct Gemm { const bf16_t* A; const bf16_t* Bt; int M, N, K, lda; };
struct StaticOrder {
    int nM, nN, nwg, G, c;
    __device__ void init(int M, int N, int G_, int c_) { nM = M / BM; nN = N / BM; nwg = nM * nN; G = G_; c = c_; }
    __device__ bool next(int i, Unit& u) const {
        const long L = (long)i * G + c; if (L >= nwg) return false;
        int wgid = (int)L; { const int q = nwg / NXCD, r = nwg % NXCD, xcd = wgid % NXCD, off = wgid / NXCD; wgid = (xcd < r ? xcd * (q + 1) : r * (q + 1) + (xcd - r) * q) + off; }
        const int nig = WGM * nN, gid = wgid / nig, fm = gid * WGM, gsz = (nM - fm) < WGM ? (nM - fm) : WGM;
        u.pm = fm + ((wgid % nig) % gsz); u.pn = (wgid % nig) / gsz; return true;
    }
};

template <class Epi>
__device__ __forceinline__ void gemm_phase(lds_t lds, const Gemm g, const StaticOrder& S, const Epi& E) {
    int tid_ = threadIdx.x; asm volatile("" : "+v"(tid_)); const int tid = tid_, wid = __builtin_amdgcn_readfirstlane(tid >> 6), lane = tid & 63, wr = wid >> 2, wc = wid & 3, fr = lane & 15, fq = lane >> 4;
    const int K = g.K, nt = K / BK, lda = g.lda;
    unsigned voffA[2], voffB[2];
#pragma unroll
    for (int i = 0; i < 2; ++i) { int R, C; stage_rc(tid * 16 + i * 8192, R, C); const int Rb = Epi::PERM ? ((R & ~31) + perm32(R & 31)) : R;
        voffA[i] = (unsigned)(R * lda + C) * 2u; voffB[i] = (unsigned)(Rb * K + C) * 2u; }
    const size_t kstep = (size_t)(BK * 2);
    const size_t hstepA = (size_t)HALF * lda * 2, hstepB = (size_t)HALF * K * 2;
    const size_t tstepA = 2 * hstepA, tstepB = 2 * hstepB;
    const unsigned ldsw = (unsigned)wid * 1024u;
    const int aoff = lds_byte(wr * 64 + fr, fq * 8), boff = lds_byte(wc * 32 + fr, fq * 8);
#define PG8_SA(b, h) (((b) * 2 + (h)) * HTB)
#define PG8_SB(b, h) ((4 + (b) * 2 + (h)) * HTB)
#define PG8_STAGE(bufoff, gbase, voff) do { _Pragma("unroll") for (int _i = 0; _i < 2; ++_i) \
        __builtin_amdgcn_global_load_lds((const unsigned*)((const char*)(gbase) + (voff)[_i]), (LAS unsigned*)(lds + (bufoff) + ldsw + _i * 8192), 16, 0, 0); } while (0)
#define PG8_LDA(dst, b, h) do { _Pragma("unroll") for (int m = 0; m < 4; ++m) _Pragma("unroll") for (int k = 0; k < 2; ++k) dst[m][k] = *(const LAS bf16x8*)(lds + PG8_SA(b, h) + aoff + m * 2048 + k * 1024); } while (0)
#define PG8_LDB(dst, b, h) do { _Pragma("unroll") for (int n = 0; n < 2; ++n) _Pragma("unroll") for (int k = 0; k < 2; ++k) dst[n][k] = *(const LAS bf16x8*)(lds + PG8_SB(b, h) + boff + n * 2048 + k * 1024); } while (0)
#define PG8_MMA(ai, bj, At, Bt) do { __builtin_amdgcn_s_setprio(1); _Pragma("unroll") for (int m = 0; m < 4; ++m) _Pragma("unroll") for (int n = 0; n < 2; ++n) _Pragma("unroll") for (int k = 0; k < 2; ++k) \
        acc[ai][bj][m][n] = __builtin_amdgcn_mfma_f32_16x16x32_bf16(Bt[n][k], At[m][k], acc[ai][bj][m][n], 0, 0, 0); __builtin_amdgcn_s_setprio(0); } while (0)
#define PG8_WAIT_V(n) asm volatile("s_waitcnt vmcnt(" #n ")" ::: "memory")
#define PG8_WAIT_L(n) asm volatile("s_waitcnt lgkmcnt(" #n ")" ::: "memory")
#define PG8_BAR __builtin_amdgcn_s_barrier()
#define PG8_SCHED __builtin_amdgcn_sched_barrier(0)
    Unit cur, nxt; int ui = 0;
    if (!S.next(0, cur)) return;
    f32x4 acc[2][2][4][2];
    E.init(acc, cur, wr, wc, fr, fq);
    bf16x8 At[4][2], B0[2][2], B1[2][2];
    E.rowscales(lds, tid * 32, cur.pm, wr, fr, fq);
    const char* cA = (const char*)g.A + (size_t)cur.pm * tstepA; const char* cB = (const char*)g.Bt + (size_t)cur.pn * tstepB;
    PG8_STAGE(PG8_SB(0, 0), cB, voffB); PG8_STAGE(PG8_SA(0, 0), cA, voffA); PG8_STAGE(PG8_SB(0, 1), cB + hstepB, voffB); PG8_STAGE(PG8_SA(0, 1), cA + hstepA, voffA);
    if (wr == 1) PG8_BAR;
    PG8_WAIT_V(4); PG8_BAR;
    PG8_STAGE(PG8_SB(1, 0), cB + kstep, voffB); PG8_STAGE(PG8_SA(1, 0), cA + kstep, voffA); PG8_STAGE(PG8_SB(1, 1), cB + hstepB + kstep, voffB);
    PG8_WAIT_V(6); PG8_BAR;
    for (;;) {
        const bool has_next = S.next(ui + 1, nxt);
        const char* nA = has_next ? (const char*)g.A + (size_t)nxt.pm * tstepA : cA; const char* nB = has_next ? (const char*)g.Bt + (size_t)nxt.pn * tstepB : cB;
        for (int t = 0; t < nt; t += 2) {
            const bool last = (t == nt - 2);
            const char* a1 = cA + (size_t)(t + 1) * kstep;
            const char* a2 = last ? nA : cA + (size_t)(t + 2) * kstep; const char* b2 = last ? nB : cB + (size_t)(t + 2) * kstep;
            const char* a3 = a2 + kstep; const char* b3 = b2 + kstep;
            PG8_LDB(B0, 0, 0); PG8_SCHED; PG8_LDA(At, 0, 0); PG8_STAGE(PG8_SA(1, 1), a1 + hstepA, voffA);
            PG8_WAIT_L(8); PG8_BAR; PG8_WAIT_L(0); PG8_MMA(0, 0, At, B0); PG8_BAR; PG8_SCHED;
            PG8_LDB(B1, 0, 1); PG8_STAGE(PG8_SB(0, 0), b2, voffB);
            PG8_BAR; PG8_WAIT_L(0); PG8_MMA(0, 1, At, B1); PG8_BAR;
            PG8_LDA(At, 0, 1); PG8_STAGE(PG8_SA(0, 0), a2, voffA);
            PG8_BAR; PG8_WAIT_L(0); PG8_MMA(1, 0, At, B0); PG8_BAR; PG8_SCHED;
            PG8_STAGE(PG8_SB(0, 1), b2 + hstepB, voffB);
            PG8_WAIT_V(6); PG8_BAR; PG8_MMA(1, 1, At, B1); PG8_BAR;
            PG8_LDB(B0, 1, 0); PG8_SCHED; PG8_LDA(At, 1, 0); PG8_STAGE(PG8_SA(0, 1), a2 + hstepA, voffA);
            PG8_WAIT_L(8); PG8_BAR; PG8_WAIT_L(0); PG8_MMA(0, 0, At, B0); PG8_BAR; PG8_SCHED;
            PG8_LDB(B1, 1, 1); PG8_STAGE(PG8_SB(1, 0), b3, voffB);
            PG8_BAR; PG8_WAIT_L(0); PG8_MMA(0, 1, At, B1); PG8_BAR;
            PG8_LDA(At, 1, 1); PG8_STAGE(PG8_SA(1, 0), a3, voffA);
            PG8_BAR; PG8_WAIT_L(0); PG8_MMA(1, 0, At, B0); PG8_BAR; PG8_SCHED;
            PG8_STAGE(PG8_SB(1, 1), b3 + hstepB, voffB);
            PG8_WAIT_V(6); PG8_BAR; PG8_MMA(1, 1, At, B1); PG8_BAR;
        }
        E(acc, lds, tid * 32, cur, wr, wc, fr, fq);
        if (!has_next) break;
        E.init(acc, nxt, wr, wc, fr, fq);
        if (nxt.pm != cur.pm) E.rowscales(lds, tid * 32, nxt.pm, wr, fr, fq);
        cur = nxt; cA = nA; cB = nB; ++ui;
    }
    PG8_WAIT_V(0);
    if (wr == 0) PG8_BAR;
    PG8_BAR;
#undef PG8_SA
#undef PG8_SB
#undef PG8_STAGE
#undef PG8_LDA
#undef PG8_LDB
#undef PG8_MMA
#undef PG8_WAIT_V
#undef PG8_WAIT_L
#undef PG8_BAR
#undef PG8_SCHED
}

__device__ __forceinline__ float rowscale(const float* ss, int row) {
    const f32x4 a = *(const f32x4*)(ss + (size_t)row * 16), b = *(const f32x4*)(ss + (size_t)row * 16 + 4), c = *(const f32x4*)(ss + (size_t)row * 16 + 8), d = *(const f32x4*)(ss + (size_t)row * 16 + 12);
    const float s = ((a[0] + a[1]) + (a[2] + a[3])) + ((b[0] + b[1]) + (b[2] + b[3])) + ((c[0] + c[1]) + (c[2] + c[3])) + ((d[0] + d[1]) + (d[2] + d[3]));
    return rsqrtf(s * (1.0f / 1024.0f) + EPS_); }

struct EpiAll {
    static constexpr bool PERM = true;
    int mode; bf16_t* O; int ldc; const float* ss; float* H; float* ssn;
    __device__ __forceinline__ void init(f32x4 (&acc)[2][2][4][2], const Unit& u, int wr, int wc, int fr, int fq) const {
        if (mode == 2) {
            const int row0 = u.pm * BM + wr * 64 + fr, col0 = u.pn * BM + wc * 32 + 8 * fq;
#pragma unroll
            for (int ai = 0; ai < 2; ++ai)
#pragma unroll
                for (int m = 0; m < 4; ++m)
#pragma unroll
                    for (int bj = 0; bj < 2; ++bj) { const u32x4 hw = *(const u32x4*)(O + (size_t)(row0 + ai * HALF + m * 16) * D_ + col0 + bj * HALF);
                        acc[ai][bj][m][0] = (f32x4){bflo(hw.x), bfhi(hw.x), bflo(hw.y), bfhi(hw.y)}; acc[ai][bj][m][1] = (f32x4){bflo(hw.z), bfhi(hw.z), bflo(hw.w), bfhi(hw.w)}; }
        } else {
#pragma unroll
            for (int a = 0; a < 2; ++a)
#pragma unroll
                for (int b = 0; b < 2; ++b)
#pragma unroll
                    for (int m = 0; m < 4; ++m)
#pragma unroll
                        for (int n = 0; n < 2; ++n) acc[a][b][m][n] = (f32x4){0.f, 0.f, 0.f, 0.f};
        }
    }
    __device__ __forceinline__ void rowscales(lds_t lds, int tslot, int pm, int wr, int fr, int fq) const {
        float rs[2][4];
        if (mode != 2) { const int row0 = pm * BM + wr * 64 + fr; f32x4 t[2][4];
#pragma unroll
            for (int ai = 0; ai < 2; ++ai)
#pragma unroll
                for (int m = 0; m < 4; ++m) t[ai][m] = *(const f32x4*)(ss + (size_t)(row0 + ai * HALF + m * 16) * 16 + 4 * fq);
#pragma unroll
            for (int ai = 0; ai < 2; ++ai)
#pragma unroll
                for (int m = 0; m < 4; ++m) { float sm = (t[ai][m][0] + t[ai][m][1]) + (t[ai][m][2] + t[ai][m][3]);
                    sm += __shfl_xor(sm, 16); sm += __shfl_xor(sm, 32);
                    rs[ai][m] = rsqrtf(sm * (1.0f / 1024.0f) + EPS_); }
            *(LAS f32x4*)(lds + 131072 + tslot) = (f32x4){rs[0][0], rs[0][1], rs[0][2], rs[0][3]};
            *(LAS f32x4*)(lds + 131072 + tslot + 16) = (f32x4){rs[1][0], rs[1][1], rs[1][2], rs[1][3]}; }
    }
    __device__ __forceinline__ void operator()(const f32x4 (&acc)[2][2][4][2], lds_t lds, int tslot, const Unit& u, int wr, int wc, int fr, int fq) const {
        const int row0 = u.pm * BM + wr * 64 + fr;
        if (mode != 2) {
            float rs[2][4];
            { const f32x4 r0 = *(const LAS f32x4*)(lds + 131072 + tslot), r1 = *(const LAS f32x4*)(lds + 131072 + tslot + 16);
              rs[0][0] = r0[0]; rs[0][1] = r0[1]; rs[0][2] = r0[2]; rs[0][3] = r0[3]; rs[1][0] = r1[0]; rs[1][1] = r1[1]; rs[1][2] = r1[2]; rs[1][3] = r1[3]; }
            if (mode == 0) {
                const int col0 = u.pn * 128 + wc * 32 + 8 * fq;
#pragma unroll
                for (int ai = 0; ai < 2; ++ai)
#pragma unroll
                    for (int m = 0; m < 4; ++m) { const int row = row0 + ai * HALF + m * 16; const float r1 = rs[ai][m];
                        float v[8];
#pragma unroll
                        for (int n = 0; n < 2; ++n)
#pragma unroll
                            for (int j = 0; j < 4; ++j) { const float gt = acc[ai][0][m][n][j] * r1, up = acc[ai][1][m][n][j] * r1; v[n * 4 + j] = siluf_(gt) * up; }
                        u32x4 w; w.x = cvt_pk_bf16(v[0], v[1]); w.y = cvt_pk_bf16(v[2], v[3]); w.z = cvt_pk_bf16(v[4], v[5]); w.w = cvt_pk_bf16(v[6], v[7]);
                        st16_sc1(O + (size_t)row * FF_ + col0, w); }
            } else {
                const int col0 = u.pn * BM + wc * 32 + 8 * fq;
#pragma unroll
                for (int ai = 0; ai < 2; ++ai)
#pragma unroll
                    for (int m = 0; m < 4; ++m) { const int row = row0 + ai * HALF + m * 16; const float r1 = rs[ai][m];
#pragma unroll
                        for (int bj = 0; bj < 2; ++bj) { const f32x4 v0 = acc[ai][bj][m][0] * r1, v1 = acc[ai][bj][m][1] * r1;
                            u32x4 w; w.x = cvt_pk_bf16(v0[0], v0[1]); w.y = cvt_pk_bf16(v0[2], v0[3]); w.z = cvt_pk_bf16(v1[0], v1[1]); w.w = cvt_pk_bf16(v1[2], v1[3]);
                            st16_sc1(O + (size_t)row * ldc + col0 + bj * HALF, w); } }
            }
        } else {
            const int col0 = u.pn * BM + wc * 32 + 8 * fq;
#pragma unroll
            for (int ai = 0; ai < 2; ++ai)
#pragma unroll
                for (int m = 0; m < 4; ++m) { const int row = row0 + ai * HALF + m * 16; float s2 = 0.f;
#pragma unroll
                    for (int bj = 0; bj < 2; ++bj) { const size_t o = (size_t)row * D_ + col0 + bj * HALF;
                        const f32x4 h0 = acc[ai][bj][m][0], h1 = acc[ai][bj][m][1];
                        u32x4 w; w.x = cvt_pk_bf16(h0[0], h0[1]); w.y = cvt_pk_bf16(h0[2], h0[3]); w.z = cvt_pk_bf16(h1[0], h1[1]); w.w = cvt_pk_bf16(h1[2], h1[3]);
                        st16_sc1(O + o, w);
                        s2 += h0[0] * h0[0] + h0[1] * h0[1] + h0[2] * h0[2] + h0[3] * h0[3] + h1[0] * h1[0] + h1[1] * h1[1] + h1[2] * h1[2] + h1[3] * h1[3]; }
                    s2 += __shfl_xor(s2, 16); s2 += __shfl_xor(s2, 32);
                    if (fq == 0) ssn[(size_t)row * 16 + u.pn * 4 + wc] = s2; }
        }
    }
};
}

struct TileDesc { const float* src; const float* gain; bf16_t* dst; float base; };
__device__ __forceinline__ int dim_of(int code) { return code == 0 ? FF_ : (code == 1 ? D_ : (code == 2 ? INW : OUTW)); }
__device__ __forceinline__ TileDesc tile_desc(CP& p, int g, int tid) {
    constexpr int TPL = 5888;
    const int l = g / TPL, r = g % TPL;
    const int seg = (r >= 704) + (r >= 1408) + (r >= 2112) + (r >= 3008) + (r >= 3264) + (r >= 3776) + (r >= 4480) + (r >= 5184);
    const int start = seg < 3 ? seg * 704 : (seg == 3 ? 2112 : (seg == 4 ? 3008 : (seg == 5 ? 3264 : 3776 + (seg - 6) * 704)));
    const int sh = 4 * seg;
    const int in_idx = (int)((0xEDCA97543ull >> sh) & 15), gidx = (int)((0x0CC097033ull >> sh) & 15), mode = (int)((0x021000021ull >> sh) & 15);
    const int N = dim_of((int)((0x100112100ull >> sh) & 15)), K = dim_of((int)((0x011311011ull >> sh) & 15));
    const size_t wl = seg < 2 ? WL_GU1 : (seg == 2 ? WL_D1 : (seg == 3 ? WL_IN : (seg == 4 ? WL_KV : (seg == 5 ? WL_OUT : (seg < 8 ? WL_GU2 : WL_D2)))));
    const int rr = r - start, ntn = N >> 6, kt = rr / ntn, nt = rr - kt * ntn;
    const float* W = p.in[in_idx] + (size_t)l * K * N;
    TileDesc d;
    d.src = W + (size_t)(kt * 64 + (tid >> 3)) * N + nt * 64 + (tid & 7) * 8;
    d.gain = gidx ? p.in[gidx - 1] + l * D_ + kt * 64 + (tid >> 3) : nullptr;
    const int nn = nt * 64 + (tid >> 3); const int drow = mode == 0 ? nn : ((nn >> 7) * 256 + (mode == 2 ? 128 : 0) + (nn & 127));
    d.dst = (bf16_t*)(p.ws + WS_WB + (size_t)l * WL_LAYER + wl) + (size_t)drow * K + kt * 64 + 8 * (tid & 7);
    d.base = (seg == 2 || seg == 8) ? 0.5f : 1.0f;
    return d;
}
__device__ __forceinline__ void transpose_range(CP& p, lds_t L, int g0, int gend, int stride) {
    int tid_ = threadIdx.x; asm volatile("" : "+v"(tid_)); const int tid = tid_;
    int g = g0; asm volatile("" : "+s"(g));
    f32x4 a = (f32x4){0.f, 0.f, 0.f, 0.f}, b = a; float gn = 1.f; TileDesc cur; cur.dst = nullptr;
    __syncthreads();
    if (g < gend) { cur = tile_desc(p, g, tid); a = *(const f32x4*)cur.src; b = *(const f32x4*)(cur.src + 4); gn = cur.base * (cur.gain ? *cur.gain : 1.0f); }
    for (; g < gend; g += stride) {
        const int gnx = g + stride; TileDesc nxt; nxt.dst = nullptr; f32x4 na = a, nb = b; float ng = 1.f;
        if (gnx < gend) { nxt = tile_desc(p, gnx, tid); na = *(const f32x4*)nxt.src; nb = *(const f32x4*)(nxt.src + 4); ng = nxt.base * (nxt.gain ? *nxt.gain : 1.0f); }
        { const int r = tid >> 3, c8 = (tid & 7) * 8, o = (r * 65 + c8) * 4;
          lds_st<float>(L, o, a[0] * gn); lds_st<float>(L, o + 4, a[1] * gn); lds_st<float>(L, o + 8, a[2] * gn); lds_st<float>(L, o + 12, a[3] * gn);
          lds_st<float>(L, o + 16, b[0] * gn); lds_st<float>(L, o + 20, b[1] * gn); lds_st<float>(L, o + 24, b[2] * gn); lds_st<float>(L, o + 28, b[3] * gn); }
        __syncthreads();
        { const int n = tid >> 3, kc = tid & 7; float v[8];
#pragma unroll
          for (int j = 0; j < 8; ++j) v[j] = lds_ld<float>(L, ((8 * kc + j) * 65 + n) * 4);
          u32x4 w; w.x = cvt_pk_bf16(v[0], v[1]); w.y = cvt_pk_bf16(v[2], v[3]); w.z = cvt_pk_bf16(v[4], v[5]); w.w = cvt_pk_bf16(v[6], v[7]);
          *(u32x4*)cur.dst = w; }
        __syncthreads();
        cur = nxt; a = na; b = nb; gn = ng;
    }
}

__device__ __forceinline__ void phase_prologue(CP& p, lds_t L) {
    int tid_ = threadIdx.x; asm volatile("" : "+v"(tid_)); const int tid = tid_, lane = tid & 63, wid = tid >> 6;
    unsigned char* ws = p.ws;
    { bf16_t* HB = (bf16_t*)(ws + WS_HB); float* ss = (float*)(ws + WS_SS); bf16_t* MB = (bf16_t*)(ws + WS_MEMB); float* ssm = (float*)(ws + WS_SSM);
      for (int row = blockIdx.x * 8 + wid; row < T_ + MEMT; row += gridDim.x * 8) {
          const bool isx = row < T_; const int r = isx ? row : row - T_;
          const float* src = (isx ? p.in[0] : p.in[1]) + (size_t)r * D_; float s2 = 0.f;
#pragma unroll
          for (int i = 0; i < 4; ++i) { const int c = i * 256 + lane * 4; const f32x4 v = *(const f32x4*)(src + c);
              s2 += v[0] * v[0] + v[1] * v[1] + v[2] * v[2] + v[3] * v[3];
              u32x2 w; w.x = cvt_pk_bf16(v[0], v[1]); w.y = cvt_pk_bf16(v[2], v[3]);
              if (isx) { *(u32x2*)(HB + (size_t)r * D_ + c) = w; } else { *(u32x2*)(MB + (size_t)r * D_ + c) = w; } }
          s2 = wave_sum(s2);
          if (lane < 16) { const float v = lane == 0 ? s2 : 0.f; if (isx) ss[(size_t)r * 16 + lane] = v; else ssm[(size_t)r * 16 + lane] = v; } } }
    transpose_range(p, L, blockIdx.x, 5888, gridDim.x);
}

__device__ __forceinline__ void lru_item(CP& p, int jl, int item, lds_t L) {
    constexpr int WLo = 0, XCo = 38400, AAo = 89600, UUo = 114176, SEGo = 138752, CARo = 141824;
    int tid_ = threadIdx.x; asm volatile("" : "+v"(tid_)); const int tid = tid_, lane = tid & 63, wid = tid >> 6, fr = lane & 15, fq = lane >> 4;
    const int pair_ = (item & 7) * 8 + (item >> 5), b = pair_ >> 3, n = pair_ & 7, q4 = (item >> 3) & 3;
    bf16_t* U = (bf16_t*)(p.ws + WS_U);
    const float* w_r = p.in[17] + ((size_t)(jl * 8 + n) * 192) * 192; const float* w_i = p.in[19] + ((size_t)(jl * 8 + n) * 192) * 192;
    __syncthreads();
#pragma unroll 1
    for (int r3 = 0; r3 < 3; ++r3) {
        float v[12];
#pragma unroll
        for (int k = 0; k < 12; ++k) { const int idx = tid + NTHR * (12 * r3 + k), i = idx / 96, oo = idx % 96; v[k] = (oo < 48 ? w_r : w_i)[(size_t)i * 192 + 48 * q4 + (oo % 48)]; }
#pragma unroll
        for (int k = 0; k < 12; ++k) { const int idx = tid + NTHR * (12 * r3 + k), i = idx / 96, oo = idx % 96; lds_st<bf16_t>(L, WLo + oo * 400 + i * 2, (bf16_t)(cvt_pk_bf16(v[k], 0.f) & 0xffffu)); }
    }
    if (tid < 96) lds_st<float>(L, CARo + tid * 4, 0.f);
    float br[3], bi[3], sp[3];
#pragma unroll
    for (int t3 = 0; t3 < 3; ++t3) { const int c = jl * MIXW + n * 192 + 48 * q4 + 16 * t3 + fr; br[t3] = p.in[18][c]; bi[t3] = p.in[20][c]; sp[t3] = softplusf_(-p.in[21][c]); }
    const int cg = tid % 24, trow = tid / 24; float cw[4][8], cb[8];
    { const int c0 = jl * MIXW + n * 192 + 8 * cg;
#pragma unroll
      for (int j = 0; j < 4; ++j)
#pragma unroll
          for (int e = 0; e < 8; ++e) cw[j][e] = p.in[15][(size_t)jl * 4 * MIXW + (size_t)j * MIXW + n * 192 + 8 * cg + e];
#pragma unroll
      for (int e = 0; e < 8; ++e) cb[e] = p.in[16][c0 + e]; }
    for (int ck = 0; ck < 16; ++ck) {
        const int t0 = ck * 128;
        u32x4 gpre[2];
#pragma unroll
        for (int k = 0; k < 2; ++k) { const int e = tid + NTHR * k; if (e < 128 * 6) gpre[k] = *(const u32x4*)(U + (size_t)(b * SEQ_ + t0 + e / 6) * INW + MIXW + n * 192 + 48 * q4 + 8 * (e % 6)); }
        if (tid < 384) {
            u32x4 raw[11];
#pragma unroll
            for (int j = 0; j < 11; ++j) { const int tt = t0 + trow * 8 - 3 + j;
                raw[j] = tt >= 0 ? *(const u32x4*)(U + (size_t)(b * SEQ_ + tt) * INW + n * 192 + 8 * cg) : (u32x4){0u, 0u, 0u, 0u}; }
#pragma unroll
            for (int it = 0; it < 8; ++it) { const int t = trow * 8 + it; float acc[8];
#pragma unroll
                for (int e = 0; e < 8; ++e) acc[e] = cb[e];
#pragma unroll
                for (int j = 0; j < 4; ++j) { const u32x4 rw = raw[it + j];
                    acc[0] += cw[j][0] * bflo(rw.x); acc[1] += cw[j][1] * bfhi(rw.x); acc[2] += cw[j][2] * bflo(rw.y); acc[3] += cw[j][3] * bfhi(rw.y);
                    acc[4] += cw[j][4] * bflo(rw.z); acc[5] += cw[j][5] * bfhi(rw.z); acc[6] += cw[j][6] * bflo(rw.w); acc[7] += cw[j][7] * bfhi(rw.w); }
                u32x4 w; w.x = cvt_pk_bf16(acc[0], acc[1]); w.y = cvt_pk_bf16(acc[2], acc[3]); w.z = cvt_pk_bf16(acc[4], acc[5]); w.w = cvt_pk_bf16(acc[6], acc[7]);
                lds_st<u32x4>(L, XCo + t * 400 + cg * 16, w); }
        }
        __syncthreads();
        {
            f32x4 acc[6];
#pragma unroll
            for (int i = 0; i < 6; ++i) acc[i] = (f32x4){0.f, 0.f, 0.f, 0.f};
#pragma unroll
            for (int ks = 0; ks < 6; ++ks) { const bf16x8 a = lds_ld<bf16x8>(L, XCo + (16 * wid + fr) * 400 + (32 * ks + 8 * fq) * 2);
#pragma unroll
                for (int nt = 0; nt < 6; ++nt) { const bf16x8 bb = lds_ld<bf16x8>(L, WLo + (16 * nt + fr) * 400 + (32 * ks + 8 * fq) * 2); acc[nt] = MFMA16(a, bb, acc[nt]); } }
#pragma unroll
            for (int t3 = 0; t3 < 3; ++t3) { const int oc = 16 * t3 + fr;
#pragma unroll
                for (int rg = 0; rg < 4; ++rg) { const int t = 16 * wid + 4 * fq + rg;
                    const float r = sigmoidf_(acc[t3][rg] + br[t3]), gi = sigmoidf_(acc[t3 + 3][rg] + bi[t3]);
                    const float la = -8.0f * r * sp[t3], a = __expf(la), mult = __builtin_amdgcn_sqrtf(fmaxf(1.0f - a * a, 0.f));
                    const float xc = bf2f(lds_ld<bf16_t>(L, XCo + t * 400 + (48 * q4 + oc) * 2));
                    lds_st<float>(L, AAo + (t * 48 + oc) * 4, a); lds_st<float>(L, UUo + (t * 48 + oc) * 4, mult * gi * xc); } }
        }
        __syncthreads();
        const int ch = tid % 48, sg = tid / 48;
        if (tid < 384) { float A = 1.f, Hh = 0.f;
#pragma unroll
            for (int i = 0; i < 16; ++i) { const int t = 16 * sg + i; const float a = lds_ld<float>(L, AAo + (t * 48 + ch) * 4), uu = lds_ld<float>(L, UUo + (t * 48 + ch) * 4); Hh = a * Hh + uu; A *= a; }
            lds_st<float>(L, SEGo + (sg * 48 + ch) * 4, A); lds_st<float>(L, SEGo + 1536 + (sg * 48 + ch) * 4, Hh); }
        __syncthreads();
        if (tid < 384) { float h = lds_ld<float>(L, CARo + ((ck & 1) * 48 + ch) * 4);
            for (int s2 = 0; s2 < sg; ++s2) h = lds_ld<float>(L, SEGo + (s2 * 48 + ch) * 4) * h + lds_ld<float>(L, SEGo + 1536 + (s2 * 48 + ch) * 4);
#pragma unroll
            for (int i = 0; i < 16; ++i) { const int t = 16 * sg + i; const float a = lds_ld<float>(L, AAo + (t * 48 + ch) * 4), uu = lds_ld<float>(L, UUo + (t * 48 + ch) * 4); h = a * h + uu; lds_st<float>(L, UUo + (t * 48 + ch) * 4, h); }
            if (sg == 7) lds_st<float>(L, CARo + (((ck + 1) & 1) * 48 + ch) * 4, h); }
        __syncthreads();
#pragma unroll
        for (int k = 0; k < 2; ++k) { const int e = tid + NTHR * k;
            if (e < 128 * 6) { const int t = e / 6, c8 = e % 6;
                const f32x4 h0 = lds_ld<f32x4>(L, UUo + (t * 48 + 8 * c8) * 4), h1 = lds_ld<f32x4>(L, UUo + (t * 48 + 8 * c8 + 4) * 4);
                bf16_t* gp = U + (size_t)(b * SEQ_ + t0 + t) * INW + MIXW + n * 192 + 48 * q4 + 8 * c8; const u32x4 g = gpre[k];
                u32x4 w; w.x = cvt_pk_bf16(h0[0] * gelu_tanh_(bflo(g.x)), h0[1] * gelu_tanh_(bfhi(g.x))); w.y = cvt_pk_bf16(h0[2] * gelu_tanh_(bflo(g.y)), h0[3] * gelu_tanh_(bfhi(g.y)));
                w.z = cvt_pk_bf16(h1[0] * gelu_tanh_(bflo(g.z)), h1[1] * gelu_tanh_(bfhi(g.z))); w.w = cvt_pk_bf16(h1[2] * gelu_tanh_(bflo(g.w)), h1[3] * gelu_tanh_(bfhi(g.w)));
                st16_sc1(gp, w); } }
    }
}

__device__ __forceinline__ void xattn_item(CP& p, int item, lds_t L) {
    constexpr int KMo = 0, VMo = 69632;
    int tid_ = threadIdx.x; asm volatile("" : "+v"(tid_)); const int tid = tid_, lane = tid & 63, wid = tid >> 6, fr = lane & 15, fq = lane >> 4;
    const int slotx_ = item >> 3, pairx_ = (item & 7) * 4 + (slotx_ >> 4), b = pairx_ >> 2, hx = pairx_ & 3, qt = slotx_ & 15;
    bf16_t* U = (bf16_t*)(p.ws + WS_U); const bf16_t* KV = (const bf16_t*)(p.ws + WS_KVM);
    __syncthreads();
    for (int e = tid; e < 4096; e += NTHR) { const int key = e >> 4, ch = e & 15; const bf16_t* src = KV + (size_t)(b * 256 + key) * 1024 + hx * 128 + ch * 8;
        lds_st<u32x4>(L, KMo + key * 272 + ch * 16, *(const u32x4*)src); lds_st<u32x4>(L, VMo + key * 288 + ch * 16, *(const u32x4*)(src + 512)); }
    bf16_t* qrow = U + (size_t)(b * SEQ_ + qt * 128 + 16 * wid + fr) * INW + 2 * MIXW + hx * 128;
    bf16x8 Bq[4];
#pragma unroll
    for (int ks = 0; ks < 4; ++ks) Bq[ks] = *(const bf16x8*)(qrow + 32 * ks + 8 * fq);
    __syncthreads();
    f32x4 S[16];
#pragma unroll
    for (int kt = 0; kt < 16; ++kt) { f32x4 a = (f32x4){0.f, 0.f, 0.f, 0.f};
#pragma unroll
        for (int ks = 0; ks < 4; ++ks) a = MFMA16(lds_ld<bf16x8>(L, KMo + (16 * kt + fr) * 272 + (32 * ks + 8 * fq) * 2), Bq[ks], a);
        S[kt] = a; }
    float mx = -3.0e38f;
#pragma unroll
    for (int kt = 0; kt < 16; ++kt)
#pragma unroll
        for (int j = 0; j < 4; ++j) mx = fmaxf(mx, S[kt][j]);
    mx = fmaxf(mx, __shfl_xor(mx, 16)); mx = fmaxf(mx, __shfl_xor(mx, 32));
    const float sc = 0.08838834764831845f; float lsum = 0.f;
#pragma unroll
    for (int kt = 0; kt < 16; ++kt)
#pragma unroll
        for (int j = 0; j < 4; ++j) { const float e = __expf((S[kt][j] - mx) * sc); S[kt][j] = e; lsum += e; }
    lsum += __shfl_xor(lsum, 16); lsum += __shfl_xor(lsum, 32);
    f32x4 O[8];
#pragma unroll
    for (int dt = 0; dt < 8; ++dt) O[dt] = (f32x4){0.f, 0.f, 0.f, 0.f};
#pragma unroll
    for (int i = 0; i < 8; ++i) { const bf16x8 bp = pack8(S[2 * i], S[2 * i + 1]);
#pragma unroll
        for (int dt = 0; dt < 8; ++dt) { const int o0 = VMo + (32 * i + 4 * fq + (fr >> 2)) * 288 + (16 * dt + 4 * (fr & 3)) * 2;
#ifdef DBG_NOTR
            u32x4 af;
            { unsigned e[8];
#pragma unroll
              for (int j = 0; j < 8; ++j) { const int key = 32 * i + (j < 4 ? 4 * fq + j : 16 + 4 * fq + (j - 4)); e[j] = lds_ld<bf16_t>(L, VMo + key * 288 + (16 * dt + fr) * 2); }
              af.x = e[0] | (e[1] << 16); af.y = e[2] | (e[3] << 16); af.z = e[4] | (e[5] << 16); af.w = e[6] | (e[7] << 16); }
            (void)o0; O[dt] = MFMA16(__builtin_bit_cast(bf16x8, af), bp, O[dt]); } }
#else
            O[dt] = MFMA16(tr_pair(L, o0, o0 + 16 * 288), bp, O[dt]); } }
#endif
    float inv = frcp_(lsum);
#ifdef DBG_IDENT
    { const u32x4 q0 = __builtin_bit_cast(u32x4, Bq[0]);
#pragma unroll
      for (int dt = 0; dt < 8; ++dt) { O[dt][0] = bflo(q0.x) + dt; O[dt][1] = bfhi(q0.x); O[dt][2] = bflo(q0.y); O[dt][3] = bfhi(q0.y); } inv = 1.0f; }
#endif
#pragma unroll
    for (int dt = 0; dt < 8; ++dt) { u32x2 w; w.x = cvt_pk_bf16(O[dt][0] * inv, O[dt][1] * inv); w.y = cvt_pk_bf16(O[dt][2] * inv, O[dt][3] * inv);
        *(u32x2*)(qrow + 16 * dt + 4 * fq) = w; }
}

__device__ __forceinline__ void ml1_item(CP& p, int jl, int item, lds_t L) {
    int tid_ = threadIdx.x; asm volatile("" : "+v"(tid_)); const int tid = tid_, lane = tid & 63, wid = tid >> 6;
    const bf16_t* U = (const bf16_t*)(p.ws + WS_U); bf16_t* XC = (bf16_t*)(p.ws + WS_XC); float* G = (float*)(p.ws + WS_G);
    const int j = tid < 384 ? tid : 0;
    float cw[4][4], cb[4], Wx[4][8], Wm[4][8];
    {
#pragma unroll
        for (int k = 0; k < 4; ++k)
#pragma unroll
            for (int c = 0; c < 4; ++c) cw[k][c] = p.in[22][(size_t)jl * 4 * MIXW + (size_t)k * MIXW + 4 * j + c];
#pragma unroll
        for (int c = 0; c < 4; ++c) cb[c] = p.in[23][jl * MIXW + 4 * j + c];
        const float* wq = p.in[24] + ((size_t)jl * 384 + j) * 16; const float* wk = p.in[25] + ((size_t)jl * 384 + j) * 16; const float* wv = p.in[26] + ((size_t)jl * 384 + j) * 16;
        const float* Wg = p.in[27] + (size_t)jl * 4608 * 8;
#pragma unroll
        for (int i = 0; i < 4; ++i)
#pragma unroll
            for (int g = 0; g < 8; ++g) { Wx[i][g] = 0.f; Wm[i][g] = 0.f; }
#pragma unroll 1
        for (int o = 0; o < 4; ++o) {
            float gq[8], gk[8], gv[8];
#pragma unroll
            for (int g = 0; g < 8; ++g) { gq[g] = Wg[(size_t)(4 * j + o) * 8 + g]; gk[g] = Wg[(size_t)(MIXW + 4 * j + o) * 8 + g]; gv[g] = Wg[(size_t)(2 * MIXW + 4 * j + o) * 8 + g]; }
#pragma unroll
            for (int i = 0; i < 4; ++i) { const float a = wq[i * 4 + o], bk = wk[i * 4 + o], cv = wv[i * 4 + o];
#pragma unroll
                for (int g = 0; g < 8; ++g) { Wx[i][g] += a * gq[g] + bk * gk[g]; Wm[i][g] += cv * gv[g]; } } }
    }
    const int r0 = item * 64, tm0 = r0 % SEQ_;
    float x3[4], x2[4], x1[4], x0[4];
    auto ldx = [&](int row, float* x) { const u32x2 raw = *(const u32x2*)(U + (size_t)row * INW + 4 * j); x[0] = bflo(raw.x); x[1] = bfhi(raw.x); x[2] = bflo(raw.y); x[3] = bfhi(raw.y); };
#pragma unroll
    for (int c = 0; c < 4; ++c) { x3[c] = 0.f; x2[c] = 0.f; x1[c] = 0.f; }
    if (tm0 > 0) { ldx(r0 - 3, x3); ldx(r0 - 2, x2); ldx(r0 - 1, x1); }
    for (int tb = 0; tb < 8; ++tb) {
        __syncthreads();
        if (tid < 384) {
            u32x2 xraw[8];
#pragma unroll
            for (int tt = 0; tt < 8; ++tt) xraw[tt] = *(const u32x2*)(U + (size_t)(r0 + tb * 8 + tt) * INW + 4 * j);
#pragma unroll
            for (int tt = 0; tt < 8; ++tt) { const int row = r0 + tb * 8 + tt; x0[0] = bflo(xraw[tt].x); x0[1] = bfhi(xraw[tt].x); x0[2] = bflo(xraw[tt].y); x0[3] = bfhi(xraw[tt].y); float xc[4];
#pragma unroll
                for (int c = 0; c < 4; ++c) xc[c] = siluf_(cb[c] + cw[0][c] * x3[c] + cw[1][c] * x2[c] + cw[2][c] * x1[c] + cw[3][c] * x0[c]);
                u32x2 w; w.x = cvt_pk_bf16(xc[0], xc[1]); w.y = cvt_pk_bf16(xc[2], xc[3]); *(u32x2*)(XC + (size_t)row * MIXW + 4 * j) = w;
#pragma unroll
                for (int g = 0; g < 8; ++g) { float s = 0.f;
#pragma unroll
                    for (int i = 0; i < 4; ++i) s += xc[i] * Wx[i][g] + x0[i] * Wm[i][g];
                    lds_st<float>(L, ((tt * 8 + g) * 388 + tid) * 4, s); }
#pragma unroll
                for (int c = 0; c < 4; ++c) { x3[c] = x2[c]; x2[c] = x1[c]; x1[c] = x0[c]; } }
        }
        __syncthreads();
        {
            const int row = tid >> 3, part = tid & 7; float s = 0.f;
#pragma unroll
            for (int i = 0; i < 12; ++i) { const f32x4 v = lds_ld<f32x4>(L, (row * 388 + part * 48 + 4 * i) * 4); s += (v[0] + v[1]) + (v[2] + v[3]); }
            s += __shfl_xor(s, 1); s += __shfl_xor(s, 2); s += __shfl_xor(s, 4);
            if (part == 0) { const int g = row & 7; const float v = s + p.in[28][jl * 8 + g]; G[(size_t)(r0 + tb * 8 + (row >> 3)) * 8 + g] = g < 4 ? v : -softplusf_(-v); }
        }
    }
}

__device__ __forceinline__ void ml2_item(CP& p, int jl, int item, lds_t L) {
    constexpr int QIo = 0, KIo = 50176, VIo = 100352, PTo = 109568, WQKo = 118784, WVo = 131072, SCo = 132096, NSo = 134144, OXo = 0;
    constexpr int IBo = SCo, MTo = SCo + 256, WIo = SCo + 512, EMo = SCo + 768, WSo = SCo + 1024, DNo = SCo + 1280, NQo = SCo + 1536, MIo = SCo + 1792;
    int tid_ = threadIdx.x; asm volatile("" : "+v"(tid_)); const int tid = tid_, lane = tid & 63, wid = tid >> 6, fr = lane & 15, fq = lane >> 4;
    const int slot_ = item >> 3, pair_ = (item & 7) * 4 + slot_ / 6, b = pair_ >> 2, hh = pair_ & 3, vb = slot_ % 6;
    const int vt = wid & 3, kh = wid >> 2;
    const bf16_t* U = (const bf16_t*)(p.ws + WS_U); const bf16_t* XC = (const bf16_t*)(p.ws + WS_XC); const float* G = (const float*)(p.ws + WS_G); bf16_t* HO = (bf16_t*)(p.ws + WS_HOUT);
    __syncthreads();
    for (int idx = tid; idx < 3072; idx += NTHR) { const int jb = idx >> 5, e = idx & 31; const size_t bo = ((size_t)jl * 384 + hh * 96 + jb) * 16;
        lds_st<float>(L, WQKo + idx * 4, e < 16 ? p.in[24][bo + e] : p.in[25][bo + e - 16]); }
    if (tid < 256) lds_st<float>(L, WVo + tid * 4, p.in[26][((size_t)jl * 384 + hh * 96 + vb * 16 + (tid >> 4)) * 16 + (tid & 15)]);
    if (tid < 384) lds_st<float>(L, NSo + tid * 4, 0.f);
    f32x4 CT[12];
#pragma unroll
    for (int i = 0; i < 12; ++i) CT[i] = (f32x4){0.f, 0.f, 0.f, 0.f};
    float m_cur = 0.f;
    const int cg = tid % 48, rg = (tid / 48) & 7;
    u32x4 pre[4]; float pli = 0.f, plf = 0.f;
    if (tid < 384) {
#pragma unroll
        for (int it = 0; it < 4; ++it) pre[it] = *(const u32x4*)(XC + (size_t)(b * SEQ_ + rg * 8 + it) * MIXW + hh * 384 + 8 * cg);
    }
    if (wid == 0) { pli = G[(size_t)(b * SEQ_ + lane) * 8 + hh]; plf = G[(size_t)(b * SEQ_ + lane) * 8 + 4 + hh]; }
    for (int c = 0; c < 32; ++c) {
        const int r0 = b * SEQ_ + 64 * c;
        __syncthreads();
        if (wid == 0) {
            const float li = pli, lf = plf;
            float bc = lf;
#pragma unroll
            for (int d = 1; d < 64; d <<= 1) { const float v = __shfl_up(bc, d); if (lane >= d) bc += v; }
            const float ib = li - bc; float pm = ib;
#pragma unroll
            for (int d = 1; d < 64; d <<= 1) { const float v = __shfl_up(pm, d); if (lane >= d) pm = fmaxf(pm, v); }
            const float Mt = fmaxf(m_cur, pm), M63 = __shfl(Mt, 63), bl = __shfl(bc, 63);
            lds_st<float>(L, IBo + lane * 4, ib); lds_st<float>(L, MTo + lane * 4, Mt); lds_st<float>(L, WIo + lane * 4, __expf(m_cur - Mt)); lds_st<float>(L, EMo + lane * 4, __expf(-(bc + Mt)));
            lds_st<float>(L, WSo + lane * 4, __expf(ib - M63)); lds_st<float>(L, DNo + lane * 4, 0.f);
            if (lane == 0) { lds_st<float>(L, MIo, __expf(m_cur - M63)); lds_st<float>(L, MIo + 4, bl + M63); }
        }
        if (tid < 384) {
            u32x4 late[4];
#pragma unroll
            for (int it = 0; it < 4; ++it) late[it] = *(const u32x4*)(XC + (size_t)(r0 + rg * 8 + 4 + it) * MIXW + hh * 384 + 8 * cg);
#pragma unroll
            for (int bk = 0; bk < 2; ++bk) {
                f32x4 wqv[4], wkv[4];
#pragma unroll
                for (int i = 0; i < 4; ++i) { wqv[i] = lds_ld<f32x4>(L, WQKo + (2 * cg + bk) * 128 + i * 16); wkv[i] = lds_ld<f32x4>(L, WQKo + (2 * cg + bk) * 128 + 64 + i * 16); }
#pragma unroll
                for (int it = 0; it < 8; ++it) { const int t = rg * 8 + it; const u32x4 raw = it < 4 ? pre[it] : late[it - 4];
                    const unsigned w0 = bk ? raw.z : raw.x, w1 = bk ? raw.w : raw.y;
                    const float x0 = bflo(w0), x1 = bfhi(w0), x2 = bflo(w1), x3 = bfhi(w1);
                    const f32x4 aq = wqv[0] * x0 + wqv[1] * x1 + wqv[2] * x2 + wqv[3] * x3;
                    const f32x4 ak = (wkv[0] * x0 + wkv[1] * x1 + wkv[2] * x2 + wkv[3] * x3) * 0.05103103630798288f;
                    u32x2 qw, kw; qw.x = cvt_pk_bf16(aq[0], aq[1]); qw.y = cvt_pk_bf16(aq[2], aq[3]); kw.x = cvt_pk_bf16(ak[0], ak[1]); kw.y = cvt_pk_bf16(ak[2], ak[3]);
                    lds_st<u32x2>(L, QIo + t * 784 + cg * 16 + bk * 8, qw); lds_st<u32x2>(L, KIo + t * 784 + cg * 16 + bk * 8, kw);
                    if ((it & 1) == 1) __builtin_amdgcn_sched_barrier(0); }
            }
        } else {
#pragma unroll 4
            for (int it = 0; it < 8; ++it) { const int e = (tid - 384) + 128 * it, t = e >> 4, jb = e & 15;
                const u32x2 raw = *(const u32x2*)(U + (size_t)(r0 + t) * INW + hh * 384 + vb * 64 + 4 * jb);
                const float x[4] = {bflo(raw.x), bfhi(raw.x), bflo(raw.y), bfhi(raw.y)};
                f32x4 av = lds_ld<f32x4>(L, WVo + jb * 64) * x[0];
#pragma unroll
                for (int i = 1; i < 4; ++i) av = av + lds_ld<f32x4>(L, WVo + jb * 64 + i * 16) * x[i];
                u32x2 w; w.x = cvt_pk_bf16(av[0], av[1]); w.y = cvt_pk_bf16(av[2], av[3]); lds_st<u32x2>(L, VIo + t * 144 + jb * 8, w); }
        }
        __syncthreads();
        const float decay = lds_ld<float>(L, MIo), m_new = lds_ld<float>(L, MIo + 4);
        {
            const int tt = wid & 3, hf = wid >> 2;
            f32x4 s0 = (f32x4){0.f, 0.f, 0.f, 0.f}, s1 = s0;
            const bool do0 = (2 * hf) <= tt, do1 = (2 * hf + 1) <= tt;
            if (do0) {
#pragma unroll
                for (int ks = 0; ks < 12; ++ks) { const bf16x8 bq = lds_ld<bf16x8>(L, QIo + (16 * tt + fr) * 784 + (32 * ks + 8 * fq) * 2);
                    s0 = MFMA16(lds_ld<bf16x8>(L, KIo + (32 * hf + fr) * 784 + (32 * ks + 8 * fq) * 2), bq, s0);
                    if (do1) s1 = MFMA16(lds_ld<bf16x8>(L, KIo + (32 * hf + 16 + fr) * 784 + (32 * ks + 8 * fq) * 2), bq, s1);
                    if ((ks & 3) == 3) __builtin_amdgcn_sched_barrier(0); } }
            const int t = 16 * tt + fr; const float Mt = lds_ld<float>(L, MTo + t * 4); float psum = 0.f;
#pragma unroll
            for (int sti = 0; sti < 2; ++sti) { const int sb = 32 * hf + 16 * sti + 4 * fq; const f32x4 ibv = lds_ld<f32x4>(L, IBo + sb * 4); f32x4 sv = sti ? s1 : s0; float pv[4];
#pragma unroll
                for (int rg = 0; rg < 4; ++rg) { const int s = sb + rg; pv[rg] = (s <= t) ? sv[rg] * __expf(ibv[rg] - Mt) : 0.f; psum += pv[rg]; }
                u32x2 w; w.x = cvt_pk_bf16(pv[0], pv[1]); w.y = cvt_pk_bf16(pv[2], pv[3]); lds_st<u32x2>(L, PTo + t * 144 + sb * 2, w); }
            psum += __shfl_xor(psum, 16); psum += __shfl_xor(psum, 32);
            if (fq == 0) __hip_atomic_fetch_add((LAS float*)(L + DNo + t * 4), psum, __ATOMIC_RELAXED, __HIP_MEMORY_SCOPE_WORKGROUP);
        }
        f32x4 ao[4];
#pragma unroll
        for (int i = 0; i < 4; ++i) ao[i] = (f32x4){0.f, 0.f, 0.f, 0.f};
#pragma unroll
        for (int i = 0; i < 6; ++i) { const bf16x8 af = pack8(CT[2 * i], CT[2 * i + 1]);
#pragma unroll
            for (int t2 = 0; t2 < 4; ++t2) { const int qo = QIo + (16 * t2 + fr) * 784 + (192 * kh + 32 * i + 4 * fq) * 2;
                const s16x4 lo = lds_ld<s16x4>(L, qo), hi = lds_ld<s16x4>(L, qo + 32);
                ao[t2] = MFMA16(af, __builtin_shufflevector(lo, hi, 0, 1, 2, 3, 4, 5, 6, 7), ao[t2]); }
            __builtin_amdgcn_sched_barrier(0); }
#pragma unroll
        for (int t2 = 0; t2 < 4; ++t2) { const float wi = lds_ld<float>(L, WIo + (16 * t2 + fr) * 4); ao[t2] = ao[t2] * wi; }
        {
            const int t = tid >> 3, part = tid & 7; float s = 0.f;
#pragma unroll
            for (int i = 0; i < 6; ++i) { const u32x4 raw = lds_ld<u32x4>(L, QIo + t * 784 + part * 96 + i * 16);
                const f32x4 n0 = lds_ld<f32x4>(L, NSo + (part * 48 + i * 8) * 4), n1 = lds_ld<f32x4>(L, NSo + (part * 48 + i * 8 + 4) * 4);
                s += bflo(raw.x) * n0[0] + bfhi(raw.x) * n0[1] + bflo(raw.y) * n0[2] + bfhi(raw.y) * n0[3] + bflo(raw.z) * n1[0] + bfhi(raw.z) * n1[1] + bflo(raw.w) * n1[2] + bfhi(raw.w) * n1[3]; }
            s += __shfl_xor(s, 1); s += __shfl_xor(s, 2); s += __shfl_xor(s, 4);
            if (part == 0) lds_st<float>(L, NQo + t * 4, s);
        }
        __syncthreads();
        if (c + 1 < 32) {
            if (tid < 384) {
#pragma unroll
                for (int it = 0; it < 4; ++it) pre[it] = *(const u32x4*)(XC + (size_t)(r0 + 64 + rg * 8 + it) * MIXW + hh * 384 + 8 * cg);
            }
            if (wid == 0) { pli = G[(size_t)(r0 + 64 + lane) * 8 + hh]; plf = G[(size_t)(r0 + 64 + lane) * 8 + 4 + hh]; }
        }
        {
            const int o0 = VIo + (32 * kh + 8 * fq + (fr >> 2)) * 144 + (16 * vt + 4 * (fr & 3)) * 2;
            const bf16x8 av = tr_pair(L, o0, o0 + 4 * 144);
#pragma unroll
            for (int t2 = 0; t2 < 4; ++t2) ao[t2] = MFMA16(av, lds_ld<bf16x8>(L, PTo + (16 * t2 + fr) * 144 + (32 * kh + 8 * fq) * 2), ao[t2]);
        }
        if (kh == 1) {
#pragma unroll
            for (int t2 = 0; t2 < 4; ++t2)
#pragma unroll
                for (int rg = 0; rg < 4; ++rg) lds_st<float>(L, OXo + ((vt * 16 + 4 * fq + rg) * 64 + 16 * t2 + fr) * 4, ao[t2][rg]);
        }
        {
            bf16x8 bv[2];
#pragma unroll
            for (int ks = 0; ks < 2; ++ks) { const int o0 = VIo + (32 * ks + 8 * fq + (fr >> 2)) * 144 + (16 * vt + 4 * (fr & 3)) * 2;
                const bf16x8 raw = tr_pair(L, o0, o0 + 4 * 144); const u32x4 rw = __builtin_bit_cast(u32x4, raw);
                const f32x4 w0 = lds_ld<f32x4>(L, WSo + (32 * ks + 8 * fq) * 4), w1 = lds_ld<f32x4>(L, WSo + (32 * ks + 8 * fq + 4) * 4);
                u32x4 o; o.x = cvt_pk_bf16(bflo(rw.x) * w0[0], bfhi(rw.x) * w0[1]); o.y = cvt_pk_bf16(bflo(rw.y) * w0[2], bfhi(rw.y) * w0[3]);
                o.z = cvt_pk_bf16(bflo(rw.z) * w1[0], bfhi(rw.z) * w1[1]); o.w = cvt_pk_bf16(bflo(rw.w) * w1[2], bfhi(rw.w) * w1[3]);
                bv[ks] = __builtin_bit_cast(bf16x8, o); }
#pragma unroll
            for (int kt = 0; kt < 12; ++kt) { f32x4 a = CT[kt] * decay;
#pragma unroll
                for (int ks = 0; ks < 2; ++ks) { const int o0 = KIo + (32 * ks + 8 * fq + (fr >> 2)) * 784 + (192 * kh + 16 * kt + 4 * (fr & 3)) * 2;
                    a = MFMA16(tr_pair(L, o0, o0 + 4 * 784), bv[ks], a); }
                CT[kt] = a; if ((kt & 1) == 1) __builtin_amdgcn_sched_barrier(0); }
        }
        if (tid < 192) { float n0 = decay * lds_ld<float>(L, NSo + tid * 8), n1 = decay * lds_ld<float>(L, NSo + tid * 8 + 4);
#pragma unroll 4
            for (int s4 = 0; s4 < 16; ++s4) { const f32x4 w4 = lds_ld<f32x4>(L, WSo + s4 * 16);
#pragma unroll
                for (int j = 0; j < 4; ++j) { const unsigned kk = lds_ld<unsigned>(L, KIo + (4 * s4 + j) * 784 + tid * 4); n0 += w4[j] * bflo(kk); n1 += w4[j] * bfhi(kk); } }
            lds_st<float>(L, NSo + tid * 8, n0); lds_st<float>(L, NSo + tid * 8 + 4, n1); }
        __syncthreads();
        if (kh == 0) {
#pragma unroll
            for (int t2 = 0; t2 < 4; ++t2) { const int t = 16 * t2 + fr;
                const float dn = fmaxf(fabsf(lds_ld<float>(L, DNo + t * 4) + lds_ld<float>(L, WIo + t * 4) * lds_ld<float>(L, NQo + t * 4)), lds_ld<float>(L, EMo + t * 4));
                const float inv = frcp_(dn); float hv[4];
#pragma unroll
                for (int rg = 0; rg < 4; ++rg) hv[rg] = (ao[t2][rg] + lds_ld<float>(L, OXo + ((vt * 16 + 4 * fq + rg) * 64 + t) * 4)) * inv;
                u32x2 w; w.x = cvt_pk_bf16(hv[0], hv[1]); w.y = cvt_pk_bf16(hv[2], hv[3]);
                *(u32x2*)(HO + (size_t)(r0 + t) * MIXW + hh * 384 + vb * 64 + 16 * vt + 4 * fq) = w; }
        }
        m_cur = m_new;
    }
}

__device__ __forceinline__ void phase_ml3(CP& p, int jl) {
    int tid_ = threadIdx.x; asm volatile("" : "+v"(tid_)); const int tid = tid_, lane = tid & 63, wid = tid >> 6;
    bf16_t* U = (bf16_t*)(p.ws + WS_U); const bf16_t* XC = (const bf16_t*)(p.ws + WS_XC); const bf16_t* HO = (const bf16_t*)(p.ws + WS_HOUT);
    const int gw = blockIdx.x * 8 + wid, nw = gridDim.x * 8, hh = gw & 3;
    float lg[6], sk[6];
#pragma unroll
    for (int i = 0; i < 3; ++i) { const int c = jl * MIXW + hh * 384 + 128 * i + 2 * lane; lg[2 * i] = p.in[29][c]; lg[2 * i + 1] = p.in[29][c + 1]; sk[2 * i] = p.in[30][c]; sk[2 * i + 1] = p.in[30][c + 1]; }
    for (int rb = (gw >> 2) * 4; rb < T_; rb += (nw >> 2) * 4) {
        unsigned hr[4][3], xr[4][3], gr[4][3];
#pragma unroll
        for (int r = 0; r < 4; ++r)
#pragma unroll
            for (int i = 0; i < 3; ++i) { const int c = hh * 384 + 128 * i + 2 * lane; const size_t row = (size_t)(rb + r);
                hr[r][i] = *(const unsigned*)(HO + row * MIXW + c); xr[r][i] = *(const unsigned*)(XC + row * MIXW + c); gr[r][i] = *(const unsigned*)(U + row * INW + MIXW + c); }
#pragma unroll
        for (int r = 0; r < 4; ++r) { float h[6]; float s = 0.f;
#pragma unroll
            for (int i = 0; i < 3; ++i) { h[2 * i] = bflo(hr[r][i]); h[2 * i + 1] = bfhi(hr[r][i]); s += h[2 * i] + h[2 * i + 1]; }
            const float mu = wave_sum(s) * (1.0f / 384.0f); float v2 = 0.f;
#pragma unroll
            for (int i = 0; i < 6; ++i) { h[i] -= mu; v2 += h[i] * h[i]; }
            const float rstd = rsqrtf(wave_sum(v2) * (1.0f / 384.0f) + EPS_);
#pragma unroll
            for (int i = 0; i < 3; ++i) { const int c = hh * 384 + 128 * i + 2 * lane;
                const float y0 = (h[2 * i] * rstd * lg[2 * i] + sk[2 * i] * bflo(xr[r][i])) * siluf_(bflo(gr[r][i]));
                const float y1 = (h[2 * i + 1] * rstd * lg[2 * i + 1] + sk[2 * i + 1] * bfhi(xr[r][i])) * siluf_(bfhi(gr[r][i]));
                *(unsigned*)(U + (size_t)(rb + r) * INW + MIXW + c) = cvt_pk_bf16(y0, y1); } }
    }
}

__device__ __forceinline__ void phase_final(CP& p) {
    int tid_ = threadIdx.x; asm volatile("" : "+v"(tid_)); const int tid = tid_, lane = tid & 63, wid = tid >> 6; float* out = p.out; const float* g = p.in[31]; const bf16_t* HB = (const bf16_t*)(p.ws + WS_HB);
    for (int row = blockIdx.x * 8 + wid; row < T_; row += gridDim.x * 8) { float v[16]; float s2 = 0.f;
#pragma unroll
        for (int i = 0; i < 2; ++i) { const u32x4 hw = *(const u32x4*)(HB + (size_t)row * D_ + i * 512 + lane * 8);
            v[8 * i + 0] = bflo(hw.x); v[8 * i + 1] = bfhi(hw.x); v[8 * i + 2] = bflo(hw.y); v[8 * i + 3] = bfhi(hw.y); v[8 * i + 4] = bflo(hw.z); v[8 * i + 5] = bfhi(hw.z); v[8 * i + 6] = bflo(hw.w); v[8 * i + 7] = bfhi(hw.w); }
#pragma unroll
        for (int i = 0; i < 16; ++i) s2 += v[i] * v[i];
        const float rs = rsqrtf(wave_sum(s2) * (1.0f / 1024.0f) + EPS_);
#pragma unroll
        for (int i = 0; i < 2; ++i) { const int c = i * 512 + lane * 8; const f32x4 g0 = *(const f32x4*)(g + c), g1 = *(const f32x4*)(g + c + 4);
            *(f32x4*)(out + (size_t)row * D_ + c) = (f32x4){v[8 * i] * rs * g0[0], v[8 * i + 1] * rs * g0[1], v[8 * i + 2] * rs * g0[2], v[8 * i + 3] * rs * g0[3]};
            *(f32x4*)(out + (size_t)row * D_ + c + 4) = (f32x4){v[8 * i + 4] * rs * g1[0], v[8 * i + 5] * rs * g1[1], v[8 * i + 6] * rs * g1[2], v[8 * i + 7] * rs * g1[3]}; } }
}

constexpr int MK_PRO = 1, MK_GEMM = 2, MK_LRU = 4, MK_XA = 8, MK_ML1 = 16, MK_ML2 = 32, MK_ML3 = 64, MK_FIN = 128, MK_ALL = 255;
template <int MASK>
__global__ void __launch_bounds__(NTHR, 2) mega(P p_arg) {
    extern __shared__ __attribute__((aligned(16))) unsigned char shm[];
    lds_t L = (lds_t)shm;
    cg::grid_group grid = cg::this_grid();
    CP* kp0 = (CP*)__builtin_amdgcn_kernarg_segment_ptr();
    const int G = (int)gridDim.x, bid = (int)blockIdx.x;
    const int ph_lo = p_arg.ph_lo, ph_hi = p_arg.ph_hi, coop = p_arg.coop, sub = p_arg.pad;
    __builtin_amdgcn_fence(__ATOMIC_ACQUIRE, "agent");
    if (threadIdx.x < 4) *(volatile LAS unsigned*)(L + LDS_BYTES - 16 + 4 * threadIdx.x) = 0u;
    __syncthreads();
    XcdBarrier xbar = xcd_barrier_post((unsigned*)(p_arg.ws + WS_BAR), (volatile LAS unsigned*)(L + LDS_BYTES - 16));
    for (int ph = ph_lo; ph < ph_hi; ++ph) {
        CP* kp = kp0; asm volatile("" : "+s"(kp)); CP& p = *kp; unsigned char* ws = p.ws;
        int type, l = 0;
        if (ph == 0) type = 0; else if (ph == 33) type = 11;
        else { const int q = ph - 1, pr = q >> 4, r = q & 15;
            if (r < 7) { l = 2 * pr; type = r < 3 ? r + 1 : (r == 3 ? 4 : r + 4); }
            else { l = 2 * pr + 1; const int r2 = r - 7; type = r2 < 3 ? r2 + 1 : r2 + 2; } }
        const unsigned char* wb = ws + WS_WB + (size_t)l * WL_LAYER; const int jl = l >> 1;
        float* SS = (float*)(ws + WS_SS); bf16_t* HB = (bf16_t*)(ws + WS_HB); bf16_t* U = (bf16_t*)(ws + WS_U);
#ifdef PROBE_REP_TYPES
        const int nrep = ((PROBE_REP_TYPES >> type) & 1) ? 2 : 1;
#else
        const int nrep = 1;
#endif
        for (int rep = 0; rep < nrep; ++rep) {
        if (type == 0) { if constexpr ((MASK & MK_PRO) != 0) phase_prologue(p, L); }
        else if (type == 1 || type == 9 || type == 2 || type == 8 || type == 10 || type == 3) {
            if constexpr ((MASK & MK_GEMM) != 0) {
            const int npass = type == 3 ? 2 : 1;
            for (int pass = 0; pass < npass; ++pass) {
                pg8::Gemm g; pg8::EpiAll E; int c = bid;
                g.M = T_; g.N = 1024; g.K = 1024; g.lda = 1024; g.A = HB; E.O = U; E.ldc = INW; E.H = p.out; E.ssn = SS; E.ss = SS;
                if (type == 1 || type == 9) { g.Bt = (const bf16_t*)(wb + (type == 1 ? WL_GU1 : WL_GU2)); g.N = 5632; E.mode = 0; E.ss = SS; }
                else if (type == 3) { E.mode = 1;
                    if (pass == 0) { g.A = (const bf16_t*)(ws + WS_MEMB); g.Bt = (const bf16_t*)(wb + WL_KV); g.M = MEMT; E.O = (bf16_t*)(ws + WS_KVM); E.ldc = 1024; E.ss = (const float*)(ws + WS_SSM); }
                    else { g.Bt = (const bf16_t*)(wb + WL_IN); g.N = INW; E.ss = SS; c = (bid + (G / 16) * 8) % G; } }
                else { E.mode = 2; E.O = HB; E.ssn = SS;
                    if (type == 8) { g.A = U + MIXW; g.Bt = (const bf16_t*)(wb + WL_OUT); g.K = OUTW; g.lda = INW; }
                    else { g.A = U; g.Bt = (const bf16_t*)(wb + (type == 2 ? WL_D1 : WL_D2)); g.K = FF_; g.lda = FF_; } }
                pg8::StaticOrder S; S.init(g.M, g.N, G, c); pg8::gemm_phase(L, g, S, E);
            }
            if constexpr ((MASK & MK_PRO) != 0) {
                if (l == 0 && G == 256) {
                    if (type == 1 && bid >= 128) transpose_range(p, L, 5888 + (bid - 128), 5888 + 2200, 128);
                    else if (type == 3 && bid >= 32 && bid < 128) transpose_range(p, L, 5888 + 2200 + (bid - 32), 5888 + 3688, 96);
                    else if (type == 9 && bid >= 128) transpose_range(p, L, 5888 + 3688 + (bid - 128), 2 * 5888, 128);
                } else if (l == 0 && type == 9) transpose_range(p, L, 5888 + bid, 2 * 5888, G);
            } }
        } else if (type == 4) {
            if constexpr ((MASK & MK_LRU) != 0) { if (sub != 2) for (int it = bid; it < 256; it += G) lru_item(p, jl, it, L); }
            if constexpr ((MASK & MK_XA) != 0) { if (sub != 1) { for (int it = bid; it < 512; it += G) xattn_item(p, it, L);
#ifdef DBG_THRASH
                { const u32x4* src = (const u32x4*)(ws + WS_WB) + (size_t)bid * 131072; unsigned acc = 0;
                  for (int i = threadIdx.x; i < 131072; i += NTHR) { const u32x4 v = src[i]; acc ^= v.x ^ v.y ^ v.z ^ v.w; }
                  if (acc == 0x12345u) ((unsigned*)(ws + WS_G))[0] = acc; }
#endif
            } }
        } else if (type == 5) { if constexpr ((MASK & MK_ML1) != 0) for (int it = bid; it < 256; it += G) ml1_item(p, jl, it, L); }
        else if (type == 6) {
            if (sub == 0 && G > 192) {
                if (bid < 192) { if constexpr ((MASK & MK_ML2) != 0) for (int r2_ = 0; r2_ < PROBE_ML2_REP; ++r2_) ml2_item(p, jl, bid, L); }
                else { if constexpr ((MASK & MK_XA) != 0) for (int it = bid - 192; it < 512; it += G - 192) xattn_item(p, it, L);
                       if constexpr ((MASK & MK_PRO) != 0) { if (l == 1) transpose_range(p, L, 2 * 5888 + bid - 192, 4 * 5888, G - 192); } }
            } else {
                if constexpr ((MASK & MK_ML2) != 0) { if (sub != 2) for (int it = bid; it < 192; it += G) ml2_item(p, jl, it, L); }
                if constexpr ((MASK & MK_XA) != 0) { if (sub != 1) for (int it = bid; it < 512; it += G) xattn_item(p, it, L); }
                if constexpr ((MASK & MK_PRO) != 0) { if (l == 1 && sub != 1) transpose_range(p, L, 2 * 5888 + bid, 4 * 5888, G); }
            }
        } else if (type == 7) { if constexpr ((MASK & MK_ML3) != 0) phase_ml3(p, jl); }
        else { if constexpr ((MASK & MK_FIN) != 0) phase_final(p); }
        }
#ifdef PROBE_XSYNC
        if (coop) for (int xs = 0; xs < PROBE_XSYNC; ++xs) grid.sync();
#endif
        if (coop && ph + 1 < ph_hi) {
            if (coop == 2) grid.sync();
            else xcd_barrier(xbar);
        }
    }
    __builtin_amdgcn_fence(__ATOMIC_RELEASE, "agent");
}
constexpr int NPH = 1 + 4 * 7 + 2 * 2 + 1;

#define DBG_NOXA 0
#define DBG_NOLRU 0
#define DBG_SKIP 0x0
#ifndef MK_LAUNCHES
#define MK_LAUNCHES 1
#endif

template <int MASK> static bool prep(int& per_cu) {
    if (hipFuncSetAttribute((const void*)mega<MASK>, hipFuncAttributeMaxDynamicSharedMemorySize, LDS_BYTES) != hipSuccess) { fprintf(stderr, "kernel_launch: hipFuncSetAttribute failed (mask %d)\n", MASK); return false; }
    if (hipOccupancyMaxActiveBlocksPerMultiprocessor(&per_cu, (const void*)mega<MASK>, NTHR, LDS_BYTES) != hipSuccess || per_cu < 1) { fprintf(stderr, "kernel_launch: occupancy query says %d (mask %d)\n", per_cu, MASK); per_cu = 1; }
    (void)hipGetLastError();
    return true;
}
template <int MASK> static void launch1(const P& p, int grid, hipStream_t stream) { hipLaunchKernelGGL(mega<MASK>, dim3(grid), dim3(NTHR), LDS_BYTES, stream, p); }

extern "C" void kernel_launch(void* const* d_in, const int* in_sizes, int n_in, void* d_out, int out_size, void* d_ws, size_t ws_size, hipStream_t stream) {
    static int grid = 0;
    if (grid == 0) {
        if (n_in != 32 || out_size != T_ * D_ || ws_size < WS_END) { fprintf(stderr, "kernel_launch: unexpected shapes (n_in %d out %d ws %zu need %zu)\n", n_in, out_size, ws_size, (size_t)WS_END); grid = -1; return; }
        int dev = 0, cus = 0, per_cu = 0;
        (void)hipGetDevice(&dev); (void)hipDeviceGetAttribute(&cus, hipDeviceAttributeMultiprocessorCount, dev);
        bool ok = true;
#if MK_LAUNCHES == 1
        ok = prep<MK_ALL>(per_cu);
#else
        ok = prep<MK_PRO>(per_cu) && prep<MK_GEMM>(per_cu) && prep<MK_LRU>(per_cu) && prep<MK_XA>(per_cu) && prep<MK_ML1>(per_cu) && prep<MK_ML2>(per_cu) && prep<MK_ML3>(per_cu) && prep<MK_FIN>(per_cu);
#endif
        if (!ok) { grid = -1; return; }
        grid = cus > 0 ? cus : 256;
    }
    if (grid < 0) return;
    P p{};
    for (int i = 0; i < 32; ++i) p.in[i] = (const float*)d_in[i];
    p.out = (float*)d_out; p.ws = (unsigned char*)d_ws;
#if MK_LAUNCHES == 1
    p.ph_lo = 0; p.ph_hi = NPH; p.coop = 1; p.pad = 0;
    (void)hipMemsetAsync((unsigned char*)d_ws + WS_BAR, 0, XCD_BAR_WORDS * 4, stream);
    void* args[] = {&p};
    hipError_t e = hipLaunchCooperativeKernel((const void*)mega<MK_ALL>, dim3(grid), dim3(NTHR), args, LDS_BYTES, stream);
    if (e != hipSuccess) fprintf(stderr, "cooperative launch failed: %s (grid %d)\n", hipGetErrorString(e), grid);
#else
    for (int i = 0; i < NPH; ++i) { p.ph_lo = i; p.ph_hi = i + 1; p.coop = 0; p.pad = 0;
        int type;
        if (i == 0) type = 0; else if (i == 33) type = 11; else { const int q = i - 1, r = q & 15; if (r < 7) type = r < 3 ? r + 1 : (r == 3 ? 4 : r + 4); else { const int r2 = r - 7; type = r2 < 3 ? r2 + 1 : r2 + 2; } }
        if (type == 0) launch1<MK_PRO>(p, grid, stream);
#ifdef DBG_SKIP
        else if (((DBG_SKIP >> type) & 1) != 0) {}
#endif
        else if (type == 4) { p.pad = 1; if (!DBG_NOLRU) launch1<MK_LRU>(p, grid, stream); p.pad = 2; if (!DBG_NOXA) launch1<MK_XA>(p, grid, stream); }
        else if (type == 5) launch1<MK_ML1>(p, grid, stream);
        else if (type == 6) { p.pad = 1; launch1<MK_ML2>(p, grid, stream); p.pad = 2; launch1<MK_XA>(p, grid, stream); }
        else if (type == 7) launch1<MK_ML3>(p, grid, stream);
        else if (type == 11) launch1<MK_FIN>(p, grid, stream);
        else launch1<MK_GEMM>(p, grid, stream);
    }
#endif
}
```

```cpp
#include <hip/hip_runtime.h>
#include <hip/hip_cooperative_groups.h>
#include <cstdio>
namespace cg = cooperative_groups;

#define PROBE_ML2_REP 1
#define LAS __attribute__((address_space(3)))
typedef unsigned short bf16_t;
typedef short bf16x8 __attribute__((ext_vector_type(8)));
typedef short s16x4 __attribute__((ext_vector_type(4)));
typedef float f32x4 __attribute__((ext_vector_type(4)));
typedef unsigned u32x4 __attribute__((ext_vector_type(4)));
typedef unsigned u32x2 __attribute__((ext_vector_type(2)));
typedef LAS unsigned char* lds_t;

constexpr int T_ = 16384, D_ = 1024, SEQ_ = 2048, NB_ = 8, FF_ = 2816, MIXW = 1536, INW = 3584, OUTW = 2048, MEMT = 2048;
constexpr float EPS_ = 1e-6f;
constexpr int NTHR = 512;
constexpr int LDS_BYTES = 152 * 1024;

constexpr size_t SZ_GU = (size_t)5632 * 1024 * 2, SZ_DN = (size_t)1024 * 2816 * 2, SZ_IN = (size_t)3584 * 1024 * 2, SZ_KV = (size_t)1024 * 1024 * 2, SZ_OUT = (size_t)1024 * 2048 * 2;
constexpr size_t WL_GU1 = 0, WL_D1 = WL_GU1 + SZ_GU, WL_IN = WL_D1 + SZ_DN, WL_KV = WL_IN + SZ_IN, WL_OUT = WL_KV + SZ_KV, WL_GU2 = WL_OUT + SZ_OUT, WL_D2 = WL_GU2 + SZ_GU, WL_LAYER = WL_D2 + SZ_DN;
constexpr size_t WS_WB = 0;
constexpr size_t WS_U = WS_WB + 4 * WL_LAYER;
constexpr size_t WS_XC = WS_U + (size_t)T_ * INW * 2;
constexpr size_t WS_HOUT = WS_XC + (size_t)T_ * MIXW * 2;
constexpr size_t WS_HB = WS_HOUT + (size_t)T_ * MIXW * 2;
constexpr size_t WS_MEMB = WS_HB + (size_t)T_ * D_ * 2;
constexpr size_t WS_KVM = WS_MEMB + (size_t)MEMT * D_ * 2;
constexpr size_t WS_G = WS_KVM + (size_t)MEMT * D_ * 2;
constexpr size_t WS_SS = WS_G + (size_t)T_ * 8 * 4;
constexpr size_t WS_SSM = WS_SS + (size_t)16 * T_ * 4;
constexpr size_t WS_BAR = WS_SSM + (size_t)MEMT * 16 * 4;
constexpr size_t WS_END = WS_BAR + 16384;

struct P {
    const float* in[32];
    float* out;
    unsigned char* ws;
    int ph_lo, ph_hi, coop, pad;
};
typedef const __attribute__((address_space(4))) P CP;

__device__ __forceinline__ unsigned cvt_pk_bf16(float lo, float hi) { unsigned r; asm("v_cvt_pk_bf16_f32 %0, %1, %2" : "=v"(r) : "v"(lo), "v"(hi)); return r; }
__device__ __forceinline__ float bflo(unsigned w) { return __uint_as_float(w << 16); }
__device__ __forceinline__ float bfhi(unsigned w) { return __uint_as_float(w & 0xffff0000u); }
__device__ __forceinline__ float bf2f(bf16_t b) { return __uint_as_float(((unsigned)b) << 16); }
__device__ __forceinline__ float frcp_(float x) { return __builtin_amdgcn_rcpf(x); }
__device__ __forceinline__ float sigmoidf_(float x) { return frcp_(1.0f + __expf(-x)); }
__device__ __forceinline__ float siluf_(float x) { return x * frcp_(1.0f + __expf(-x)); }
__device__ __forceinline__ float gelu_tanh_(float x) { const float u = 1.5957691216f * (x + 0.044715f * x * x * x); return x * frcp_(1.0f + __expf(-u)); }
__device__ __forceinline__ float softplusf_(float x) { return fmaxf(x, 0.f) + log1pf(__expf(-fabsf(x))); }
__device__ __forceinline__ float wave_sum(float v) {
#pragma unroll
    for (int d = 32; d >= 1; d >>= 1) v += __shfl_xor(v, d);
    return v;
}
template <class Tt> __device__ __forceinline__ Tt lds_ld(lds_t L, int off) { return *(const LAS Tt*)(L + off); }
template <class Tt> __device__ __forceinline__ void lds_st(lds_t L, int off, Tt v) { *(LAS Tt*)(L + off) = v; }
__device__ __forceinline__ bf16x8 tr_pair(lds_t L, int off0, int off1) {
    s16x4 a = __builtin_amdgcn_ds_read_tr16_b64_v4i16((LAS s16x4*)(L + off0));
    s16x4 b = __builtin_amdgcn_ds_read_tr16_b64_v4i16((LAS s16x4*)(L + off1));
    return __builtin_shufflevector(a, b, 0, 1, 2, 3, 4, 5, 6, 7);
}
__device__ __forceinline__ bf16x8 pack8(f32x4 a, f32x4 b) {
    u32x4 w; w.x = cvt_pk_bf16(a[0], a[1]); w.y = cvt_pk_bf16(a[2], a[3]); w.z = cvt_pk_bf16(b[0], b[1]); w.w = cvt_pk_bf16(b[2], b[3]);
    return __builtin_bit_cast(bf16x8, w);
}
__device__ __forceinline__ void st16_sc1(void* ptr, u32x4 v) { asm volatile("global_store_dwordx4 %0, %1, off sc1\n\ts_nop 2" :: "v"(ptr), "v"(v) : "memory"); }
#define MFMA16(a, b, c) __builtin_amdgcn_mfma_f32_16x16x32_bf16((a), (b), (c), 0, 0, 0)

#define XB_TMO      128
#define XB_XCNT(j)  (256  + 64 * (j))
#define XB_XSUB(j)  (1280 + 64 * (j))
#define XB_XGEN(j)  (2304 + 64 * (j))
#define XB_TOP      3328
#define XB_TOPGEN   3392
#define XCD_BAR_WORDS 3456
#define XB_SPIN_CAP (1u << 18)

__device__ __forceinline__ unsigned xb_ld(unsigned* p)              { return __hip_atomic_load(p, __ATOMIC_RELAXED, __HIP_MEMORY_SCOPE_AGENT); }
__device__ __forceinline__ unsigned xb_add(unsigned* p, unsigned v) { return __hip_atomic_fetch_add(p, v, __ATOMIC_RELAXED, __HIP_MEMORY_SCOPE_AGENT); }
__device__ __forceinline__ unsigned xb_xcc_id() { return (unsigned)__builtin_amdgcn_s_getreg((3 << 11) | 20) & 0xFu; }
#define XB_SPIN(cond, bar) do { unsigned _sp = 0; while (cond) { __builtin_amdgcn_s_sleep(1); \
    if ((++_sp & 255u) == 0u) { if (xb_ld(&(bar)[XB_TMO])) break; if (_sp > XB_SPIN_CAP) { atomicAdd(&(bar)[XB_TMO], 1u); break; } } } } while (0)

struct XcdBarrier {
    unsigned* bar; unsigned x;
    volatile LAS unsigned* st;
};

__device__ __forceinline__ XcdBarrier xcd_barrier_post(unsigned* bar, volatile LAS unsigned* st) {
    XcdBarrier b; b.bar = bar; b.x = xb_xcc_id(); b.st = st;
    if (threadIdx.x == 0) (void)xb_add(&bar[XB_XCNT(b.x)], 1u);
    return b;
}
__device__ __forceinline__ void xcd_barrier_complete(unsigned* bar, unsigned x, unsigned& nloc, unsigned& nx) {
    const unsigned G = gridDim.x * gridDim.y * gridDim.z;
    unsigned sum, cnt, mine, sp = 0u;
    for (;;) {
        sum = 0u; cnt = 0u; mine = 0u;
#pragma unroll
        for (unsigned j = 0; j < 16; ++j) { const unsigned c = xb_ld(&bar[XB_XCNT(j)]); sum += c; cnt += (c > 0u) ? 1u : 0u; mine = (j == x) ? c : mine; }
        if (sum == G) break;
        __builtin_amdgcn_s_sleep(1);
        if ((++sp & 255u) == 0u) { if (xb_ld(&bar[XB_TMO])) break; if (sp > XB_SPIN_CAP) { atomicAdd(&bar[XB_TMO], 1u); break; } }
    }
    nloc = mine > 0u ? mine : 1u; nx = cnt > 0u ? cnt : 1u;
}

__device__ __forceinline__ void xcd_barrier(const XcdBarrier& b) {
    asm volatile("s_waitcnt vmcnt(0)" ::: "memory");
    __syncthreads();
    if (threadIdx.x == 0) {
        unsigned* bar = b.bar;
        __builtin_amdgcn_s_waitcnt(0);
        unsigned nloc = b.st[0], nx = b.st[1];
        if (nloc == 0u) { xcd_barrier_complete(bar, b.x, nloc, nx); b.st[0] = nloc; b.st[1] = nx; }
        const unsigned old = xb_add(&bar[XB_XSUB(b.x)], 1u);
        const unsigned gen = old / nloc;
        if (old + 1u == (gen + 1u) * nloc) {
            __builtin_amdgcn_fence(__ATOMIC_RELEASE, "agent");
            asm volatile("s_waitcnt vmcnt(0)" ::: "memory");
            const unsigned og = xb_add(&bar[XB_TOP], 1u);
            const unsigned tg = og / nx;
            if (og + 1u == (tg + 1u) * nx) xb_add(&bar[XB_TOPGEN], 1u);
            else XB_SPIN(xb_ld(&bar[XB_TOPGEN]) == tg, bar);
            __builtin_amdgcn_fence(__ATOMIC_ACQUIRE, "agent");
            xb_add(&bar[XB_XGEN(b.x)], 1u);
            asm volatile("s_waitcnt vmcnt(0)" ::: "memory");
        } else {
            XB_SPIN(xb_ld(&bar[XB_XGEN(b.x)]) == gen, bar);
            __builtin_amdgcn_fence(__ATOMIC_ACQUIRE, "agent");
            asm volatile("s_waitcnt vmcnt(0)" ::: "memory");
        }
    }
    __syncthreads();
}


namespace pg8 {
constexpr int BM = 256, BK = 64, HALF = 128, HTB = HALF * BK * 2, NXCD = 8, WGM = 8;
__device__ __forceinline__ int lds_byte(int r, int c) { const int st = (r >> 4) * 2 + (c >> 5), rr = r & 15, cc = c & 31, ob = rr * 64 + cc * 2; return st * 1024 + (ob ^ (((ob >> 9) & 1) << 5)); }
__device__ __forceinline__ void stage_rc(int b, int& R, int& C) { const int st = b / 1024, sb = b % 1024, swz = sb ^ (((sb >> 9) & 1) << 5); R = (st >> 1) * 16 + swz / 64; C = (st & 1) * 32 + (swz % 64) / 2; }
__device__ __forceinline__ int perm32(int rho) { const int n = rho >> 4, i = rho & 15; return 8 * (i >> 2) + 4 * n + (i & 3); }
struct Unit { int pm, pn; };
struct Gemm { const bf16_t* A; const bf16_t* Bt; int M, N, K, lda; };
struct StaticOrder {
    int nM, nN, nwg, G, c, sf, sl;
    __device__ void init(int M, int N, int G_, int c_) { nM = M / BM; nN = N / BM; nwg = nM * nN; G = G_; c = c_; sf = 1 << 30; sl = 0; }
    __device__ bool next(int i, Unit& u) const {
        const long L = (long)i * G + c; if (L >= nwg) return false;
        int wgid = (int)L; { const int q = nwg / NXCD, r = nwg % NXCD, xcd = wgid % NXCD, off = wgid / NXCD; wgid = (xcd < r ? xcd * (q + 1) : r * (q + 1) + (xcd - r) * q) + off; }
        const int nig = WGM * nN, gid = wgid / nig, fm = gid * WGM, gsz = (nM - fm) < WGM ? (nM - fm) : WGM;
        u.pm = fm + ((wgid % nig) % gsz); u.pn = (wgid % nig) / gsz; if (u.pn >= sf) u.pn += sl; return true;
    }
};

template <class Epi>
__device__ __forceinline__ void gemm_phase(lds_t lds, const Gemm g, const StaticOrder& S, const Epi& E) {
    int tid_ = threadIdx.x; asm volatile("" : "+v"(tid_)); const int tid = tid_, wid = __builtin_amdgcn_readfirstlane(tid >> 6), lane = tid & 63, wr = wid >> 2, wc = wid & 3, fr = lane & 15, fq = lane >> 4;
    const int K = g.K, nt = K / BK, lda = g.lda;
    unsigned voffA[2], voffB[2];
#pragma unroll
    for (int i = 0; i < 2; ++i) { int R, C; stage_rc(tid * 16 + i * 8192, R, C); const int Rb = Epi::PERM ? ((R & ~31) + perm32(R & 31)) : R;
        voffA[i] = (unsigned)(R * lda + C) * 2u; voffB[i] = (unsigned)(Rb * K + C) * 2u; }
    const size_t kstep = (size_t)(BK * 2);
    const size_t hstepA = (size_t)HALF * lda * 2, hstepB = (size_t)HALF * K * 2;
    const size_t tstepA = 2 * hstepA, tstepB = 2 * hstepB;
    const unsigned ldsw = (unsigned)wid * 1024u;
    const int aoff = lds_byte(wr * 64 + fr, fq * 8), boff = lds_byte(wc * 32 + fr, fq * 8);
#define PG8_SA(b, h) (((b) * 2 + (h)) * HTB)
#define PG8_SB(b, h) ((4 + (b) * 2 + (h)) * HTB)
#define PG8_STAGE(bufoff, gbase, voff) do { _Pragma("unroll") for (int _i = 0; _i < 2; ++_i) \
        __builtin_amdgcn_global_load_lds((const unsigned*)((const char*)(gbase) + (voff)[_i]), (LAS unsigned*)(lds + (bufoff) + ldsw + _i * 8192), 16, 0, 0); } while (0)
#define PG8_LDA(dst, b, h) do { _Pragma("unroll") for (int m = 0; m < 4; ++m) _Pragma("unroll") for (int k = 0; k < 2; ++k) dst[m][k] = *(const LAS bf16x8*)(lds + PG8_SA(b, h) + aoff + m * 2048 + k * 1024); } while (0)
#define PG8_LDB(dst, b, h) do { _Pragma("unroll") for (int n = 0; n < 2; ++n) _Pragma("unroll") for (int k = 0; k < 2; ++k) dst[n][k] = *(const LAS bf16x8*)(lds + PG8_SB(b, h) + boff + n * 2048 + k * 1024); } while (0)
#define PG8_MMA(ai, bj, At, Bt) do { __builtin_amdgcn_s_setprio(1); _Pragma("unroll") for (int m = 0; m < 4; ++m) _Pragma("unroll") for (int n = 0; n < 2; ++n) _Pragma("unroll") for (int k = 0; k < 2; ++k) \
        acc[ai][bj][m][n] = __builtin_amdgcn_mfma_f32_16x16x32_bf16(Bt[n][k], At[m][k], acc[ai][bj][m][n], 0, 0, 0); __builtin_amdgcn_s_setprio(0); } while (0)
#define PG8_WAIT_V(n) asm volatile("s_waitcnt vmcnt(" #n ")" ::: "memory")
#define PG8_WAIT_L(n) asm volatile("s_waitcnt lgkmcnt(" #n ")" ::: "memory")
#define PG8_BAR __builtin_amdgcn_s_barrier()
#define PG8_SCHED __builtin_amdgcn_sched_barrier(0)
    Unit cur, nxt; int ui = 0;
    if (!S.next(0, cur)) return;
    f32x4 acc[2][2][4][2];
    E.init(acc, cur, wr, wc, fr, fq);
    bf16x8 At[4][2], B0[2][2], B1[2][2];
    E.rowscales(lds, tid * 32, cur.pm, wr, fr, fq);
    const char* cA = (const char*)g.A + (size_t)cur.pm * tstepA; const char* cB = (const char*)g.Bt + (size_t)cur.pn * tstepB;
    PG8_STAGE(PG8_SB(0, 0), cB, voffB); PG8_STAGE(PG8_SA(0, 0), cA, voffA); PG8_STAGE(PG8_SB(0, 1), cB + hstepB, voffB); PG8_STAGE(PG8_SA(0, 1), cA + hstepA, voffA);
    if (wr == 1) PG8_BAR;
    PG8_WAIT_V(4); PG8_BAR;
    PG8_STAGE(PG8_SB(1, 0), cB + kstep, voffB); PG8_STAGE(PG8_SA(1, 0), cA + kstep, voffA); PG8_STAGE(PG8_SB(1, 1), cB + hstepB + kstep, voffB);
    PG8_WAIT_V(6); PG8_BAR;
    for (;;) {
        const bool has_next = S.next(ui + 1, nxt);
        const char* nA = has_next ? (const char*)g.A + (size_t)nxt.pm * tstepA : cA; const char* nB = has_next ? (const char*)g.Bt + (size_t)nxt.pn * tstepB : cB;
        for (int t = 0; t < nt; t += 2) {
            const bool last = (t == nt - 2);
            const char* a1 = cA + (size_t)(t + 1) * kstep;
            const char* a2 = last ? nA : cA + (size_t)(t + 2) * kstep; const char* b2 = last ? nB : cB + (size_t)(t + 2) * kstep;
            const char* a3 = a2 + kstep; const char* b3 = b2 + kstep;
            PG8_LDB(B0, 0, 0); PG8_SCHED; PG8_LDA(At, 0, 0); PG8_STAGE(PG8_SA(1, 1), a1 + hstepA, voffA);
            PG8_WAIT_L(8); PG8_BAR; PG8_WAIT_L(0); PG8_MMA(0, 0, At, B0); PG8_BAR; PG8_SCHED;
            PG8_LDB(B1, 0, 1); PG8_STAGE(PG8_SB(0, 0), b2, voffB);
            PG8_BAR; PG8_WAIT_L(0); PG8_MMA(0, 1, At, B1); PG8_BAR;
            PG8_LDA(At, 0, 1); PG8_STAGE(PG8_SA(0, 0), a2, voffA);
            PG8_BAR; PG8_WAIT_L(0); PG8_MMA(1, 0, At, B0); PG8_BAR; PG8_SCHED;
            PG8_STAGE(PG8_SB(0, 1), b2 + hstepB, voffB);
            PG8_WAIT_V(6); PG8_BAR; PG8_MMA(1, 1, At, B1); PG8_BAR;
            PG8_LDB(B0, 1, 0); PG8_SCHED; PG8_LDA(At, 1, 0); PG8_STAGE(PG8_SA(0, 1), a2 + hstepA, voffA);
            PG8_WAIT_L(8); PG8_BAR; PG8_WAIT_L(0); PG8_MMA(0, 0, At, B0); PG8_BAR; PG8_SCHED;
            PG8_LDB(B1, 1, 1); PG8_STAGE(PG8_SB(1, 0), b3, voffB);
            PG8_BAR; PG8_WAIT_L(0); PG8_MMA(0, 1, At, B1); PG8_BAR;
            PG8_LDA(At, 1, 1); PG8_STAGE(PG8_SA(1, 0), a3, voffA);
            PG8_BAR; PG8_WAIT_L(0); PG8_MMA(1, 0, At, B0); PG8_BAR; PG8_SCHED;
            PG8_STAGE(PG8_SB(1, 1), b3 + hstepB, voffB);
            PG8_WAIT_V(6); PG8_BAR; PG8_MMA(1, 1, At, B1); PG8_BAR;
        }
        E(acc, lds, tid * 32, cur, wr, wc, fr, fq);
        if (!has_next) break;
        E.init(acc, nxt, wr, wc, fr, fq);
        if (nxt.pm != cur.pm) E.rowscales(lds, tid * 32, nxt.pm, wr, fr, fq);
        cur = nxt; cA = nA; cB = nB; ++ui;
    }
    PG8_WAIT_V(0);
    if (wr == 0) PG8_BAR;
    PG8_BAR;
#undef PG8_SA
#undef PG8_SB
#undef PG8_STAGE
#undef PG8_LDA
#undef PG8_LDB
#undef PG8_MMA
#undef PG8_WAIT_V
#undef PG8_WAIT_L
#undef PG8_BAR
#undef PG8_SCHED
}

__device__ __forceinline__ float rowscale(const float* ss, int row) {
    const f32x4 a = *(const f32x4*)(ss + (size_t)row * 16), b = *(const f32x4*)(ss + (size_t)row * 16 + 4), c = *(const f32x4*)(ss + (size_t)row * 16 + 8), d = *(const f32x4*)(ss + (size_t)row * 16 + 12);
    const float s = ((a[0] + a[1]) + (a[2] + a[3])) + ((b[0] + b[1]) + (b[2] + b[3])) + ((c[0] + c[1]) + (c[2] + c[3])) + ((d[0] + d[1]) + (d[2] + d[3]));
    return rsqrtf(s * (1.0f / 1024.0f) + EPS_); }

struct EpiAll {
    static constexpr bool PERM = true;
    int mode; bf16_t* O; int ldc; const float* ss; float* H; float* ssn;
    __device__ __forceinline__ void init(f32x4 (&acc)[2][2][4][2], const Unit& u, int wr, int wc, int fr, int fq) const {
        if (mode == 2) {
            const int row0 = u.pm * BM + wr * 64 + fr, col0 = u.pn * BM + wc * 32 + 8 * fq;
#pragma unroll
            for (int ai = 0; ai < 2; ++ai)
#pragma unroll
                for (int m = 0; m < 4; ++m)
#pragma unroll
                    for (int bj = 0; bj < 2; ++bj) { const u32x4 hw = *(const u32x4*)(O + (size_t)(row0 + ai * HALF + m * 16) * D_ + col0 + bj * HALF);
                        acc[ai][bj][m][0] = (f32x4){bflo(hw.x), bfhi(hw.x), bflo(hw.y), bfhi(hw.y)}; acc[ai][bj][m][1] = (f32x4){bflo(hw.z), bfhi(hw.z), bflo(hw.w), bfhi(hw.w)}; }
        } else {
#pragma unroll
            for (int a = 0; a < 2; ++a)
#pragma unroll
                for (int b = 0; b < 2; ++b)
#pragma unroll
                    for (int m = 0; m < 4; ++m)
#pragma unroll
                        for (int n = 0; n < 2; ++n) acc[a][b][m][n] = (f32x4){0.f, 0.f, 0.f, 0.f};
        }
    }
    __device__ __forceinline__ void rowscales(lds_t lds, int tslot, int pm, int wr, int fr, int fq) const {
        float rs[2][4];
        if (mode != 2) { const int row0 = pm * BM + wr * 64 + fr; f32x4 t[2][4];
#pragma unroll
            for (int ai = 0; ai < 2; ++ai)
#pragma unroll
                for (int m = 0; m < 4; ++m) t[ai][m] = *(const f32x4*)(ss + (size_t)(row0 + ai * HALF + m * 16) * 16 + 4 * fq);
#pragma unroll
            for (int ai = 0; ai < 2; ++ai)
#pragma unroll
                for (int m = 0; m < 4; ++m) { float sm = (t[ai][m][0] + t[ai][m][1]) + (t[ai][m][2] + t[ai][m][3]);
                    sm += __shfl_xor(sm, 16); sm += __shfl_xor(sm, 32);
                    rs[ai][m] = rsqrtf(sm * (1.0f / 1024.0f) + EPS_); }
            *(LAS f32x4*)(lds + 131072 + tslot) = (f32x4){rs[0][0], rs[0][1], rs[0][2], rs[0][3]};
            *(LAS f32x4*)(lds + 131072 + tslot + 16) = (f32x4){rs[1][0], rs[1][1], rs[1][2], rs[1][3]}; }
    }
    __device__ __forceinline__ void operator()(const f32x4 (&acc)[2][2][4][2], lds_t lds, int tslot, const Unit& u, int wr, int wc, int fr, int fq) const {
        const int row0 = u.pm * BM + wr * 64 + fr;
        if (mode != 2) {
            float rs[2][4];
            { const f32x4 r0 = *(const LAS f32x4*)(lds + 131072 + tslot), r1 = *(const LAS f32x4*)(lds + 131072 + tslot + 16);
              rs[0][0] = r0[0]; rs[0][1] = r0[1]; rs[0][2] = r0[2]; rs[0][3] = r0[3]; rs[1][0] = r1[0]; rs[1][1] = r1[1]; rs[1][2] = r1[2]; rs[1][3] = r1[3]; }
            if (mode == 0) {
                const int col0 = u.pn * 128 + wc * 32 + 8 * fq;
#pragma unroll
                for (int ai = 0; ai < 2; ++ai)
#pragma unroll
                    for (int m = 0; m < 4; ++m) { const int row = row0 + ai * HALF + m * 16; const float r1 = rs[ai][m];
                        float v[8];
#pragma unroll
                        for (int n = 0; n < 2; ++n)
#pragma unroll
                            for (int j = 0; j < 4; ++j) { const float gt = acc[ai][0][m][n][j] * r1, up = acc[ai][1][m][n][j] * r1; v[n * 4 + j] = siluf_(gt) * up; }
                        u32x4 w; w.x = cvt_pk_bf16(v[0], v[1]); w.y = cvt_pk_bf16(v[2], v[3]); w.z = cvt_pk_bf16(v[4], v[5]); w.w = cvt_pk_bf16(v[6], v[7]);
                        st16_sc1(O + (size_t)row * FF_ + col0, w); }
            } else {
                const int col0 = u.pn * BM + wc * 32 + 8 * fq;
#pragma unroll
                for (int ai = 0; ai < 2; ++ai)
#pragma unroll
                    for (int m = 0; m < 4; ++m) { const int row = row0 + ai * HALF + m * 16; const float r1 = rs[ai][m];
#pragma unroll
                        for (int bj = 0; bj < 2; ++bj) { const f32x4 v0 = acc[ai][bj][m][0] * r1, v1 = acc[ai][bj][m][1] * r1;
                            u32x4 w; w.x = cvt_pk_bf16(v0[0], v0[1]); w.y = cvt_pk_bf16(v0[2], v0[3]); w.z = cvt_pk_bf16(v1[0], v1[1]); w.w = cvt_pk_bf16(v1[2], v1[3]);
                            st16_sc1(O + (size_t)row * ldc + col0 + bj * HALF, w); } }
            }
        } else {
            const int col0 = u.pn * BM + wc * 32 + 8 * fq;
#pragma unroll
            for (int ai = 0; ai < 2; ++ai)
#pragma unroll
                for (int m = 0; m < 4; ++m) { const int row = row0 + ai * HALF + m * 16; float s2 = 0.f;
#pragma unroll
                    for (int bj = 0; bj < 2; ++bj) { const size_t o = (size_t)row * D_ + col0 + bj * HALF;
                        const f32x4 h0 = acc[ai][bj][m][0], h1 = acc[ai][bj][m][1];
                        u32x4 w; w.x = cvt_pk_bf16(h0[0], h0[1]); w.y = cvt_pk_bf16(h0[2], h0[3]); w.z = cvt_pk_bf16(h1[0], h1[1]); w.w = cvt_pk_bf16(h1[2], h1[3]);
                        st16_sc1(O + o, w);
                        s2 += h0[0] * h0[0] + h0[1] * h0[1] + h0[2] * h0[2] + h0[3] * h0[3] + h1[0] * h1[0] + h1[1] * h1[1] + h1[2] * h1[2] + h1[3] * h1[3]; }
                    s2 += __shfl_xor(s2, 16); s2 += __shfl_xor(s2, 32);
                    if (fq == 0) ssn[(size_t)row * 16 + u.pn * 4 + wc] = s2; }
        }
    }
};
}

struct TileDesc { const float* src; const float* gain; bf16_t* dst; float base; };
__device__ __forceinline__ int dim_of(int code) { return code == 0 ? FF_ : (code == 1 ? D_ : (code == 2 ? INW : OUTW)); }
__device__ __forceinline__ TileDesc tile_desc(CP& p, int g, int tid) {
    constexpr int TPL = 5888;
    const int l = g / TPL, r = g % TPL;
    const int seg = (r >= 704) + (r >= 1408) + (r >= 2112) + (r >= 3008) + (r >= 3264) + (r >= 3776) + (r >= 4480) + (r >= 5184);
    const int start = seg < 3 ? seg * 704 : (seg == 3 ? 2112 : (seg == 4 ? 3008 : (seg == 5 ? 3264 : 3776 + (seg - 6) * 704)));
    const int sh = 4 * seg;
    const int in_idx = (int)((0xEDCA97543ull >> sh) & 15), gidx = (int)((0x0CC097033ull >> sh) & 15), mode = (int)((0x021000021ull >> sh) & 15);
    const int N = dim_of((int)((0x100112100ull >> sh) & 15)), K = dim_of((int)((0x011311011ull >> sh) & 15));
    const size_t wl = seg < 2 ? WL_GU1 : (seg == 2 ? WL_D1 : (seg == 3 ? WL_IN : (seg == 4 ? WL_KV : (seg == 5 ? WL_OUT : (seg < 8 ? WL_GU2 : WL_D2)))));
    const int rr = r - start, ntn = N >> 6, kt = rr / ntn, nt = rr - kt * ntn;
    const float* W = p.in[in_idx] + (size_t)l * K * N;
    TileDesc d;
    d.src = W + (size_t)(kt * 64 + (tid >> 3)) * N + nt * 64 + (tid & 7) * 8;
    d.gain = gidx ? p.in[gidx - 1] + l * D_ + kt * 64 + (tid >> 3) : nullptr;
    const int nn = nt * 64 + (tid >> 3); const int drow = mode == 0 ? nn : ((nn >> 7) * 256 + (mode == 2 ? 128 : 0) + (nn & 127));
    d.dst = (bf16_t*)(p.ws + WS_WB + (size_t)l * WL_LAYER + wl) + (size_t)drow * K + kt * 64 + 8 * (tid & 7);
    d.base = (seg == 2 || seg == 8) ? 0.5f : 1.0f;
    return d;
}
__device__ __forceinline__ void transpose_range(CP& p, lds_t L, int g0, int gend, int stride) {
    int tid_ = threadIdx.x; asm volatile("" : "+v"(tid_)); const int tid = tid_;
    int g = g0; asm volatile("" : "+s"(g));
    f32x4 a = (f32x4){0.f, 0.f, 0.f, 0.f}, b = a; float gn = 1.f; TileDesc cur; cur.dst = nullptr;
    __syncthreads();
    if (g < gend) { cur = tile_desc(p, g, tid); a = *(const f32x4*)cur.src; b = *(const f32x4*)(cur.src + 4); gn = cur.base * (cur.gain ? *cur.gain : 1.0f); }
    for (; g < gend; g += stride) {
        const int gnx = g + stride; TileDesc nxt; nxt.dst = nullptr; f32x4 na = a, nb = b; float ng = 1.f;
        if (gnx < gend) { nxt = tile_desc(p, gnx, tid); na = *(const f32x4*)nxt.src; nb = *(const f32x4*)(nxt.src + 4); ng = nxt.base * (nxt.gain ? *nxt.gain : 1.0f); }
        { const int r = tid >> 3, c8 = (tid & 7) * 8, o = (r * 65 + c8) * 4;
          lds_st<float>(L, o, a[0] * gn); lds_st<float>(L, o + 4, a[1] * gn); lds_st<float>(L, o + 8, a[2] * gn); lds_st<float>(L, o + 12, a[3] * gn);
          lds_st<float>(L, o + 16, b[0] * gn); lds_st<float>(L, o + 20, b[1] * gn); lds_st<float>(L, o + 24, b[2] * gn); lds_st<float>(L, o + 28, b[3] * gn); }
        __syncthreads();
        { const int n = tid >> 3, kc = tid & 7; float v[8];
#pragma unroll
          for (int j = 0; j < 8; ++j) v[j] = lds_ld<float>(L, ((8 * kc + j) * 65 + n) * 4);
          u32x4 w; w.x = cvt_pk_bf16(v[0], v[1]); w.y = cvt_pk_bf16(v[2], v[3]); w.z = cvt_pk_bf16(v[4], v[5]); w.w = cvt_pk_bf16(v[6], v[7]);
          *(u32x4*)cur.dst = w; }
        __syncthreads();
        cur = nxt; a = na; b = nb; gn = ng;
    }
}

__device__ __forceinline__ void phase_prologue(CP& p, lds_t L) {
    int tid_ = threadIdx.x; asm volatile("" : "+v"(tid_)); const int tid = tid_, lane = tid & 63, wid = tid >> 6;
    unsigned char* ws = p.ws;
    { bf16_t* HB = (bf16_t*)(ws + WS_HB); float* ss = (float*)(ws + WS_SS); bf16_t* MB = (bf16_t*)(ws + WS_MEMB); float* ssm = (float*)(ws + WS_SSM);
      for (int row = blockIdx.x * 8 + wid; row < T_ + MEMT; row += gridDim.x * 8) {
          const bool isx = row < T_; const int r = isx ? row : row - T_;
          const float* src = (isx ? p.in[0] : p.in[1]) + (size_t)r * D_; float s2 = 0.f;
#pragma unroll
          for (int i = 0; i < 4; ++i) { const int c = i * 256 + lane * 4; const f32x4 v = *(const f32x4*)(src + c);
              s2 += v[0] * v[0] + v[1] * v[1] + v[2] * v[2] + v[3] * v[3];
              u32x2 w; w.x = cvt_pk_bf16(v[0], v[1]); w.y = cvt_pk_bf16(v[2], v[3]);
              if (isx) { *(u32x2*)(HB + (size_t)r * D_ + c) = w; } else { *(u32x2*)(MB + (size_t)r * D_ + c) = w; } }
          s2 = wave_sum(s2);
          if (lane < 16) { const float v = lane == 0 ? s2 : 0.f; if (isx) ss[(size_t)r * 16 + lane] = v; else ssm[(size_t)r * 16 + lane] = v; } } }
    transpose_range(p, L, blockIdx.x, 5888, gridDim.x);
}

__device__ __forceinline__ void lru_item(CP& p, int jl, int item, lds_t L) {
    constexpr int WLo = 0, XCo = 38400, AAo = 89600, UUo = 114176, SEGo = 138752, CARo = 141824;
    int tid_ = threadIdx.x; asm volatile("" : "+v"(tid_)); const int tid = tid_, lane = tid & 63, wid = tid >> 6, fr = lane & 15, fq = lane >> 4;
    const int pair_ = (item & 7) * 8 + (item >> 5), b = pair_ >> 3, n = pair_ & 7, q4 = (item >> 3) & 3;
    bf16_t* U = (bf16_t*)(p.ws + WS_U);
    const float* w_r = p.in[17] + ((size_t)(jl * 8 + n) * 192) * 192; const float* w_i = p.in[19] + ((size_t)(jl * 8 + n) * 192) * 192;
    __syncthreads();
#pragma unroll 1
    for (int r3 = 0; r3 < 3; ++r3) {
        float v[12];
#pragma unroll
        for (int k = 0; k < 12; ++k) { const int idx = tid + NTHR * (12 * r3 + k), i = idx / 96, oo = idx % 96; v[k] = (oo < 48 ? w_r : w_i)[(size_t)i * 192 + 48 * q4 + (oo % 48)]; }
#pragma unroll
        for (int k = 0; k < 12; ++k) { const int idx = tid + NTHR * (12 * r3 + k), i = idx / 96, oo = idx % 96; lds_st<bf16_t>(L, WLo + oo * 400 + i * 2, (bf16_t)(cvt_pk_bf16(v[k], 0.f) & 0xffffu)); }
    }
    if (tid < 96) lds_st<float>(L, CARo + tid * 4, 0.f);
    float br[3], bi[3], sp[3];
#pragma unroll
    for (int t3 = 0; t3 < 3; ++t3) { const int c = jl * MIXW + n * 192 + 48 * q4 + 16 * t3 + fr; br[t3] = p.in[18][c]; bi[t3] = p.in[20][c]; sp[t3] = softplusf_(-p.in[21][c]); }
    const int cg = tid % 24, trow = tid / 24; float cw[4][8], cb[8];
    { const int c0 = jl * MIXW + n * 192 + 8 * cg;
#pragma unroll
      for (int j = 0; j < 4; ++j)
#pragma unroll
          for (int e = 0; e < 8; ++e) cw[j][e] = p.in[15][(size_t)jl * 4 * MIXW + (size_t)j * MIXW + n * 192 + 8 * cg + e];
#pragma unroll
      for (int e = 0; e < 8; ++e) cb[e] = p.in[16][c0 + e]; }
    for (int ck = 0; ck < 16; ++ck) {
        const int t0 = ck * 128;
        u32x4 gpre[2];
#pragma unroll
        for (int k = 0; k < 2; ++k) { const int e = tid + NTHR * k; if (e < 128 * 6) gpre[k] = *(const u32x4*)(U + (size_t)(b * SEQ_ + t0 + e / 6) * INW + MIXW + n * 192 + 48 * q4 + 8 * (e % 6)); }
        if (tid < 384) {
            u32x4 raw[11];
#pragma unroll
            for (int j = 0; j < 11; ++j) { const int tt = t0 + trow * 8 - 3 + j;
                raw[j] = tt >= 0 ? *(const u32x4*)(U + (size_t)(b * SEQ_ + tt) * INW + n * 192 + 8 * cg) : (u32x4){0u, 0u, 0u, 0u}; }
#pragma unroll
            for (int it = 0; it < 8; ++it) { const int t = trow * 8 + it; float acc[8];
#pragma unroll
                for (int e = 0; e < 8; ++e) acc[e] = cb[e];
#pragma unroll
                for (int j = 0; j < 4; ++j) { const u32x4 rw = raw[it + j];
                    acc[0] += cw[j][0] * bflo(rw.x); acc[1] += cw[j][1] * bfhi(rw.x); acc[2] += cw[j][2] * bflo(rw.y); acc[3] += cw[j][3] * bfhi(rw.y);
                    acc[4] += cw[j][4] * bflo(rw.z); acc[5] += cw[j][5] * bfhi(rw.z); acc[6] += cw[j][6] * bflo(rw.w); acc[7] += cw[j][7] * bfhi(rw.w); }
                u32x4 w; w.x = cvt_pk_bf16(acc[0], acc[1]); w.y = cvt_pk_bf16(acc[2], acc[3]); w.z = cvt_pk_bf16(acc[4], acc[5]); w.w = cvt_pk_bf16(acc[6], acc[7]);
                lds_st<u32x4>(L, XCo + t * 400 + cg * 16, w); }
        }
        __syncthreads();
        {
            f32x4 acc[6];
#pragma unroll
            for (int i = 0; i < 6; ++i) acc[i] = (f32x4){0.f, 0.f, 0.f, 0.f};
#pragma unroll
            for (int ks = 0; ks < 6; ++ks) { const bf16x8 a = lds_ld<bf16x8>(L, XCo + (16 * wid + fr) * 400 + (32 * ks + 8 * fq) * 2);
#pragma unroll
                for (int nt = 0; nt < 6; ++nt) { const bf16x8 bb = lds_ld<bf16x8>(L, WLo + (16 * nt + fr) * 400 + (32 * ks + 8 * fq) * 2); acc[nt] = MFMA16(a, bb, acc[nt]); } }
#pragma unroll
            for (int t3 = 0; t3 < 3; ++t3) { const int oc = 16 * t3 + fr;
#pragma unroll
                for (int rg = 0; rg < 4; ++rg) { const int t = 16 * wid + 4 * fq + rg;
                    const float r = sigmoidf_(acc[t3][rg] + br[t3]), gi = sigmoidf_(acc[t3 + 3][rg] + bi[t3]);
                    const float la = -8.0f * r * sp[t3], a = __expf(la), mult = __builtin_amdgcn_sqrtf(fmaxf(1.0f - a * a, 0.f));
                    const float xc = bf2f(lds_ld<bf16_t>(L, XCo + t * 400 + (48 * q4 + oc) * 2));
                    lds_st<float>(L, AAo + (t * 48 + oc) * 4, a); lds_st<float>(L, UUo + (t * 48 + oc) * 4, mult * gi * xc); } }
        }
        __syncthreads();
        const int ch = tid % 48, sg = tid / 48;
        if (tid < 384) { float A = 1.f, Hh = 0.f;
#pragma unroll
            for (int i = 0; i < 16; ++i) { const int t = 16 * sg + i; const float a = lds_ld<float>(L, AAo + (t * 48 + ch) * 4), uu = lds_ld<float>(L, UUo + (t * 48 + ch) * 4); Hh = a * Hh + uu; A *= a; }
            lds_st<float>(L, SEGo + (sg * 48 + ch) * 4, A); lds_st<float>(L, SEGo + 1536 + (sg * 48 + ch) * 4, Hh); }
        __syncthreads();
        if (tid < 384) { float h = lds_ld<float>(L, CARo + ((ck & 1) * 48 + ch) * 4);
            for (int s2 = 0; s2 < sg; ++s2) h = lds_ld<float>(L, SEGo + (s2 * 48 + ch) * 4) * h + lds_ld<float>(L, SEGo + 1536 + (s2 * 48 + ch) * 4);
#pragma unroll
            for (int i = 0; i < 16; ++i) { const int t = 16 * sg + i; const float a = lds_ld<float>(L, AAo + (t * 48 + ch) * 4), uu = lds_ld<float>(L, UUo + (t * 48 + ch) * 4); h = a * h + uu; lds_st<float>(L, UUo + (t * 48 + ch) * 4, h); }
            if (sg == 7) lds_st<float>(L, CARo + (((ck + 1) & 1) * 48 + ch) * 4, h); }
        __syncthreads();
#pragma unroll
        for (int k = 0; k < 2; ++k) { const int e = tid + NTHR * k;
            if (e < 128 * 6) { const int t = e / 6, c8 = e % 6;
                const f32x4 h0 = lds_ld<f32x4>(L, UUo + (t * 48 + 8 * c8) * 4), h1 = lds_ld<f32x4>(L, UUo + (t * 48 + 8 * c8 + 4) * 4);
                bf16_t* gp = U + (size_t)(b * SEQ_ + t0 + t) * INW + MIXW + n * 192 + 48 * q4 + 8 * c8; const u32x4 g = gpre[k];
                u32x4 w; w.x = cvt_pk_bf16(h0[0] * gelu_tanh_(bflo(g.x)), h0[1] * gelu_tanh_(bfhi(g.x))); w.y = cvt_pk_bf16(h0[2] * gelu_tanh_(bflo(g.y)), h0[3] * gelu_tanh_(bfhi(g.y)));
                w.z = cvt_pk_bf16(h1[0] * gelu_tanh_(bflo(g.z)), h1[1] * gelu_tanh_(bfhi(g.z))); w.w = cvt_pk_bf16(h1[2] * gelu_tanh_(bflo(g.w)), h1[3] * gelu_tanh_(bfhi(g.w)));
                st16_sc1(gp, w); } }
    }
}

__device__ __forceinline__ void xattn_item(CP& p, int item, lds_t L) {
    constexpr int KMo = 0, VMo = 69632;
    int tid_ = threadIdx.x; asm volatile("" : "+v"(tid_)); const int tid = tid_, lane = tid & 63, wid = tid >> 6, fr = lane & 15, fq = lane >> 4;
    const int slotx_ = item >> 3, pairx_ = (item & 7) * 4 + (slotx_ >> 4), b = pairx_ >> 2, hx = pairx_ & 3, qt = slotx_ & 15;
    bf16_t* U = (bf16_t*)(p.ws + WS_U); const bf16_t* KV = (const bf16_t*)(p.ws + WS_KVM);
    __syncthreads();
    for (int e = tid; e < 4096; e += NTHR) { const int key = e >> 4, ch = e & 15; const bf16_t* src = KV + (size_t)(b * 256 + key) * 1024 + hx * 128 + ch * 8;
        lds_st<u32x4>(L, KMo + key * 272 + ch * 16, *(const u32x4*)src); lds_st<u32x4>(L, VMo + key * 288 + ch * 16, *(const u32x4*)(src + 512)); }
    bf16_t* qrow = U + (size_t)(b * SEQ_ + qt * 128 + 16 * wid + fr) * INW + 2 * MIXW + hx * 128;
    bf16x8 Bq[4];
#pragma unroll
    for (int ks = 0; ks < 4; ++ks) Bq[ks] = *(const bf16x8*)(qrow + 32 * ks + 8 * fq);
    __syncthreads();
    f32x4 S[16];
#pragma unroll
    for (int kt = 0; kt < 16; ++kt) { f32x4 a = (f32x4){0.f, 0.f, 0.f, 0.f};
#pragma unroll
        for (int ks = 0; ks < 4; ++ks) a = MFMA16(lds_ld<bf16x8>(L, KMo + (16 * kt + fr) * 272 + (32 * ks + 8 * fq) * 2), Bq[ks], a);
        S[kt] = a; }
    float mx = -3.0e38f;
#pragma unroll
    for (int kt = 0; kt < 16; ++kt)
#pragma unroll
        for (int j = 0; j < 4; ++j) mx = fmaxf(mx, S[kt][j]);
    mx = fmaxf(mx, __shfl_xor(mx, 16)); mx = fmaxf(mx, __shfl_xor(mx, 32));
    const float sc = 0.08838834764831845f; float lsum = 0.f;
#pragma unroll
    for (int kt = 0; kt < 16; ++kt)
#pragma unroll
        for (int j = 0; j < 4; ++j) { const float e = __expf((S[kt][j] - mx) * sc); S[kt][j] = e; lsum += e; }
    lsum += __shfl_xor(lsum, 16); lsum += __shfl_xor(lsum, 32);
    f32x4 O[8];
#pragma unroll
    for (int dt = 0; dt < 8; ++dt) O[dt] = (f32x4){0.f, 0.f, 0.f, 0.f};
#pragma unroll
    for (int i = 0; i < 8; ++i) { const bf16x8 bp = pack8(S[2 * i], S[2 * i + 1]);
#pragma unroll
        for (int dt = 0; dt < 8; ++dt) { const int o0 = VMo + (32 * i + 4 * fq + (fr >> 2)) * 288 + (16 * dt + 4 * (fr & 3)) * 2;
#ifdef DBG_NOTR
            u32x4 af;
            { unsigned e[8];
#pragma unroll
              for (int j = 0; j < 8; ++j) { const int key = 32 * i + (j < 4 ? 4 * fq + j : 16 + 4 * fq + (j - 4)); e[j] = lds_ld<bf16_t>(L, VMo + key * 288 + (16 * dt + fr) * 2); }
              af.x = e[0] | (e[1] << 16); af.y = e[2] | (e[3] << 16); af.z = e[4] | (e[5] << 16); af.w = e[6] | (e[7] << 16); }
            (void)o0; O[dt] = MFMA16(__builtin_bit_cast(bf16x8, af), bp, O[dt]); } }
#else
            O[dt] = MFMA16(tr_pair(L, o0, o0 + 16 * 288), bp, O[dt]); } }
#endif
    float inv = frcp_(lsum);
#ifdef DBG_IDENT
    { const u32x4 q0 = __builtin_bit_cast(u32x4, Bq[0]);
#pragma unroll
      for (int dt = 0; dt < 8; ++dt) { O[dt][0] = bflo(q0.x) + dt; O[dt][1] = bfhi(q0.x); O[dt][2] = bflo(q0.y); O[dt][3] = bfhi(q0.y); } inv = 1.0f; }
#endif
#pragma unroll
    for (int dt = 0; dt < 8; ++dt) { u32x2 w; w.x = cvt_pk_bf16(O[dt][0] * inv, O[dt][1] * inv); w.y = cvt_pk_bf16(O[dt][2] * inv, O[dt][3] * inv);
        *(u32x2*)(qrow + 16 * dt + 4 * fq) = w; }
}

__device__ __forceinline__ void ml1_item(CP& p, int jl, int item, lds_t L) {
    int tid_ = threadIdx.x; asm volatile("" : "+v"(tid_)); const int tid = tid_, lane = tid & 63, wid = tid >> 6;
    const bf16_t* U = (const bf16_t*)(p.ws + WS_U); bf16_t* XC = (bf16_t*)(p.ws + WS_XC); float* G = (float*)(p.ws + WS_G);
    const int j = tid < 384 ? tid : 0;
    float cw[4][4], cb[4], Wx[4][8], Wm[4][8];
    {
#pragma unroll
        for (int k = 0; k < 4; ++k)
#pragma unroll
            for (int c = 0; c < 4; ++c) cw[k][c] = p.in[22][(size_t)jl * 4 * MIXW + (size_t)k * MIXW + 4 * j + c];
#pragma unroll
        for (int c = 0; c < 4; ++c) cb[c] = p.in[23][jl * MIXW + 4 * j + c];
        const float* wq = p.in[24] + ((size_t)jl * 384 + j) * 16; const float* wk = p.in[25] + ((size_t)jl * 384 + j) * 16; const float* wv = p.in[26] + ((size_t)jl * 384 + j) * 16;
        const float* Wg = p.in[27] + (size_t)jl * 4608 * 8;
#pragma unroll
        for (int i = 0; i < 4; ++i)
#pragma unroll
            for (int g = 0; g < 8; ++g) { Wx[i][g] = 0.f; Wm[i][g] = 0.f; }
#pragma unroll 1
        for (int o = 0; o < 4; ++o) {
            float gq[8], gk[8], gv[8];
#pragma unroll
            for (int g = 0; g < 8; ++g) { gq[g] = Wg[(size_t)(4 * j + o) * 8 + g]; gk[g] = Wg[(size_t)(MIXW + 4 * j + o) * 8 + g]; gv[g] = Wg[(size_t)(2 * MIXW + 4 * j + o) * 8 + g]; }
#pragma unroll
            for (int i = 0; i < 4; ++i) { const float a = wq[i * 4 + o], bk = wk[i * 4 + o], cv = wv[i * 4 + o];
#pragma unroll
                for (int g = 0; g < 8; ++g) { Wx[i][g] += a * gq[g] + bk * gk[g]; Wm[i][g] += cv * gv[g]; } } }
    }
    const int r0 = item * 64, tm0 = r0 % SEQ_;
    float x3[4], x2[4], x1[4], x0[4];
    auto ldx = [&](int row, float* x) { const u32x2 raw = *(const u32x2*)(U + (size_t)row * INW + 4 * j); x[0] = bflo(raw.x); x[1] = bfhi(raw.x); x[2] = bflo(raw.y); x[3] = bfhi(raw.y); };
#pragma unroll
    for (int c = 0; c < 4; ++c) { x3[c] = 0.f; x2[c] = 0.f; x1[c] = 0.f; }
    if (tm0 > 0) { ldx(r0 - 3, x3); ldx(r0 - 2, x2); ldx(r0 - 1, x1); }
    for (int tb = 0; tb < 8; ++tb) {
        __syncthreads();
        if (tid < 384) {
            u32x2 xraw[8];
#pragma unroll
            for (int tt = 0; tt < 8; ++tt) xraw[tt] = *(const u32x2*)(U + (size_t)(r0 + tb * 8 + tt) * INW + 4 * j);
#pragma unroll
            for (int tt = 0; tt < 8; ++tt) { const int row = r0 + tb * 8 + tt; x0[0] = bflo(xraw[tt].x); x0[1] = bfhi(xraw[tt].x); x0[2] = bflo(xraw[tt].y); x0[3] = bfhi(xraw[tt].y); float xc[4];
#pragma unroll
                for (int c = 0; c < 4; ++c) xc[c] = siluf_(cb[c] + cw[0][c] * x3[c] + cw[1][c] * x2[c] + cw[2][c] * x1[c] + cw[3][c] * x0[c]);
                u32x2 w; w.x = cvt_pk_bf16(xc[0], xc[1]); w.y = cvt_pk_bf16(xc[2], xc[3]); *(u32x2*)(XC + (size_t)row * MIXW + 4 * j) = w;
#pragma unroll
                for (int g = 0; g < 8; ++g) { float s = 0.f;
#pragma unroll
                    for (int i = 0; i < 4; ++i) s += xc[i] * Wx[i][g] + x0[i] * Wm[i][g];
                    lds_st<float>(L, ((tt * 8 + g) * 388 + tid) * 4, s); }
#pragma unroll
                for (int c = 0; c < 4; ++c) { x3[c] = x2[c]; x2[c] = x1[c]; x1[c] = x0[c]; } }
        }
        __syncthreads();
        {
            const int row = tid >> 3, part = tid & 7; float s = 0.f;
#pragma unroll
            for (int i = 0; i < 12; ++i) { const f32x4 v = lds_ld<f32x4>(L, (row * 388 + part * 48 + 4 * i) * 4); s += (v[0] + v[1]) + (v[2] + v[3]); }
            s += __shfl_xor(s, 1); s += __shfl_xor(s, 2); s += __shfl_xor(s, 4);
            if (part == 0) { const int g = row & 7; const float v = s + p.in[28][jl * 8 + g]; G[(size_t)(r0 + tb * 8 + (row >> 3)) * 8 + g] = g < 4 ? v : -softplusf_(-v); }
        }
    }
}

__device__ __forceinline__ void ml2_item(CP& p, int jl, int item, lds_t L) {
    constexpr int QIo = 0, KIo = 50176, VIo = 100352, PTo = 109568, WQKo = 118784, WVo = 131072, SCo = 132096, NSo = 134144, OXo = 0;
    constexpr int IBo = SCo, MTo = SCo + 256, WIo = SCo + 512, EMo = SCo + 768, WSo = SCo + 1024, DNo = SCo + 1280, NQo = SCo + 1536, MIo = SCo + 1792;
    int tid_ = threadIdx.x; asm volatile("" : "+v"(tid_)); const int tid = tid_, lane = tid & 63, wid = tid >> 6, fr = lane & 15, fq = lane >> 4;
    const int slot_ = item >> 3, pair_ = (item & 7) * 4 + slot_ / 6, b = pair_ >> 2, hh = pair_ & 3, vb = slot_ % 6;
    const int vt = wid & 3, kh = wid >> 2;
    const bf16_t* U = (const bf16_t*)(p.ws + WS_U); const bf16_t* XC = (const bf16_t*)(p.ws + WS_XC); const float* G = (const float*)(p.ws + WS_G); bf16_t* HO = (bf16_t*)(p.ws + WS_HOUT);
    __syncthreads();
    for (int idx = tid; idx < 3072; idx += NTHR) { const int jb = idx >> 5, e = idx & 31; const size_t bo = ((size_t)jl * 384 + hh * 96 + jb) * 16;
        lds_st<float>(L, WQKo + idx * 4, e < 16 ? p.in[24][bo + e] : p.in[25][bo + e - 16]); }
    if (tid < 256) lds_st<float>(L, WVo + tid * 4, p.in[26][((size_t)jl * 384 + hh * 96 + vb * 16 + (tid >> 4)) * 16 + (tid & 15)]);
    if (tid < 384) lds_st<float>(L, NSo + tid * 4, 0.f);
    f32x4 CT[12];
#pragma unroll
    for (int i = 0; i < 12; ++i) CT[i] = (f32x4){0.f, 0.f, 0.f, 0.f};
    float m_cur = 0.f;
    const int cg = tid % 48, rg = (tid / 48) & 7;
    u32x4 pre[4]; float pli = 0.f, plf = 0.f;
    if (tid < 384) {
#pragma unroll
        for (int it = 0; it < 4; ++it) pre[it] = *(const u32x4*)(XC + (size_t)(b * SEQ_ + rg * 8 + it) * MIXW + hh * 384 + 8 * cg);
    }
    if (wid == 0) { pli = G[(size_t)(b * SEQ_ + lane) * 8 + hh]; plf = G[(size_t)(b * SEQ_ + lane) * 8 + 4 + hh]; }
    for (int c = 0; c < 32; ++c) {
        const int r0 = b * SEQ_ + 64 * c;
        __syncthreads();
        if (wid == 0) {
            const float li = pli, lf = plf;
            float bc = lf;
#pragma unroll
            for (int d = 1; d < 64; d <<= 1) { const float v = __shfl_up(bc, d); if (lane >= d) bc += v; }
            const float ib = li - bc; float pm = ib;
#pragma unroll
            for (int d = 1; d < 64; d <<= 1) { const float v = __shfl_up(pm, d); if (lane >= d) pm = fmaxf(pm, v); }
            const float Mt = fmaxf(m_cur, pm), M63 = __shfl(Mt, 63), bl = __shfl(bc, 63);
            lds_st<float>(L, IBo + lane * 4, ib); lds_st<float>(L, MTo + lane * 4, Mt); lds_st<float>(L, WIo + lane * 4, __expf(m_cur - Mt)); lds_st<float>(L, EMo + lane * 4, __expf(-(bc + Mt)));
            lds_st<float>(L, WSo + lane * 4, __expf(ib - M63)); lds_st<float>(L, DNo + lane * 4, 0.f);
            if (lane == 0) { lds_st<float>(L, MIo, __expf(m_cur - M63)); lds_st<float>(L, MIo + 4, bl + M63); }
        }
        if (tid < 384) {
            u32x4 late[4];
#pragma unroll
            for (int it = 0; it < 4; ++it) late[it] = *(const u32x4*)(XC + (size_t)(r0 + rg * 8 + 4 + it) * MIXW + hh * 384 + 8 * cg);
#pragma unroll
            for (int bk = 0; bk < 2; ++bk) {
                f32x4 wqv[4], wkv[4];
#pragma unroll
                for (int i = 0; i < 4; ++i) { wqv[i] = lds_ld<f32x4>(L, WQKo + (2 * cg + bk) * 128 + i * 16); wkv[i] = lds_ld<f32x4>(L, WQKo + (2 * cg + bk) * 128 + 64 + i * 16); }
#pragma unroll
                for (int it = 0; it < 8; ++it) { const int t = rg * 8 + it; const u32x4 raw = it < 4 ? pre[it] : late[it - 4];
                    const unsigned w0 = bk ? raw.z : raw.x, w1 = bk ? raw.w : raw.y;
                    const float x0 = bflo(w0), x1 = bfhi(w0), x2 = bflo(w1), x3 = bfhi(w1);
                    const f32x4 aq = wqv[0] * x0 + wqv[1] * x1 + wqv[2] * x2 + wqv[3] * x3;
                    const f32x4 ak = (wkv[0] * x0 + wkv[1] * x1 + wkv[2] * x2 + wkv[3] * x3) * 0.05103103630798288f;
                    u32x2 qw, kw; qw.x = cvt_pk_bf16(aq[0], aq[1]); qw.y = cvt_pk_bf16(aq[2], aq[3]); kw.x = cvt_pk_bf16(ak[0], ak[1]); kw.y = cvt_pk_bf16(ak[2], ak[3]);
                    lds_st<u32x2>(L, QIo + t * 784 + cg * 16 + bk * 8, qw); lds_st<u32x2>(L, KIo + t * 784 + cg * 16 + bk * 8, kw);
                    if ((it & 1) == 1) __builtin_amdgcn_sched_barrier(0); }
            }
        } else {
#pragma unroll 4
            for (int it = 0; it < 8; ++it) { const int e = (tid - 384) + 128 * it, t = e >> 4, jb = e & 15;
                const u32x2 raw = *(const u32x2*)(U + (size_t)(r0 + t) * INW + hh * 384 + vb * 64 + 4 * jb);
                const float x[4] = {bflo(raw.x), bfhi(raw.x), bflo(raw.y), bfhi(raw.y)};
                f32x4 av = lds_ld<f32x4>(L, WVo + jb * 64) * x[0];
#pragma unroll
                for (int i = 1; i < 4; ++i) av = av + lds_ld<f32x4>(L, WVo + jb * 64 + i * 16) * x[i];
                u32x2 w; w.x = cvt_pk_bf16(av[0], av[1]); w.y = cvt_pk_bf16(av[2], av[3]); lds_st<u32x2>(L, VIo + t * 144 + jb * 8, w); }
        }
        __syncthreads();
        const float decay = lds_ld<float>(L, MIo), m_new = lds_ld<float>(L, MIo + 4);
        {
            const int tt = wid & 3, hf = wid >> 2;
            f32x4 s0 = (f32x4){0.f, 0.f, 0.f, 0.f}, s1 = s0;
            const bool do0 = (2 * hf) <= tt, do1 = (2 * hf + 1) <= tt;
            if (do0) {
#pragma unroll
                for (int ks = 0; ks < 12; ++ks) { const bf16x8 bq = lds_ld<bf16x8>(L, QIo + (16 * tt + fr) * 784 + (32 * ks + 8 * fq) * 2);
                    s0 = MFMA16(lds_ld<bf16x8>(L, KIo + (32 * hf + fr) * 784 + (32 * ks + 8 * fq) * 2), bq, s0);
                    if (do1) s1 = MFMA16(lds_ld<bf16x8>(L, KIo + (32 * hf + 16 + fr) * 784 + (32 * ks + 8 * fq) * 2), bq, s1);
                    if ((ks & 3) == 3) __builtin_amdgcn_sched_barrier(0); } }
            const int t = 16 * tt + fr; const float Mt = lds_ld<float>(L, MTo + t * 4); float psum = 0.f;
#pragma unroll
            for (int sti = 0; sti < 2; ++sti) { const int sb = 32 * hf + 16 * sti + 4 * fq; const f32x4 ibv = lds_ld<f32x4>(L, IBo + sb * 4); f32x4 sv = sti ? s1 : s0; float pv[4];
#pragma unroll
                for (int rg = 0; rg < 4; ++rg) { const int s = sb + rg; pv[rg] = (s <= t) ? sv[rg] * __expf(ibv[rg] - Mt) : 0.f; psum += pv[rg]; }
                u32x2 w; w.x = cvt_pk_bf16(pv[0], pv[1]); w.y = cvt_pk_bf16(pv[2], pv[3]); lds_st<u32x2>(L, PTo + t * 144 + sb * 2, w); }
            psum += __shfl_xor(psum, 16); psum += __shfl_xor(psum, 32);
            if (fq == 0) __hip_atomic_fetch_add((LAS float*)(L + DNo + t * 4), psum, __ATOMIC_RELAXED, __HIP_MEMORY_SCOPE_WORKGROUP);
        }
        f32x4 ao[4];
#pragma unroll
        for (int i = 0; i < 4; ++i) ao[i] = (f32x4){0.f, 0.f, 0.f, 0.f};
#pragma unroll
        for (int i = 0; i < 6; ++i) { const bf16x8 af = pack8(CT[2 * i], CT[2 * i + 1]);
#pragma unroll
            for (int t2 = 0; t2 < 4; ++t2) { const int qo = QIo + (16 * t2 + fr) * 784 + (192 * kh + 32 * i + 4 * fq) * 2;
                const s16x4 lo = lds_ld<s16x4>(L, qo), hi = lds_ld<s16x4>(L, qo + 32);
                ao[t2] = MFMA16(af, __builtin_shufflevector(lo, hi, 0, 1, 2, 3, 4, 5, 6, 7), ao[t2]); }
            __builtin_amdgcn_sched_barrier(0); }
#pragma unroll
        for (int t2 = 0; t2 < 4; ++t2) { const float wi = lds_ld<float>(L, WIo + (16 * t2 + fr) * 4); ao[t2] = ao[t2] * wi; }
        {
            const int t = tid >> 3, part = tid & 7; float s = 0.f;
#pragma unroll
            for (int i = 0; i < 6; ++i) { const u32x4 raw = lds_ld<u32x4>(L, QIo + t * 784 + part * 96 + i * 16);
                const f32x4 n0 = lds_ld<f32x4>(L, NSo + (part * 48 + i * 8) * 4), n1 = lds_ld<f32x4>(L, NSo + (part * 48 + i * 8 + 4) * 4);
                s += bflo(raw.x) * n0[0] + bfhi(raw.x) * n0[1] + bflo(raw.y) * n0[2] + bfhi(raw.y) * n0[3] + bflo(raw.z) * n1[0] + bfhi(raw.z) * n1[1] + bflo(raw.w) * n1[2] + bfhi(raw.w) * n1[3]; }
            s += __shfl_xor(s, 1); s += __shfl_xor(s, 2); s += __shfl_xor(s, 4);
            if (part == 0) lds_st<float>(L, NQo + t * 4, s);
        }
        __syncthreads();
        if (c + 1 < 32) {
            if (tid < 384) {
#pragma unroll
                for (int it = 0; it < 4; ++it) pre[it] = *(const u32x4*)(XC + (size_t)(r0 + 64 + rg * 8 + it) * MIXW + hh * 384 + 8 * cg);
            }
            if (wid == 0) { pli = G[(size_t)(r0 + 64 + lane) * 8 + hh]; plf = G[(size_t)(r0 + 64 + lane) * 8 + 4 + hh]; }
        }
        {
            const int o0 = VIo + (32 * kh + 8 * fq + (fr >> 2)) * 144 + (16 * vt + 4 * (fr & 3)) * 2;
            const bf16x8 av = tr_pair(L, o0, o0 + 4 * 144);
#pragma unroll
            for (int t2 = 0; t2 < 4; ++t2) ao[t2] = MFMA16(av, lds_ld<bf16x8>(L, PTo + (16 * t2 + fr) * 144 + (32 * kh + 8 * fq) * 2), ao[t2]);
        }
        if (kh == 1) {
#pragma unroll
            for (int t2 = 0; t2 < 4; ++t2)
#pragma unroll
                for (int rg = 0; rg < 4; ++rg) lds_st<float>(L, OXo + ((vt * 16 + 4 * fq + rg) * 64 + 16 * t2 + fr) * 4, ao[t2][rg]);
        }
        {
            bf16x8 bv[2];
#pragma unroll
            for (int ks = 0; ks < 2; ++ks) { const int o0 = VIo + (32 * ks + 8 * fq + (fr >> 2)) * 144 + (16 * vt + 4 * (fr & 3)) * 2;
                const bf16x8 raw = tr_pair(L, o0, o0 + 4 * 144); const u32x4 rw = __builtin_bit_cast(u32x4, raw);
                const f32x4 w0 = lds_ld<f32x4>(L, WSo + (32 * ks + 8 * fq) * 4), w1 = lds_ld<f32x4>(L, WSo + (32 * ks + 8 * fq + 4) * 4);
                u32x4 o; o.x = cvt_pk_bf16(bflo(rw.x) * w0[0], bfhi(rw.x) * w0[1]); o.y = cvt_pk_bf16(bflo(rw.y) * w0[2], bfhi(rw.y) * w0[3]);
                o.z = cvt_pk_bf16(bflo(rw.z) * w1[0], bfhi(rw.z) * w1[1]); o.w = cvt_pk_bf16(bflo(rw.w) * w1[2], bfhi(rw.w) * w1[3]);
                bv[ks] = __builtin_bit_cast(bf16x8, o); }
#pragma unroll
            for (int kt = 0; kt < 12; ++kt) { f32x4 a = CT[kt] * decay;
#pragma unroll
                for (int ks = 0; ks < 2; ++ks) { const int o0 = KIo + (32 * ks + 8 * fq + (fr >> 2)) * 784 + (192 * kh + 16 * kt + 4 * (fr & 3)) * 2;
                    a = MFMA16(tr_pair(L, o0, o0 + 4 * 784), bv[ks], a); }
                CT[kt] = a; if ((kt & 1) == 1) __builtin_amdgcn_sched_barrier(0); }
        }
        if (tid < 192) { float n0 = decay * lds_ld<float>(L, NSo + tid * 8), n1 = decay * lds_ld<float>(L, NSo + tid * 8 + 4);
#pragma unroll 4
            for (int s4 = 0; s4 < 16; ++s4) { const f32x4 w4 = lds_ld<f32x4>(L, WSo + s4 * 16);
#pragma unroll
                for (int j = 0; j < 4; ++j) { const unsigned kk = lds_ld<unsigned>(L, KIo + (4 * s4 + j) * 784 + tid * 4); n0 += w4[j] * bflo(kk); n1 += w4[j] * bfhi(kk); } }
            lds_st<float>(L, NSo + tid * 8, n0); lds_st<float>(L, NSo + tid * 8 + 4, n1); }
        __syncthreads();
        if (kh == 0) {
#pragma unroll
            for (int t2 = 0; t2 < 4; ++t2) { const int t = 16 * t2 + fr;
                const float dn = fmaxf(fabsf(lds_ld<float>(L, DNo + t * 4) + lds_ld<float>(L, WIo + t * 4) * lds_ld<float>(L, NQo + t * 4)), lds_ld<float>(L, EMo + t * 4));
                const float inv = frcp_(dn); float hv[4];
#pragma unroll
                for (int rg = 0; rg < 4; ++rg) hv[rg] = (ao[t2][rg] + lds_ld<float>(L, OXo + ((vt * 16 + 4 * fq + rg) * 64 + t) * 4)) * inv;
                u32x2 w; w.x = cvt_pk_bf16(hv[0], hv[1]); w.y = cvt_pk_bf16(hv[2], hv[3]);
                *(u32x2*)(HO + (size_t)(r0 + t) * MIXW + hh * 384 + vb * 64 + 16 * vt + 4 * fq) = w; }
        }
        m_cur = m_new;
    }
}

__device__ __forceinline__ void phase_ml3(CP& p, int jl) {
    int tid_ = threadIdx.x; asm volatile("" : "+v"(tid_)); const int tid = tid_, lane = tid & 63, wid = tid >> 6;
    bf16_t* U = (bf16_t*)(p.ws + WS_U); const bf16_t* XC = (const bf16_t*)(p.ws + WS_XC); const bf16_t* HO = (const bf16_t*)(p.ws + WS_HOUT);
    const int gw = blockIdx.x * 8 + wid, nw = gridDim.x * 8, hh = gw & 3;
    float lg[6], sk[6];
#pragma unroll
    for (int i = 0; i < 3; ++i) { const int c = jl * MIXW + hh * 384 + 128 * i + 2 * lane; lg[2 * i] = p.in[29][c]; lg[2 * i + 1] = p.in[29][c + 1]; sk[2 * i] = p.in[30][c]; sk[2 * i + 1] = p.in[30][c + 1]; }
    for (int rb = (gw >> 2) * 4; rb < T_; rb += (nw >> 2) * 4) {
        unsigned hr[4][3], xr[4][3], gr[4][3];
#pragma unroll
        for (int r = 0; r < 4; ++r)
#pragma unroll
            for (int i = 0; i < 3; ++i) { const int c = hh * 384 + 128 * i + 2 * lane; const size_t row = (size_t)(rb + r);
                hr[r][i] = *(const unsigned*)(HO + row * MIXW + c); xr[r][i] = *(const unsigned*)(XC + row * MIXW + c); gr[r][i] = *(const unsigned*)(U + row * INW + MIXW + c); }
#pragma unroll
        for (int r = 0; r < 4; ++r) { float h[6]; float s = 0.f;
#pragma unroll
            for (int i = 0; i < 3; ++i) { h[2 * i] = bflo(hr[r][i]); h[2 * i + 1] = bfhi(hr[r][i]); s += h[2 * i] + h[2 * i + 1]; }
            const float mu = wave_sum(s) * (1.0f / 384.0f); float v2 = 0.f;
#pragma unroll
            for (int i = 0; i < 6; ++i) { h[i] -= mu; v2 += h[i] * h[i]; }
            const float rstd = rsqrtf(wave_sum(v2) * (1.0f / 384.0f) + EPS_);
#pragma unroll
            for (int i = 0; i < 3; ++i) { const int c = hh * 384 + 128 * i + 2 * lane;
                const float y0 = (h[2 * i] * rstd * lg[2 * i] + sk[2 * i] * bflo(xr[r][i])) * siluf_(bflo(gr[r][i]));
                const float y1 = (h[2 * i + 1] * rstd * lg[2 * i + 1] + sk[2 * i + 1] * bfhi(xr[r][i])) * siluf_(bfhi(gr[r][i]));
                *(unsigned*)(U + (size_t)(rb + r) * INW + MIXW + c) = cvt_pk_bf16(y0, y1); } }
    }
}

__device__ __forceinline__ void phase_final(CP& p) {
    int tid_ = threadIdx.x; asm volatile("" : "+v"(tid_)); const int tid = tid_, lane = tid & 63, wid = tid >> 6; float* out = p.out; const float* g = p.in[31]; const bf16_t* HB = (const bf16_t*)(p.ws + WS_HB);
    for (int row = blockIdx.x * 8 + wid; row < T_; row += gridDim.x * 8) { float v[16]; float s2 = 0.f;
#pragma unroll
        for (int i = 0; i < 2; ++i) { const u32x4 hw = *(const u32x4*)(HB + (size_t)row * D_ + i * 512 + lane * 8);
            v[8 * i + 0] = bflo(hw.x); v[8 * i + 1] = bfhi(hw.x); v[8 * i + 2] = bflo(hw.y); v[8 * i + 3] = bfhi(hw.y); v[8 * i + 4] = bflo(hw.z); v[8 * i + 5] = bfhi(hw.z); v[8 * i + 6] = bflo(hw.w); v[8 * i + 7] = bfhi(hw.w); }
#pragma unroll
        for (int i = 0; i < 16; ++i) s2 += v[i] * v[i];
        const float rs = rsqrtf(wave_sum(s2) * (1.0f / 1024.0f) + EPS_);
#pragma unroll
        for (int i = 0; i < 2; ++i) { const int c = i * 512 + lane * 8; const f32x4 g0 = *(const f32x4*)(g + c), g1 = *(const f32x4*)(g + c + 4);
            *(f32x4*)(out + (size_t)row * D_ + c) = (f32x4){v[8 * i] * rs * g0[0], v[8 * i + 1] * rs * g0[1], v[8 * i + 2] * rs * g0[2], v[8 * i + 3] * rs * g0[3]};
            *(f32x4*)(out + (size_t)row * D_ + c + 4) = (f32x4){v[8 * i + 4] * rs * g1[0], v[8 * i + 5] * rs * g1[1], v[8 * i + 6] * rs * g1[2], v[8 * i + 7] * rs * g1[3]}; } }
}

constexpr int MK_PRO = 1, MK_GEMM = 2, MK_LRU = 4, MK_XA = 8, MK_ML1 = 16, MK_ML2 = 32, MK_ML3 = 64, MK_FIN = 128, MK_ALL = 255;
template <int MASK>
__global__ void __launch_bounds__(NTHR, 2) mega(P p_arg) {
    extern __shared__ __attribute__((aligned(16))) unsigned char shm[];
    lds_t L = (lds_t)shm;
    cg::grid_group grid = cg::this_grid();
    CP* kp0 = (CP*)__builtin_amdgcn_kernarg_segment_ptr();
    const int G = (int)gridDim.x, bid = (int)blockIdx.x;
    const int ph_lo = p_arg.ph_lo, ph_hi = p_arg.ph_hi, coop = p_arg.coop, sub = p_arg.pad;
    __builtin_amdgcn_fence(__ATOMIC_ACQUIRE, "agent");
    if (threadIdx.x < 4) *(volatile LAS unsigned*)(L + LDS_BYTES - 16 + 4 * threadIdx.x) = 0u;
    __syncthreads();
    XcdBarrier xbar = xcd_barrier_post((unsigned*)(p_arg.ws + WS_BAR), (volatile LAS unsigned*)(L + LDS_BYTES - 16));
    for (int ph = ph_lo; ph < ph_hi; ++ph) {
        CP* kp = kp0; asm volatile("" : "+s"(kp)); CP& p = *kp; unsigned char* ws = p.ws;
        int type, l = 0;
        if (ph == 0) type = 0; else if (ph == 33) type = 11;
        else { const int q = ph - 1, pr = q >> 4, r = q & 15;
            if (r < 7) { l = 2 * pr; type = r < 3 ? r + 1 : (r == 3 ? 4 : r + 4); }
            else { l = 2 * pr + 1; const int r2 = r - 7; type = r2 < 3 ? r2 + 1 : r2 + 2; } }
        const unsigned char* wb = ws + WS_WB + (size_t)l * WL_LAYER; const int jl = l >> 1;
        float* SS = (float*)(ws + WS_SS); bf16_t* HB = (bf16_t*)(ws + WS_HB); bf16_t* U = (bf16_t*)(ws + WS_U);
#ifdef PROBE_REP_TYPES
        const int nrep = ((PROBE_REP_TYPES >> type) & 1) ? 2 : 1;
#else
        const int nrep = 1;
#endif
        for (int rep = 0; rep < nrep; ++rep) {
        if (type == 0) { if constexpr ((MASK & MK_PRO) != 0) phase_prologue(p, L); }
        else {
        const bool split = (l == 3) && coop && G == 256;
        const bool gemm_now = (type == 1 || type == 9 || type == 2 || type == 8 || type == 10 || type == 3) || (type == 6 && split && bid >= 192);
        if (gemm_now) {
            if constexpr ((MASK & MK_GEMM) != 0) {
            const int npass = ((type == 3 && !split) || (type == 1 && split)) ? 2 : 1;
            for (int pass = 0; pass < npass; ++pass) {
                pg8::Gemm g; pg8::EpiAll E; int c = bid, Ge = G, sf = 1 << 30, sl = 0;
                g.M = T_; g.N = 1024; g.K = 1024; g.lda = 1024; g.A = HB; E.O = U; E.ldc = INW; E.H = p.out; E.ssn = SS; E.ss = SS;
                const bool kvpass = (type == 3 && !split && pass == 0) || (type == 1 && split && pass == 1);
                if (kvpass) { E.mode = 1; g.A = (const bf16_t*)(ws + WS_MEMB); g.Bt = (const bf16_t*)(wb + WL_KV); g.M = MEMT; E.O = (bf16_t*)(ws + WS_KVM); E.ldc = 1024; E.ss = (const float*)(ws + WS_SSM);
                    if (type == 1) c = bid >= 128 ? bid - 128 : (1 << 20); }
                else if (type == 1 || type == 9) { g.Bt = (const bf16_t*)(wb + (type == 1 ? WL_GU1 : WL_GU2)); g.N = 5632; E.mode = 0; }
                else if (type == 3) { E.mode = 1; g.Bt = (const bf16_t*)(wb + WL_IN);
                    if (split) { g.N = 2048; sf = 6; sl = 6; }
                    else { g.N = INW; c = (bid + (G / 16) * 8) % G; } }
                else if (type == 6) { E.mode = 1; g.Bt = (const bf16_t*)(wb + WL_IN); g.N = 1536; sf = 0; sl = 6; Ge = 64; c = bid - 192; }
                else { E.mode = 2; E.O = HB; E.ssn = SS;
                    if (type == 8) { g.A = U + MIXW; g.Bt = (const bf16_t*)(wb + WL_OUT); g.K = OUTW; g.lda = INW; }
                    else { g.A = U; g.Bt = (const bf16_t*)(wb + (type == 2 ? WL_D1 : WL_D2)); g.K = FF_; g.lda = FF_; } }
                pg8::StaticOrder S; S.init(g.M, g.N, Ge, c); S.sf = sf; S.sl = sl; pg8::gemm_phase(L, g, S, E);
            }
            if constexpr ((MASK & MK_PRO) != 0) {
                if (l == 0 && G == 256) {
                    if (type == 1 && bid >= 128) transpose_range(p, L, 5888 + (bid - 128), 5888 + 2200, 128);
                    else if (type == 3 && bid >= 32 && bid < 128) transpose_range(p, L, 5888 + 2200 + (bid - 32), 5888 + 3688, 96);
                    else if (type == 9 && bid >= 128) transpose_range(p, L, 5888 + 3688 + (bid - 128), 2 * 5888, 128);
                } else if (l == 0 && type == 9) transpose_range(p, L, 5888 + bid, 2 * 5888, G);
            } }
        }
        if (type == 4) {

            if constexpr ((MASK & MK_LRU) != 0) { if (sub != 2) for (int it = bid; it < 256; it += G) lru_item(p, jl, it, L); }
            if constexpr ((MASK & MK_XA) != 0) { if (sub != 1) { for (int it = bid; it < 512; it += G) xattn_item(p, it, L);
#ifdef DBG_THRASH
                { const u32x4* src = (const u32x4*)(ws + WS_WB) + (size_t)bid * 131072; unsigned acc = 0;
                  for (int i = threadIdx.x; i < 131072; i += NTHR) { const u32x4 v = src[i]; acc ^= v.x ^ v.y ^ v.z ^ v.w; }
                  if (acc == 0x12345u) ((unsigned*)(ws + WS_G))[0] = acc; }
#endif
            } }
        } else if (type == 5) { if constexpr ((MASK & MK_ML1) != 0) for (int it = bid; it < 256; it += G) ml1_item(p, jl, it, L); }
        else if (type == 6) {
            if (sub == 0 && G > 192) {
                if (bid < 192) { if constexpr ((MASK & MK_ML2) != 0) for (int r2_ = 0; r2_ < PROBE_ML2_REP; ++r2_) ml2_item(p, jl, bid, L); }
                else { if constexpr ((MASK & MK_XA) != 0) for (int it = bid - 192; it < 512; it += G - 192) xattn_item(p, it, L);
                       if constexpr ((MASK & MK_PRO) != 0) { if (l == 1) transpose_range(p, L, 2 * 5888 + bid - 192, 4 * 5888, G - 192); } }
            } else {
                if constexpr ((MASK & MK_ML2) != 0) { if (sub != 2) for (int it = bid; it < 192; it += G) ml2_item(p, jl, it, L); }
                if constexpr ((MASK & MK_XA) != 0) { if (sub != 1) for (int it = bid; it < 512; it += G) xattn_item(p, it, L); }
                if constexpr ((MASK & MK_PRO) != 0) { if (l == 1 && sub != 1) transpose_range(p, L, 2 * 5888 + bid, 4 * 5888, G); }
            }
        } else if (type == 7) { if constexpr ((MASK & MK_ML3) != 0) phase_ml3(p, jl); }
        else if (type == 11) { if constexpr ((MASK & MK_FIN) != 0) phase_final(p); }
        }
        }
#ifdef PROBE_XSYNC
        if (coop) for (int xs = 0; xs < PROBE_XSYNC; ++xs) grid.sync();
#endif
        if (coop && ph + 1 < ph_hi) {
            if (coop == 2) grid.sync();
            else xcd_barrier(xbar);
        }
    }
    __builtin_amdgcn_fence(__ATOMIC_RELEASE, "agent");
}
constexpr int NPH = 1 + 4 * 7 + 2 * 2 + 1;

#define DBG_NOXA 0
#define DBG_NOLRU 0
#define DBG_SKIP 0x0
#ifndef MK_LAUNCHES
#define MK_LAUNCHES 1
#endif

template <int MASK> static bool prep(int& per_cu) {
    if (hipFuncSetAttribute((const void*)mega<MASK>, hipFuncAttributeMaxDynamicSharedMemorySize, LDS_BYTES) != hipSuccess) { fprintf(stderr, "kernel_launch: hipFuncSetAttribute failed (mask %d)\n", MASK); return false; }
    if (hipOccupancyMaxActiveBlocksPerMultiprocessor(&per_cu, (const void*)mega<MASK>, NTHR, LDS_BYTES) != hipSuccess || per_cu < 1) { fprintf(stderr, "kernel_launch: occupancy query says %d (mask %d)\n", per_cu, MASK); per_cu = 1; }
    (void)hipGetLastError();
    return true;
}
template <int MASK> static void launch1(const P& p, int grid, hipStream_t stream) { hipLaunchKernelGGL(mega<MASK>, dim3(grid), dim3(NTHR), LDS_BYTES, stream, p); }

extern "C" void kernel_launch(void* const* d_in, const int* in_sizes, int n_in, void* d_out, int out_size, void* d_ws, size_t ws_size, hipStream_t stream) {
    static int grid = 0;
    if (grid == 0) {
        if (n_in != 32 || out_size != T_ * D_ || ws_size < WS_END) { fprintf(stderr, "kernel_launch: unexpected shapes (n_in %d out %d ws %zu need %zu)\n", n_in, out_size, ws_size, (size_t)WS_END); grid = -1; return; }
        int dev = 0, cus = 0, per_cu = 0;
        (void)hipGetDevice(&dev); (void)hipDeviceGetAttribute(&cus, hipDeviceAttributeMultiprocessorCount, dev);
        bool ok = true;
#if MK_LAUNCHES == 1
        ok = prep<MK_ALL>(per_cu);
#else
        ok = prep<MK_PRO>(per_cu) && prep<MK_GEMM>(per_cu) && prep<MK_LRU>(per_cu) && prep<MK_XA>(per_cu) && prep<MK_ML1>(per_cu) && prep<MK_ML2>(per_cu) && prep<MK_ML3>(per_cu) && prep<MK_FIN>(per_cu);
#endif
        if (!ok) { grid = -1; return; }
        grid = cus > 0 ? cus : 256;
    }
    if (grid < 0) return;
    P p{};
    for (int i = 0; i < 32; ++i) p.in[i] = (const float*)d_in[i];
    p.out = (float*)d_out; p.ws = (unsigned char*)d_ws;
#if MK_LAUNCHES == 1
    p.ph_lo = 0; p.ph_hi = NPH; p.coop = 1; p.pad = 0;
    (void)hipMemsetAsync((unsigned char*)d_ws + WS_BAR, 0, XCD_BAR_WORDS * 4, stream);
    void* args[] = {&p};
    hipError_t e = hipLaunchCooperativeKernel((const void*)mega<MK_ALL>, dim3(grid), dim3(NTHR), args, LDS_BYTES, stream);
    if (e != hipSuccess) fprintf(stderr, "cooperative launch failed: %s (grid %d)\n", hipGetErrorString(e), grid);
#else
    for (int i = 0; i < NPH; ++i) { p.ph_lo = i; p.ph_hi = i + 1; p.coop = 0; p.pad = 0;
        int type;
        if (i == 0) type = 0; else if (i == 33) type = 11; else { const int q = i - 1, r = q & 15; if (r < 7) type = r < 3 ? r + 1 : (r == 3 ? 4 : r + 4); else { const int r2 = r - 7; type = r2 < 3 ? r2 + 1 : r2 + 2; } }
        if (type == 0) launch1<MK_PRO>(p, grid, stream);
#ifdef DBG_SKIP
        else if (((DBG_SKIP >> type) & 1) != 0) {}
#endif
        else if (type == 4) { p.pad = 1; if (!DBG_NOLRU) launch1<MK_LRU>(p, grid, stream); p.pad = 2; if (!DBG_NOXA) launch1<MK_XA>(p, grid, stream); }
        else if (type == 5) launch1<MK_ML1>(p, grid, stream);
        else if (type == 6) { p.pad = 1; launch1<MK_ML2>(p, grid, stream); p.pad = 2; launch1<MK_XA>(p, grid, stream); }
        else if (type == 7) launch1<MK_ML3>(p, grid, stream);
        else if (type == 11) launch1<MK_FIN>(p, grid, stream);
        else launch1<MK_GEMM>(p, grid, stream);
    }
#endif
}
```

```cpp
#include <hip/hip_runtime.h>
#include <hip/hip_cooperative_groups.h>
#include <cstdio>
namespace cg = cooperative_groups;

#define PROBE_ML2_REP 1
#define LAS __attribute__((address_space(3)))
typedef unsigned short bf16_t;
typedef short bf16x8 __attribute__((ext_vector_type(8)));
typedef short s16x4 __attribute__((ext_vector_type(4)));
typedef float f32x4 __attribute__((ext_vector_type(4)));
typedef unsigned u32x4 __attribute__((ext_vector_type(4)));
typedef unsigned u32x2 __attribute__((ext_vector_type(2)));
typedef LAS unsigned char* lds_t;

constexpr int T_ = 16384, D_ = 1024, SEQ_ = 2048, NB_ = 8, FF_ = 2816, MIXW = 1536, INW = 3584, OUTW = 2048, MEMT = 2048;
constexpr float EPS_ = 1e-6f;
constexpr int NTHR = 512;
constexpr int LDS_BYTES = 152 * 1024;

constexpr size_t SZ_GU = (size_t)5632 * 1024 * 2, SZ_DN = (size_t)1024 * 2816 * 2, SZ_IN = (size_t)3584 * 1024 * 2, SZ_KV = (size_t)1024 * 1024 * 2, SZ_OUT = (size_t)1024 * 2048 * 2;
constexpr size_t WL_GU1 = 0, WL_D1 = WL_GU1 + SZ_GU, WL_IN = WL_D1 + SZ_DN, WL_KV = WL_IN + SZ_IN, WL_OUT = WL_KV + SZ_KV, WL_GU2 = WL_OUT + SZ_OUT, WL_D2 = WL_GU2 + SZ_GU, WL_LAYER = WL_D2 + SZ_DN;
constexpr size_t WS_WB = 0;
constexpr size_t WS_U = WS_WB + 4 * WL_LAYER;
constexpr size_t WS_XC = WS_U + (size_t)T_ * INW * 2;
constexpr size_t WS_HOUT = WS_XC + (size_t)T_ * MIXW * 2;
constexpr size_t WS_HB = WS_HOUT + (size_t)T_ * MIXW * 2;
constexpr size_t WS_MEMB = WS_HB + (size_t)T_ * D_ * 2;
constexpr size_t WS_KVM = WS_MEMB + (size_t)MEMT * D_ * 2;
constexpr size_t WS_G = WS_KVM + (size_t)MEMT * D_ * 2;
constexpr size_t WS_SS = WS_G + (size_t)T_ * 8 * 4;
constexpr size_t WS_SSM = WS_SS + (size_t)16 * T_ * 4;
constexpr size_t WS_BAR = WS_SSM + (size_t)MEMT * 16 * 4;
constexpr size_t WS_END = WS_BAR + 16384;

struct P {
    const float* in[32];
    float* out;
    unsigned char* ws;
    int ph_lo, ph_hi, coop, pad;
};
typedef const __attribute__((address_space(4))) P CP;

__device__ __forceinline__ unsigned cvt_pk_bf16(float lo, float hi) { unsigned r; asm("v_cvt_pk_bf16_f32 %0, %1, %2" : "=v"(r) : "v"(lo), "v"(hi)); return r; }
__device__ __forceinline__ float bflo(unsigned w) { return __uint_as_float(w << 16); }
__device__ __forceinline__ float bfhi(unsigned w) { return __uint_as_float(w & 0xffff0000u); }
__device__ __forceinline__ float bf2f(bf16_t b) { return __uint_as_float(((unsigned)b) << 16); }
__device__ __forceinline__ float frcp_(float x) { return __builtin_amdgcn_rcpf(x); }
__device__ __forceinline__ float sigmoidf_(float x) { return frcp_(1.0f + __expf(-x)); }
__device__ __forceinline__ float siluf_(float x) { return x * frcp_(1.0f + __expf(-x)); }
__device__ __forceinline__ float gelu_tanh_(float x) { const float u = 1.5957691216f * (x + 0.044715f * x * x * x); return x * frcp_(1.0f + __expf(-u)); }
__device__ __forceinline__ float softplusf_(float x) { return fmaxf(x, 0.f) + log1pf(__expf(-fabsf(x))); }
__device__ __forceinline__ float wave_sum(float v) {
#pragma unroll
    for (int d = 32; d >= 1; d >>= 1) v += __shfl_xor(v, d);
    return v;
}
template <class Tt> __device__ __forceinline__ Tt lds_ld(lds_t L, int off) { return *(const LAS Tt*)(L + off); }
template <class Tt> __device__ __forceinline__ void lds_st(lds_t L, int off, Tt v) { *(LAS Tt*)(L + off) = v; }
__device__ __forceinline__ bf16x8 tr_pair(lds_t L, int off0, int off1) {
    s16x4 a = __builtin_amdgcn_ds_read_tr16_b64_v4i16((LAS s16x4*)(L + off0));
    s16x4 b = __builtin_amdgcn_ds_read_tr16_b64_v4i16((LAS s16x4*)(L + off1));
    return __builtin_shufflevector(a, b, 0, 1, 2, 3, 4, 5, 6, 7);
}
__device__ __forceinline__ bf16x8 pack8(f32x4 a, f32x4 b) {
    u32x4 w; w.x = cvt_pk_bf16(a[0], a[1]); w.y = cvt_pk_bf16(a[2], a[3]); w.z = cvt_pk_bf16(b[0], b[1]); w.w = cvt_pk_bf16(b[2], b[3]);
    return __builtin_bit_cast(bf16x8, w);
}
__device__ __forceinline__ void st16_sc1(void* ptr, u32x4 v) { asm volatile("global_store_dwordx4 %0, %1, off sc1\n\ts_nop 2" :: "v"(ptr), "v"(v) : "memory"); }
#define MFMA16(a, b, c) __builtin_amdgcn_mfma_f32_16x16x32_bf16((a), (b), (c), 0, 0, 0)

#define XB_TMO      128
#define XB_XCNT(j)  (256  + 64 * (j))
#define XB_XSUB(j)  (1280 + 64 * (j))
#define XB_XGEN(j)  (2304 + 64 * (j))
#define XB_TOP      3328
#define XB_TOPGEN   3392
#define XCD_BAR_WORDS 3456
#define XB_SPIN_CAP (1u << 18)

__device__ __forceinline__ unsigned xb_ld(unsigned* p)              { return __hip_atomic_load(p, __ATOMIC_RELAXED, __HIP_MEMORY_SCOPE_AGENT); }
__device__ __forceinline__ unsigned xb_add(unsigned* p, unsigned v) { return __hip_atomic_fetch_add(p, v, __ATOMIC_RELAXED, __HIP_MEMORY_SCOPE_AGENT); }
__device__ __forceinline__ unsigned xb_xcc_id() { return (unsigned)__builtin_amdgcn_s_getreg((3 << 11) | 20) & 0xFu; }
#define XB_SPIN(cond, bar) do { unsigned _sp = 0; while (cond) { __builtin_amdgcn_s_sleep(1); \
    if ((++_sp & 255u) == 0u) { if (xb_ld(&(bar)[XB_TMO])) break; if (_sp > XB_SPIN_CAP) { atomicAdd(&(bar)[XB_TMO], 1u); break; } } } } while (0)

struct XcdBarrier {
    unsigned* bar; unsigned x;
    volatile LAS unsigned* st;
};

__device__ __forceinline__ XcdBarrier xcd_barrier_post(unsigned* bar, volatile LAS unsigned* st) {
    XcdBarrier b; b.bar = bar; b.x = xb_xcc_id(); b.st = st;
    if (threadIdx.x == 0) (void)xb_add(&bar[XB_XCNT(b.x)], 1u);
    return b;
}
__device__ __forceinline__ void xcd_barrier_complete(unsigned* bar, unsigned x, unsigned& nloc, unsigned& nx) {
    const unsigned G = gridDim.x * gridDim.y * gridDim.z;
    unsigned sum, cnt, mine, sp = 0u;
    for (;;) {
        sum = 0u; cnt = 0u; mine = 0u;
#pragma unroll
        for (unsigned j = 0; j < 16; ++j) { const unsigned c = xb_ld(&bar[XB_XCNT(j)]); sum += c; cnt += (c > 0u) ? 1u : 0u; mine = (j == x) ? c : mine; }
        if (sum == G) break;
        __builtin_amdgcn_s_sleep(1);
        if ((++sp & 255u) == 0u) { if (xb_ld(&bar[XB_TMO])) break; if (sp > XB_SPIN_CAP) { atomicAdd(&bar[XB_TMO], 1u); break; } }
    }
    nloc = mine > 0u ? mine : 1u; nx = cnt > 0u ? cnt : 1u;
}

__device__ __forceinline__ void xcd_barrier(const XcdBarrier& b) {
    asm volatile("s_waitcnt vmcnt(0)" ::: "memory");
    __syncthreads();
    if (threadIdx.x == 0) {
        unsigned* bar = b.bar;
        __builtin_amdgcn_s_waitcnt(0);
        unsigned nloc = b.st[0], nx = b.st[1];
        if (nloc == 0u) { xcd_barrier_complete(bar, b.x, nloc, nx); b.st[0] = nloc; b.st[1] = nx; }
        const unsigned old = xb_add(&bar[XB_XSUB(b.x)], 1u);
        const unsigned gen = old / nloc;
        if (old + 1u == (gen + 1u) * nloc) {
            __builtin_amdgcn_fence(__ATOMIC_RELEASE, "agent");
            asm volatile("s_waitcnt vmcnt(0)" ::: "memory");
            const unsigned og = xb_add(&bar[XB_TOP], 1u);
            const unsigned tg = og / nx;
            if (og + 1u == (tg + 1u) * nx) xb_add(&bar[XB_TOPGEN], 1u);
            else XB_SPIN(xb_ld(&bar[XB_TOPGEN]) == tg, bar);
            __builtin_amdgcn_fence(__ATOMIC_ACQUIRE, "agent");
            xb_add(&bar[XB_XGEN(b.x)], 1u);
            asm volatile("s_waitcnt vmcnt(0)" ::: "memory");
        } else {
            XB_SPIN(xb_ld(&bar[XB_XGEN(b.x)]) == gen, bar);
            __builtin_amdgcn_fence(__ATOMIC_ACQUIRE, "agent");
            asm volatile("s_waitcnt vmcnt(0)" ::: "memory");
        }
    }
    __syncthreads();
}


namespace pg8 {
constexpr int BM = 256, BK = 64, HALF = 128, HTB = HALF * BK * 2, NXCD = 8, WGM = 8;
__device__ __forceinline__ int lds_byte(int r, int c) { const int st = (r >> 4) * 2 + (c >> 5), rr = r & 15, cc = c & 31, ob = rr * 64 + cc * 2; return st * 1024 + (ob ^ (((ob >> 9) & 1) << 5)); }
__device__ __forceinline__ void stage_rc(int b, int& R, int& C) { const int st = b / 1024, sb = b % 1024, swz = sb ^ (((sb >> 9) & 1) << 5); R = (st >> 1) * 16 + swz / 64; C = (st & 1) * 32 + (swz % 64) / 2; }
__device__ __forceinline__ int perm32(int rho) { const int n = rho >> 4, i = rho & 15; return 8 * (i >> 2) + 4 * n + (i & 3); }
struct Unit { int pm, pn; };
struct Gemm { const bf16_t* A; const bf16_t* Bt; int M, N, K, lda; };
struct StaticOrder {
    int nM, nN, nwg, G, c, sf, sl;
    __device__ void init(int M, int N, int G_, int c_) { nM = M / BM; nN = N / BM; nwg = nM * nN; G = G_; c = c_; sf = 1 << 30; sl = 0; }
    __device__ bool next(int i, Unit& u) const {
        const long L = (long)i * G + c; if (L >= nwg) return false;
        int wgid = (int)L; { const int q = nwg / NXCD, r = nwg % NXCD, xcd = wgid % NXCD, off = wgid / NXCD; wgid = (xcd < r ? xcd * (q + 1) : r * (q + 1) + (xcd - r) * q) + off; }
        const int nig = WGM * nN, gid = wgid / nig, fm = gid * WGM, gsz = (nM - fm) < WGM ? (nM - fm) : WGM;
        u.pm = fm + ((wgid % nig) % gsz); u.pn = (wgid % nig) / gsz; if (u.pn >= sf) u.pn += sl; return true;
    }
};

template <class Epi>
__device__ __forceinline__ void gemm_phase(lds_t lds, const Gemm g, const StaticOrder& S, const Epi& E) {
    int tid_ = threadIdx.x; asm volatile("" : "+v"(tid_)); const int tid = tid_, wid = __builtin_amdgcn_readfirstlane(tid >> 6), lane = tid & 63, wr = wid >> 2, wc = wid & 3, fr = lane & 15, fq = lane >> 4;
    const int K = g.K, nt = K / BK, lda = g.lda;
    unsigned voffA[2], voffB[2];
#pragma unroll
    for (int i = 0; i < 2; ++i) { int R, C; stage_rc(tid * 16 + i * 8192, R, C); const int Rb = Epi::PERM ? ((R & ~31) + perm32(R & 31)) : R;
        voffA[i] = (unsigned)(R * lda + C) * 2u; voffB[i] = (unsigned)(Rb * K + C) * 2u; }
    const size_t kstep = (size_t)(BK * 2);
    const size_t hstepA = (size_t)HALF * lda * 2, hstepB = (size_t)HALF * K * 2;
    const size_t tstepA = 2 * hstepA, tstepB = 2 * hstepB;
    const unsigned ldsw = (unsigned)wid * 1024u;
    const int aoff = lds_byte(wr * 64 + fr, fq * 8), boff = lds_byte(wc * 32 + fr, fq * 8);
#define PG8_SA(b, h) (((b) * 2 + (h)) * HTB)
#define PG8_SB(b, h) ((4 + (b) * 2 + (h)) * HTB)
#define PG8_STAGE(bufoff, gbase, voff) do { _Pragma("unroll") for (int _i = 0; _i < 2; ++_i) \
        __builtin_amdgcn_global_load_lds((const unsigned*)((const char*)(gbase) + (voff)[_i]), (LAS unsigned*)(lds + (bufoff) + ldsw + _i * 8192), 16, 0, 0); } while (0)
#define PG8_LDA(dst, b, h) do { _Pragma("unroll") for (int m = 0; m < 4; ++m) _Pragma("unroll") for (int k = 0; k < 2; ++k) dst[m][k] = *(const LAS bf16x8*)(lds + PG8_SA(b, h) + aoff + m * 2048 + k * 1024); } while (0)
#define PG8_LDB(dst, b, h) do { _Pragma("unroll") for (int n = 0; n < 2; ++n) _Pragma("unroll") for (int k = 0; k < 2; ++k) dst[n][k] = *(const LAS bf16x8*)(lds + PG8_SB(b, h) + boff + n * 2048 + k * 1024); } while (0)
#define PG8_MMA(ai, bj, At, Bt) do { __builtin_amdgcn_s_setprio(1); _Pragma("unroll") for (int m = 0; m < 4; ++m) _Pragma("unroll") for (int n = 0; n < 2; ++n) _Pragma("unroll") for (int k = 0; k < 2; ++k) \
        acc[ai][bj][m][n] = __builtin_amdgcn_mfma_f32_16x16x32_bf16(Bt[n][k], At[m][k], acc[ai][bj][m][n], 0, 0, 0); __builtin_amdgcn_s_setprio(0); } while (0)
#define PG8_WAIT_V(n) asm volatile("s_waitcnt vmcnt(" #n ")" ::: "memory")
#define PG8_WAIT_L(n) asm volatile("s_waitcnt lgkmcnt(" #n ")" ::: "memory")
#define PG8_BAR __builtin_amdgcn_s_barrier()
#define PG8_SCHED __builtin_amdgcn_sched_barrier(0)
    Unit cur, nxt; int ui = 0;
    if (!S.next(0, cur)) return;
    f32x4 acc[2][2][4][2];
    E.init(acc, cur, wr, wc, fr, fq);
    bf16x8 At[4][2], B0[2][2], B1[2][2];
    E.rowscales(lds, tid * 32, cur.pm, wr, fr, fq);
    const char* cA = (const char*)g.A + (size_t)cur.pm * tstepA; const char* cB = (const char*)g.Bt + (size_t)cur.pn * tstepB;
    PG8_STAGE(PG8_SB(0, 0), cB, voffB); PG8_STAGE(PG8_SA(0, 0), cA, voffA); PG8_STAGE(PG8_SB(0, 1), cB + hstepB, voffB); PG8_STAGE(PG8_SA(0, 1), cA + hstepA, voffA);
    if (wr == 1) PG8_BAR;
    PG8_WAIT_V(4); PG8_BAR;
    PG8_STAGE(PG8_SB(1, 0), cB + kstep, voffB); PG8_STAGE(PG8_SA(1, 0), cA + kstep, voffA); PG8_STAGE(PG8_SB(1, 1), cB + hstepB + kstep, voffB);
    PG8_WAIT_V(6); PG8_BAR;
    for (;;) {
        const bool has_next = S.next(ui + 1, nxt);
        const char* nA = has_next ? (const char*)g.A + (size_t)nxt.pm * tstepA : cA; const char* nB = has_next ? (const char*)g.Bt + (size_t)nxt.pn * tstepB : cB;
        for (int t = 0; t < nt; t += 2) {
            const bool last = (t == nt - 2);
            const char* a1 = cA + (size_t)(t + 1) * kstep;
            const char* a2 = last ? nA : cA + (size_t)(t + 2) * kstep; const char* b2 = last ? nB : cB + (size_t)(t + 2) * kstep;
            const char* a3 = a2 + kstep; const char* b3 = b2 + kstep;
            PG8_LDB(B0, 0, 0); PG8_SCHED; PG8_LDA(At, 0, 0); PG8_STAGE(PG8_SA(1, 1), a1 + hstepA, voffA);
            PG8_WAIT_L(8); PG8_BAR; PG8_WAIT_L(0); PG8_MMA(0, 0, At, B0); PG8_BAR; PG8_SCHED;
            PG8_LDB(B1, 0, 1); PG8_STAGE(PG8_SB(0, 0), b2, voffB);
            PG8_BAR; PG8_WAIT_L(0); PG8_MMA(0, 1, At, B1); PG8_BAR;
            PG8_LDA(At, 0, 1); PG8_STAGE(PG8_SA(0, 0), a2, voffA);
            PG8_BAR; PG8_WAIT_L(0); PG8_MMA(1, 0, At, B0); PG8_BAR; PG8_SCHED;
            PG8_STAGE(PG8_SB(0, 1), b2 + hstepB, voffB);
            PG8_WAIT_V(6); PG8_BAR; PG8_MMA(1, 1, At, B1); PG8_BAR;
            PG8_LDB(B0, 1, 0); PG8_SCHED; PG8_LDA(At, 1, 0); PG8_STAGE(PG8_SA(0, 1), a2 + hstepA, voffA);
            PG8_WAIT_L(8); PG8_BAR; PG8_WAIT_L(0); PG8_MMA(0, 0, At, B0); PG8_BAR; PG8_SCHED;
            PG8_LDB(B1, 1, 1); PG8_STAGE(PG8_SB(1, 0), b3, voffB);
            PG8_BAR; PG8_WAIT_L(0); PG8_MMA(0, 1, At, B1); PG8_BAR;
            PG8_LDA(At, 1, 1); PG8_STAGE(PG8_SA(1, 0), a3, voffA);
            PG8_BAR; PG8_WAIT_L(0); PG8_MMA(1, 0, At, B0); PG8_BAR; PG8_SCHED;
            PG8_STAGE(PG8_SB(1, 1), b3 + hstepB, voffB);
            PG8_WAIT_V(6); PG8_BAR; PG8_MMA(1, 1, At, B1); PG8_BAR;
        }
        E(acc, lds, tid * 32, cur, wr, wc, fr, fq);
        if (!has_next) break;
        E.init(acc, nxt, wr, wc, fr, fq);
        if (nxt.pm != cur.pm) E.rowscales(lds, tid * 32, nxt.pm, wr, fr, fq);
        cur = nxt; cA = nA; cB = nB; ++ui;
    }
    PG8_WAIT_V(0);
    if (wr == 0) PG8_BAR;
    PG8_BAR;
#undef PG8_SA
#undef PG8_SB
#undef PG8_STAGE
#undef PG8_LDA
#undef PG8_LDB
#undef PG8_MMA
#undef PG8_WAIT_V
#undef PG8_WAIT_L
#undef PG8_BAR
#undef PG8_SCHED
}

__device__ __forceinline__ float rowscale(const float* ss, int row) {
    const f32x4 a = *(const f32x4*)(ss + (size_t)row * 16), b = *(const f32x4*)(ss + (size_t)row * 16 + 4), c = *(const f32x4*)(ss + (size_t)row * 16 + 8), d = *(const f32x4*)(ss + (size_t)row * 16 + 12);
    const float s = ((a[0] + a[1]) + (a[2] + a[3])) + ((b[0] + b[1]) + (b[2] + b[3])) + ((c[0] + c[1]) + (c[2] + c[3])) + ((d[0] + d[1]) + (d[2] + d[3]));
    return rsqrtf(s * (1.0f / 1024.0f) + EPS_); }

struct EpiAll {
    static constexpr bool PERM = true;
    int mode; bf16_t* O; int ldc; const float* ss; float* H; float* ssn;
    __device__ __forceinline__ void init(f32x4 (&acc)[2][2][4][2], const Unit& u, int wr, int wc, int fr, int fq) const {
        if (mode == 2) {
            const int row0 = u.pm * BM + wr * 64 + fr, col0 = u.pn * BM + wc * 32 + 8 * fq;
#pragma unroll
            for (int ai = 0; ai < 2; ++ai)
#pragma unroll
                for (int m = 0; m < 4; ++m)
#pragma unroll
                    for (int bj = 0; bj < 2; ++bj) { const u32x4 hw = *(const u32x4*)(O + (size_t)(row0 + ai * HALF + m * 16) * D_ + col0 + bj * HALF);
                        acc[ai][bj][m][0] = (f32x4){bflo(hw.x), bfhi(hw.x), bflo(hw.y), bfhi(hw.y)}; acc[ai][bj][m][1] = (f32x4){bflo(hw.z), bfhi(hw.z), bflo(hw.w), bfhi(hw.w)}; }
        } else {
#pragma unroll
            for (int a = 0; a < 2; ++a)
#pragma unroll
                for (int b = 0; b < 2; ++b)
#pragma unroll
                    for (int m = 0; m < 4; ++m)
#pragma unroll
                        for (int n = 0; n < 2; ++n) acc[a][b][m][n] = (f32x4){0.f, 0.f, 0.f, 0.f};
        }
    }
    __device__ __forceinline__ void rowscales(lds_t lds, int tslot, int pm, int wr, int fr, int fq) const {
        float rs[2][4];
        if (mode != 2) { const int row0 = pm * BM + wr * 64 + fr; f32x4 t[2][4];
#pragma unroll
            for (int ai = 0; ai < 2; ++ai)
#pragma unroll
                for (int m = 0; m < 4; ++m) t[ai][m] = *(const f32x4*)(ss + (size_t)(row0 + ai * HALF + m * 16) * 16 + 4 * fq);
#pragma unroll
            for (int ai = 0; ai < 2; ++ai)
#pragma unroll
                for (int m = 0; m < 4; ++m) { float sm = (t[ai][m][0] + t[ai][m][1]) + (t[ai][m][2] + t[ai][m][3]);
                    sm += __shfl_xor(sm, 16); sm += __shfl_xor(sm, 32);
                    rs[ai][m] = rsqrtf(sm * (1.0f / 1024.0f) + EPS_); }
            *(LAS f32x4*)(lds + 131072 + tslot) = (f32x4){rs[0][0], rs[0][1], rs[0][2], rs[0][3]};
            *(LAS f32x4*)(lds + 131072 + tslot + 16) = (f32x4){rs[1][0], rs[1][1], rs[1][2], rs[1][3]}; }
    }
    __device__ __forceinline__ void operator()(const f32x4 (&acc)[2][2][4][2], lds_t lds, int tslot, const Unit& u, int wr, int wc, int fr, int fq) const {
        const int row0 = u.pm * BM + wr * 64 + fr;
        if (mode != 2) {
            float rs[2][4];
            { const f32x4 r0 = *(const LAS f32x4*)(lds + 131072 + tslot), r1 = *(const LAS f32x4*)(lds + 131072 + tslot + 16);
              rs[0][0] = r0[0]; rs[0][1] = r0[1]; rs[0][2] = r0[2]; rs[0][3] = r0[3]; rs[1][0] = r1[0]; rs[1][1] = r1[1]; rs[1][2] = r1[2]; rs[1][3] = r1[3]; }
            if (mode == 0) {
                const int col0 = u.pn * 128 + wc * 32 + 8 * fq;
#pragma unroll
                for (int ai = 0; ai < 2; ++ai)
#pragma unroll
                    for (int m = 0; m < 4; ++m) { const int row = row0 + ai * HALF + m * 16; const float r1 = rs[ai][m];
                        float v[8];
#pragma unroll
                        for (int n = 0; n < 2; ++n)
#pragma unroll
                            for (int j = 0; j < 4; ++j) { const float gt = acc[ai][0][m][n][j] * r1, up = acc[ai][1][m][n][j] * r1; v[n * 4 + j] = siluf_(gt) * up; }
                        u32x4 w; w.x = cvt_pk_bf16(v[0], v[1]); w.y = cvt_pk_bf16(v[2], v[3]); w.z = cvt_pk_bf16(v[4], v[5]); w.w = cvt_pk_bf16(v[6], v[7]);
                        st16_sc1(O + (size_t)row * FF_ + col0, w); }
            } else {
                const int col0 = u.pn * BM + wc * 32 + 8 * fq;
#pragma unroll
                for (int ai = 0; ai < 2; ++ai)
#pragma unroll
                    for (int m = 0; m < 4; ++m) { const int row = row0 + ai * HALF + m * 16; const float r1 = rs[ai][m];
#pragma unroll
                        for (int bj = 0; bj < 2; ++bj) { const f32x4 v0 = acc[ai][bj][m][0] * r1, v1 = acc[ai][bj][m][1] * r1;
                            u32x4 w; w.x = cvt_pk_bf16(v0[0], v0[1]); w.y = cvt_pk_bf16(v0[2], v0[3]); w.z = cvt_pk_bf16(v1[0], v1[1]); w.w = cvt_pk_bf16(v1[2], v1[3]);
                            st16_sc1(O + (size_t)row * ldc + col0 + bj * HALF, w); } }
            }
        } else {
            const int col0 = u.pn * BM + wc * 32 + 8 * fq;
#pragma unroll
            for (int ai = 0; ai < 2; ++ai)
#pragma unroll
                for (int m = 0; m < 4; ++m) { const int row = row0 + ai * HALF + m * 16; float s2 = 0.f;
#pragma unroll
                    for (int bj = 0; bj < 2; ++bj) { const size_t o = (size_t)row * D_ + col0 + bj * HALF;
                        const f32x4 h0 = acc[ai][bj][m][0], h1 = acc[ai][bj][m][1];
                        u32x4 w; w.x = cvt_pk_bf16(h0[0], h0[1]); w.y = cvt_pk_bf16(h0[2], h0[3]); w.z = cvt_pk_bf16(h1[0], h1[1]); w.w = cvt_pk_bf16(h1[2], h1[3]);
                        st16_sc1(O + o, w);
                        s2 += h0[0] * h0[0] + h0[1] * h0[1] + h0[2] * h0[2] + h0[3] * h0[3] + h1[0] * h1[0] + h1[1] * h1[1] + h1[2] * h1[2] + h1[3] * h1[3]; }
                    s2 += __shfl_xor(s2, 16); s2 += __shfl_xor(s2, 32);
                    if (fq == 0) ssn[(size_t)row * 16 + u.pn * 4 + wc] = s2; }
        }
    }
};
}

struct TileDesc { const float* src; const float* gain; bf16_t* dst; float base; };
__device__ __forceinline__ int dim_of(int code) { return code == 0 ? FF_ : (code == 1 ? D_ : (code == 2 ? INW : OUTW)); }
__device__ __forceinline__ TileDesc tile_desc(CP& p, int g, int tid) {
    constexpr int TPL = 5888;
    const int l = g / TPL, r = g % TPL;
    const int seg = (r >= 704) + (r >= 1408) + (r >= 2112) + (r >= 3008) + (r >= 3264) + (r >= 3776) + (r >= 4480) + (r >= 5184);
    const int start = seg < 3 ? seg * 704 : (seg == 3 ? 2112 : (seg == 4 ? 3008 : (seg == 5 ? 3264 : 3776 + (seg - 6) * 704)));
    const int sh = 4 * seg;
    const int in_idx = (int)((0xEDCA97543ull >> sh) & 15), gidx = (int)((0x0CC097033ull >> sh) & 15), mode = (int)((0x021000021ull >> sh) & 15);
    const int N = dim_of((int)((0x100112100ull >> sh) & 15)), K = dim_of((int)((0x011311011ull >> sh) & 15));
    const size_t wl = seg < 2 ? WL_GU1 : (seg == 2 ? WL_D1 : (seg == 3 ? WL_IN : (seg == 4 ? WL_KV : (seg == 5 ? WL_OUT : (seg < 8 ? WL_GU2 : WL_D2)))));
    const int rr = r - start, ntn = N >> 6, kt = rr / ntn, nt = rr - kt * ntn;
    const float* W = p.in[in_idx] + (size_t)l * K * N;
    TileDesc d;
    d.src = W + (size_t)(kt * 64 + (tid >> 3)) * N + nt * 64 + (tid & 7) * 8;
    d.gain = gidx ? p.in[gidx - 1] + l * D_ + kt * 64 + (tid >> 3) : nullptr;
    const int nn = nt * 64 + (tid >> 3); const int drow = mode == 0 ? nn : ((nn >> 7) * 256 + (mode == 2 ? 128 : 0) + (nn & 127));
    d.dst = (bf16_t*)(p.ws + WS_WB + (size_t)l * WL_LAYER + wl) + (size_t)drow * K + kt * 64 + 8 * (tid & 7);
    d.base = (seg == 2 || seg == 8) ? 0.5f : 1.0f;
    return d;
}
__device__ __forceinline__ void transpose_range(CP& p, lds_t L, int g0, int gend, int stride) {
    int tid_ = threadIdx.x; asm volatile("" : "+v"(tid_)); const int tid = tid_;
    int g = g0; asm volatile("" : "+s"(g));
    f32x4 a = (f32x4){0.f, 0.f, 0.f, 0.f}, b = a; float gn = 1.f; TileDesc cur; cur.dst = nullptr;
    __syncthreads();
    if (g < gend) { cur = tile_desc(p, g, tid); a = *(const f32x4*)cur.src; b = *(const f32x4*)(cur.src + 4); gn = cur.base * (cur.gain ? *cur.gain : 1.0f); }
    for (; g < gend; g += stride) {
        const int gnx = g + stride; TileDesc nxt; nxt.dst = nullptr; f32x4 na = a, nb = b; float ng = 1.f;
        if (gnx < gend) { nxt = tile_desc(p, gnx, tid); na = *(const f32x4*)nxt.src; nb = *(const f32x4*)(nxt.src + 4); ng = nxt.base * (nxt.gain ? *nxt.gain : 1.0f); }
        { const int r = tid >> 3, c8 = (tid & 7) * 8, o = (r * 65 + c8) * 4;
          lds_st<float>(L, o, a[0] * gn); lds_st<float>(L, o + 4, a[1] * gn); lds_st<float>(L, o + 8, a[2] * gn); lds_st<float>(L, o + 12, a[3] * gn);
          lds_st<float>(L, o + 16, b[0] * gn); lds_st<float>(L, o + 20, b[1] * gn); lds_st<float>(L, o + 24, b[2] * gn); lds_st<float>(L, o + 28, b[3] * gn); }
        __syncthreads();
        { const int n = tid >> 3, kc = tid & 7; float v[8];
#pragma unroll
          for (int j = 0; j < 8; ++j) v[j] = lds_ld<float>(L, ((8 * kc + j) * 65 + n) * 4);
          u32x4 w; w.x = cvt_pk_bf16(v[0], v[1]); w.y = cvt_pk_bf16(v[2], v[3]); w.z = cvt_pk_bf16(v[4], v[5]); w.w = cvt_pk_bf16(v[6], v[7]);
          *(u32x4*)cur.dst = w; }
        __syncthreads();
        cur = nxt; a = na; b = nb; gn = ng;
    }
}

__device__ __forceinline__ void phase_prologue(CP& p, lds_t L) {
    int tid_ = threadIdx.x; asm volatile("" : "+v"(tid_)); const int tid = tid_, lane = tid & 63, wid = tid >> 6;
    unsigned char* ws = p.ws;
    { bf16_t* HB = (bf16_t*)(ws + WS_HB); float* ss = (float*)(ws + WS_SS); bf16_t* MB = (bf16_t*)(ws + WS_MEMB); float* ssm = (float*)(ws + WS_SSM);
      for (int row = blockIdx.x * 8 + wid; row < T_ + MEMT; row += gridDim.x * 8) {
          const bool isx = row < T_; const int r = isx ? row : row - T_;
          const float* src = (isx ? p.in[0] : p.in[1]) + (size_t)r * D_; float s2 = 0.f;
#pragma unroll
          for (int i = 0; i < 4; ++i) { const int c = i * 256 + lane * 4; const f32x4 v = *(const f32x4*)(src + c);
              s2 += v[0] * v[0] + v[1] * v[1] + v[2] * v[2] + v[3] * v[3];
              u32x2 w; w.x = cvt_pk_bf16(v[0], v[1]); w.y = cvt_pk_bf16(v[2], v[3]);
              if (isx) { *(u32x2*)(HB + (size_t)r * D_ + c) = w; } else { *(u32x2*)(MB + (size_t)r * D_ + c) = w; } }
          s2 = wave_sum(s2);
          if (lane < 16) { const float v = lane == 0 ? s2 : 0.f; if (isx) ss[(size_t)r * 16 + lane] = v; else ssm[(size_t)r * 16 + lane] = v; } } }
    transpose_range(p, L, blockIdx.x, 5888, gridDim.x);
}

__device__ __forceinline__ void lru_item(CP& p, int jl, int item, lds_t L) {
    constexpr int WLo = 0, XCo = 38400, AAo = 89600, UUo = 114176, SEGo = 138752, CARo = 141824;
    int tid_ = threadIdx.x; asm volatile("" : "+v"(tid_)); const int tid = tid_, lane = tid & 63, wid = tid >> 6, fr = lane & 15, fq = lane >> 4;
    const int pair_ = (item & 7) * 8 + (item >> 5), b = pair_ >> 3, n = pair_ & 7, q4 = (item >> 3) & 3;
    bf16_t* U = (bf16_t*)(p.ws + WS_U);
    const float* w_r = p.in[17] + ((size_t)(jl * 8 + n) * 192) * 192; const float* w_i = p.in[19] + ((size_t)(jl * 8 + n) * 192) * 192;
    __syncthreads();
#pragma unroll 1
    for (int r3 = 0; r3 < 3; ++r3) {
        float v[12];
#pragma unroll
        for (int k = 0; k < 12; ++k) { const int idx = tid + NTHR * (12 * r3 + k), i = idx / 96, oo = idx % 96; v[k] = (oo < 48 ? w_r : w_i)[(size_t)i * 192 + 48 * q4 + (oo % 48)]; }
#pragma unroll
        for (int k = 0; k < 12; ++k) { const int idx = tid + NTHR * (12 * r3 + k), i = idx / 96, oo = idx % 96; lds_st<bf16_t>(L, WLo + oo * 400 + i * 2, (bf16_t)(cvt_pk_bf16(v[k], 0.f) & 0xffffu)); }
    }
    if (tid < 96) lds_st<float>(L, CARo + tid * 4, 0.f);
    float br[3], bi[3], sp[3];
#pragma unroll
    for (int t3 = 0; t3 < 3; ++t3) { const int c = jl * MIXW + n * 192 + 48 * q4 + 16 * t3 + fr; br[t3] = p.in[18][c]; bi[t3] = p.in[20][c]; sp[t3] = softplusf_(-p.in[21][c]); }
    const int cg = tid % 24, trow = tid / 24; float cw[4][8], cb[8];
    { const int c0 = jl * MIXW + n * 192 + 8 * cg;
#pragma unroll
      for (int j = 0; j < 4; ++j)
#pragma unroll
          for (int e = 0; e < 8; ++e) cw[j][e] = p.in[15][(size_t)jl * 4 * MIXW + (size_t)j * MIXW + n * 192 + 8 * cg + e];
#pragma unroll
      for (int e = 0; e < 8; ++e) cb[e] = p.in[16][c0 + e]; }
    for (int ck = 0; ck < 16; ++ck) {
        const int t0 = ck * 128;
        u32x4 gpre[2];
#pragma unroll
        for (int k = 0; k < 2; ++k) { const int e = tid + NTHR * k; if (e < 128 * 6) gpre[k] = *(const u32x4*)(U + (size_t)(b * SEQ_ + t0 + e / 6) * INW + MIXW + n * 192 + 48 * q4 + 8 * (e % 6)); }
        if (tid < 384) {
            u32x4 raw[11];
#pragma unroll
            for (int j = 0; j < 11; ++j) { const int tt = t0 + trow * 8 - 3 + j;
                raw[j] = tt >= 0 ? *(const u32x4*)(U + (size_t)(b * SEQ_ + tt) * INW + n * 192 + 8 * cg) : (u32x4){0u, 0u, 0u, 0u}; }
#pragma unroll
            for (int it = 0; it < 8; ++it) { const int t = trow * 8 + it; float acc[8];
#pragma unroll
                for (int e = 0; e < 8; ++e) acc[e] = cb[e];
#pragma unroll
                for (int j = 0; j < 4; ++j) { const u32x4 rw = raw[it + j];
                    acc[0] += cw[j][0] * bflo(rw.x); acc[1] += cw[j][1] * bfhi(rw.x); acc[2] += cw[j][2] * bflo(rw.y); acc[3] += cw[j][3] * bfhi(rw.y);
                    acc[4] += cw[j][4] * bflo(rw.z); acc[5] += cw[j][5] * bfhi(rw.z); acc[6] += cw[j][6] * bflo(rw.w); acc[7] += cw[j][7] * bfhi(rw.w); }
                u32x4 w; w.x = cvt_pk_bf16(acc[0], acc[1]); w.y = cvt_pk_bf16(acc[2], acc[3]); w.z = cvt_pk_bf16(acc[4], acc[5]); w.w = cvt_pk_bf16(acc[6], acc[7]);
                lds_st<u32x4>(L, XCo + t * 400 + cg * 16, w); }
        }
        __syncthreads();
        {
            f32x4 acc[6];
#pragma unroll
            for (int i = 0; i < 6; ++i) acc[i] = (f32x4){0.f, 0.f, 0.f, 0.f};
#pragma unroll
            for (int ks = 0; ks < 6; ++ks) { const bf16x8 a = lds_ld<bf16x8>(L, XCo + (16 * wid + fr) * 400 + (32 * ks + 8 * fq) * 2);
#pragma unroll
                for (int nt = 0; nt < 6; ++nt) { const bf16x8 bb = lds_ld<bf16x8>(L, WLo + (16 * nt + fr) * 400 + (32 * ks + 8 * fq) * 2); acc[nt] = MFMA16(a, bb, acc[nt]); } }
#pragma unroll
            for (int t3 = 0; t3 < 3; ++t3) { const int oc = 16 * t3 + fr;
#pragma unroll
                for (int rg = 0; rg < 4; ++rg) { const int t = 16 * wid + 4 * fq + rg;
                    const float r = sigmoidf_(acc[t3][rg] + br[t3]), gi = sigmoidf_(acc[t3 + 3][rg] + bi[t3]);
                    const float la = -8.0f * r * sp[t3], a = __expf(la), mult = __builtin_amdgcn_sqrtf(fmaxf(1.0f - a * a, 0.f));
                    const float xc = bf2f(lds_ld<bf16_t>(L, XCo + t * 400 + (48 * q4 + oc) * 2));
                    lds_st<float>(L, AAo + (t * 48 + oc) * 4, a); lds_st<float>(L, UUo + (t * 48 + oc) * 4, mult * gi * xc); } }
        }
        __syncthreads();
        const int ch = tid % 48, sg = tid / 48;
        if (tid < 384) { float A = 1.f, Hh = 0.f;
#pragma unroll
            for (int i = 0; i < 16; ++i) { const int t = 16 * sg + i; const float a = lds_ld<float>(L, AAo + (t * 48 + ch) * 4), uu = lds_ld<float>(L, UUo + (t * 48 + ch) * 4); Hh = a * Hh + uu; A *= a; }
            lds_st<float>(L, SEGo + (sg * 48 + ch) * 4, A); lds_st<float>(L, SEGo + 1536 + (sg * 48 + ch) * 4, Hh); }
        __syncthreads();
        if (tid < 384) { float h = lds_ld<float>(L, CARo + ((ck & 1) * 48 + ch) * 4);
            for (int s2 = 0; s2 < sg; ++s2) h = lds_ld<float>(L, SEGo + (s2 * 48 + ch) * 4) * h + lds_ld<float>(L, SEGo + 1536 + (s2 * 48 + ch) * 4);
#pragma unroll
            for (int i = 0; i < 16; ++i) { const int t = 16 * sg + i; const float a = lds_ld<float>(L, AAo + (t * 48 + ch) * 4), uu = lds_ld<float>(L, UUo + (t * 48 + ch) * 4); h = a * h + uu; lds_st<float>(L, UUo + (t * 48 + ch) * 4, h); }
            if (sg == 7) lds_st<float>(L, CARo + (((ck + 1) & 1) * 48 + ch) * 4, h); }
        __syncthreads();
#pragma unroll
        for (int k = 0; k < 2; ++k) { const int e = tid + NTHR * k;
            if (e < 128 * 6) { const int t = e / 6, c8 = e % 6;
                const f32x4 h0 = lds_ld<f32x4>(L, UUo + (t * 48 + 8 * c8) * 4), h1 = lds_ld<f32x4>(L, UUo + (t * 48 + 8 * c8 + 4) * 4);
                bf16_t* gp = U + (size_t)(b * SEQ_ + t0 + t) * INW + MIXW + n * 192 + 48 * q4 + 8 * c8; const u32x4 g = gpre[k];
                u32x4 w; w.x = cvt_pk_bf16(h0[0] * gelu_tanh_(bflo(g.x)), h0[1] * gelu_tanh_(bfhi(g.x))); w.y = cvt_pk_bf16(h0[2] * gelu_tanh_(bflo(g.y)), h0[3] * gelu_tanh_(bfhi(g.y)));
                w.z = cvt_pk_bf16(h1[0] * gelu_tanh_(bflo(g.z)), h1[1] * gelu_tanh_(bfhi(g.z))); w.w = cvt_pk_bf16(h1[2] * gelu_tanh_(bflo(g.w)), h1[3] * gelu_tanh_(bfhi(g.w)));
                st16_sc1(gp, w); } }
    }
}

__device__ __forceinline__ void xattn_item(CP& p, int item, lds_t L) {
    constexpr int KMo = 0, VMo = 69632;
    int tid_ = threadIdx.x; asm volatile("" : "+v"(tid_)); const int tid = tid_, lane = tid & 63, wid = tid >> 6, fr = lane & 15, fq = lane >> 4;
    const int slotx_ = item >> 3, pairx_ = (item & 7) * 4 + (slotx_ >> 4), b = pairx_ >> 2, hx = pairx_ & 3, qt = slotx_ & 15;
    bf16_t* U = (bf16_t*)(p.ws + WS_U); const bf16_t* KV = (const bf16_t*)(p.ws + WS_KVM);
    __syncthreads();
    for (int e = tid; e < 4096; e += NTHR) { const int key = e >> 4, ch = e & 15; const bf16_t* src = KV + (size_t)(b * 256 + key) * 1024 + hx * 128 + ch * 8;
        lds_st<u32x4>(L, KMo + key * 272 + ch * 16, *(const u32x4*)src); lds_st<u32x4>(L, VMo + key * 288 + ch * 16, *(const u32x4*)(src + 512)); }
    bf16_t* qrow = U + (size_t)(b * SEQ_ + qt * 128 + 16 * wid + fr) * INW + 2 * MIXW + hx * 128;
    bf16x8 Bq[4];
#pragma unroll
    for (int ks = 0; ks < 4; ++ks) Bq[ks] = *(const bf16x8*)(qrow + 32 * ks + 8 * fq);
    __syncthreads();
    f32x4 S[16];
#pragma unroll
    for (int kt = 0; kt < 16; ++kt) { f32x4 a = (f32x4){0.f, 0.f, 0.f, 0.f};
#pragma unroll
        for (int ks = 0; ks < 4; ++ks) a = MFMA16(lds_ld<bf16x8>(L, KMo + (16 * kt + fr) * 272 + (32 * ks + 8 * fq) * 2), Bq[ks], a);
        S[kt] = a; }
    float mx = -3.0e38f;
#pragma unroll
    for (int kt = 0; kt < 16; ++kt)
#pragma unroll
        for (int j = 0; j < 4; ++j) mx = fmaxf(mx, S[kt][j]);
    mx = fmaxf(mx, __shfl_xor(mx, 16)); mx = fmaxf(mx, __shfl_xor(mx, 32));
    const float sc = 0.08838834764831845f; float lsum = 0.f;
#pragma unroll
    for (int kt = 0; kt < 16; ++kt)
#pragma unroll
        for (int j = 0; j < 4; ++j) { const float e = __expf((S[kt][j] - mx) * sc); S[kt][j] = e; lsum += e; }
    lsum += __shfl_xor(lsum, 16); lsum += __shfl_xor(lsum, 32);
    f32x4 O[8];
#pragma unroll
    for (int dt = 0; dt < 8; ++dt) O[dt] = (f32x4){0.f, 0.f, 0.f, 0.f};
#pragma unroll
    for (int i = 0; i < 8; ++i) { const bf16x8 bp = pack8(S[2 * i], S[2 * i + 1]);
#pragma unroll
        for (int dt = 0; dt < 8; ++dt) { const int o0 = VMo + (32 * i + 4 * fq + (fr >> 2)) * 288 + (16 * dt + 4 * (fr & 3)) * 2;
#ifdef DBG_NOTR
            u32x4 af;
            { unsigned e[8];
#pragma unroll
              for (int j = 0; j < 8; ++j) { const int key = 32 * i + (j < 4 ? 4 * fq + j : 16 + 4 * fq + (j - 4)); e[j] = lds_ld<bf16_t>(L, VMo + key * 288 + (16 * dt + fr) * 2); }
              af.x = e[0] | (e[1] << 16); af.y = e[2] | (e[3] << 16); af.z = e[4] | (e[5] << 16); af.w = e[6] | (e[7] << 16); }
            (void)o0; O[dt] = MFMA16(__builtin_bit_cast(bf16x8, af), bp, O[dt]); } }
#else
            O[dt] = MFMA16(tr_pair(L, o0, o0 + 16 * 288), bp, O[dt]); } }
#endif
    float inv = frcp_(lsum);
#ifdef DBG_IDENT
    { const u32x4 q0 = __builtin_bit_cast(u32x4, Bq[0]);
#pragma unroll
      for (int dt = 0; dt < 8; ++dt) { O[dt][0] = bflo(q0.x) + dt; O[dt][1] = bfhi(q0.x); O[dt][2] = bflo(q0.y); O[dt][3] = bfhi(q0.y); } inv = 1.0f; }
#endif
#pragma unroll
    for (int dt = 0; dt < 8; ++dt) { u32x2 w; w.x = cvt_pk_bf16(O[dt][0] * inv, O[dt][1] * inv); w.y = cvt_pk_bf16(O[dt][2] * inv, O[dt][3] * inv);
        *(u32x2*)(qrow + 16 * dt + 4 * fq) = w; }
}

__device__ __forceinline__ void ml1_item(CP& p, int jl, int item, lds_t L) {
    int tid_ = threadIdx.x; asm volatile("" : "+v"(tid_)); const int tid = tid_, lane = tid & 63, wid = tid >> 6;
    const bf16_t* U = (const bf16_t*)(p.ws + WS_U); bf16_t* XC = (bf16_t*)(p.ws + WS_XC); float* G = (float*)(p.ws + WS_G);
    const int j = tid < 384 ? tid : 0;
    float cw[4][4], cb[4], Wx[4][8], Wm[4][8];
    {
#pragma unroll
        for (int k = 0; k < 4; ++k)
#pragma unroll
            for (int c = 0; c < 4; ++c) cw[k][c] = p.in[22][(size_t)jl * 4 * MIXW + (size_t)k * MIXW + 4 * j + c];
#pragma unroll
        for (int c = 0; c < 4; ++c) cb[c] = p.in[23][jl * MIXW + 4 * j + c];
        const float* wq = p.in[24] + ((size_t)jl * 384 + j) * 16; const float* wk = p.in[25] + ((size_t)jl * 384 + j) * 16; const float* wv = p.in[26] + ((size_t)jl * 384 + j) * 16;
        const float* Wg = p.in[27] + (size_t)jl * 4608 * 8;
#pragma unroll
        for (int i = 0; i < 4; ++i)
#pragma unroll
            for (int g = 0; g < 8; ++g) { Wx[i][g] = 0.f; Wm[i][g] = 0.f; }
#pragma unroll 1
        for (int o = 0; o < 4; ++o) {
            float gq[8], gk[8], gv[8];
#pragma unroll
            for (int g = 0; g < 8; ++g) { gq[g] = Wg[(size_t)(4 * j + o) * 8 + g]; gk[g] = Wg[(size_t)(MIXW + 4 * j + o) * 8 + g]; gv[g] = Wg[(size_t)(2 * MIXW + 4 * j + o) * 8 + g]; }
#pragma unroll
            for (int i = 0; i < 4; ++i) { const float a = wq[i * 4 + o], bk = wk[i * 4 + o], cv = wv[i * 4 + o];
#pragma unroll
                for (int g = 0; g < 8; ++g) { Wx[i][g] += a * gq[g] + bk * gk[g]; Wm[i][g] += cv * gv[g]; } } }
    }
    const int r0 = item * 64, tm0 = r0 % SEQ_;
    float x3[4], x2[4], x1[4], x0[4];
    auto ldx = [&](int row, float* x) { const u32x2 raw = *(const u32x2*)(U + (size_t)row * INW + 4 * j); x[0] = bflo(raw.x); x[1] = bfhi(raw.x); x[2] = bflo(raw.y); x[3] = bfhi(raw.y); };
#pragma unroll
    for (int c = 0; c < 4; ++c) { x3[c] = 0.f; x2[c] = 0.f; x1[c] = 0.f; }
    if (tm0 > 0) { ldx(r0 - 3, x3); ldx(r0 - 2, x2); ldx(r0 - 1, x1); }
    for (int tb = 0; tb < 8; ++tb) {
        __syncthreads();
        if (tid < 384) {
            u32x2 xraw[8];
#pragma unroll
            for (int tt = 0; tt < 8; ++tt) xraw[tt] = *(const u32x2*)(U + (size_t)(r0 + tb * 8 + tt) * INW + 4 * j);
#pragma unroll
            for (int tt = 0; tt < 8; ++tt) { const int row = r0 + tb * 8 + tt; x0[0] = bflo(xraw[tt].x); x0[1] = bfhi(xraw[tt].x); x0[2] = bflo(xraw[tt].y); x0[3] = bfhi(xraw[tt].y); float xc[4];
#pragma unroll
                for (int c = 0; c < 4; ++c) xc[c] = siluf_(cb[c] + cw[0][c] * x3[c] + cw[1][c] * x2[c] + cw[2][c] * x1[c] + cw[3][c] * x0[c]);
                u32x2 w; w.x = cvt_pk_bf16(xc[0], xc[1]); w.y = cvt_pk_bf16(xc[2], xc[3]); *(u32x2*)(XC + (size_t)row * MIXW + 4 * j) = w;
#pragma unroll
                for (int g = 0; g < 8; ++g) { float s = 0.f;
#pragma unroll
                    for (int i = 0; i < 4; ++i) s += xc[i] * Wx[i][g] + x0[i] * Wm[i][g];
                    lds_st<float>(L, ((tt * 8 + g) * 388 + tid) * 4, s); }
#pragma unroll
                for (int c = 0; c < 4; ++c) { x3[c] = x2[c]; x2[c] = x1[c]; x1[c] = x0[c]; } }
        }
        __syncthreads();
        {
            const int row = tid >> 3, part = tid & 7; float s = 0.f;
#pragma unroll
            for (int i = 0; i < 12; ++i) { const f32x4 v = lds_ld<f32x4>(L, (row * 388 + part * 48 + 4 * i) * 4); s += (v[0] + v[1]) + (v[2] + v[3]); }
            s += __shfl_xor(s, 1); s += __shfl_xor(s, 2); s += __shfl_xor(s, 4);
            if (part == 0) { const int g = row & 7; const float v = s + p.in[28][jl * 8 + g]; G[(size_t)(r0 + tb * 8 + (row >> 3)) * 8 + g] = g < 4 ? v : -softplusf_(-v); }
        }
    }
}

__device__ __forceinline__ void ml2_item(CP& p, int jl, int item, lds_t L) {
    constexpr int QIo = 0, KIo = 50176, VIo = 100352, PTo = 109568, WQKo = 118784, WVo = 131072, SCo = 132096, NSo = 134144, OXo = 0;
    constexpr int IBo = SCo, MTo = SCo + 256, WIo = SCo + 512, EMo = SCo + 768, WSo = SCo + 1024, DNo = SCo + 1280, NQo = SCo + 1536, MIo = SCo + 1792;
    int tid_ = threadIdx.x; asm volatile("" : "+v"(tid_)); const int tid = tid_, lane = tid & 63, wid = tid >> 6, fr = lane & 15, fq = lane >> 4;
    const int slot_ = item >> 3, pair_ = (item & 7) * 4 + slot_ / 6, b = pair_ >> 2, hh = pair_ & 3, vb = slot_ % 6;
    const int vt = wid & 3, kh = wid >> 2;
    const bf16_t* U = (const bf16_t*)(p.ws + WS_U); const bf16_t* XC = (const bf16_t*)(p.ws + WS_XC); const float* G = (const float*)(p.ws + WS_G); bf16_t* HO = (bf16_t*)(p.ws + WS_HOUT);
    __syncthreads();
    for (int idx = tid; idx < 3072; idx += NTHR) { const int jb = idx >> 5, e = idx & 31; const size_t bo = ((size_t)jl * 384 + hh * 96 + jb) * 16;
        lds_st<float>(L, WQKo + idx * 4, e < 16 ? p.in[24][bo + e] : p.in[25][bo + e - 16]); }
    if (tid < 256) lds_st<float>(L, WVo + tid * 4, p.in[26][((size_t)jl * 384 + hh * 96 + vb * 16 + (tid >> 4)) * 16 + (tid & 15)]);
    if (tid < 384) lds_st<float>(L, NSo + tid * 4, 0.f);
    f32x4 CT[12];
#pragma unroll
    for (int i = 0; i < 12; ++i) CT[i] = (f32x4){0.f, 0.f, 0.f, 0.f};
    float m_cur = 0.f;
    const int cg = tid % 48, rg = (tid / 48) & 7;
    u32x4 pre[4]; float pli = 0.f, plf = 0.f;
    if (tid < 384) {
#pragma unroll
        for (int it = 0; it < 4; ++it) pre[it] = *(const u32x4*)(XC + (size_t)(b * SEQ_ + rg * 8 + it) * MIXW + hh * 384 + 8 * cg);
    }
    if (wid == 0) { pli = G[(size_t)(b * SEQ_ + lane) * 8 + hh]; plf = G[(size_t)(b * SEQ_ + lane) * 8 + 4 + hh]; }
    for (int c = 0; c < 32; ++c) {
        const int r0 = b * SEQ_ + 64 * c;
        __syncthreads();
        if (wid == 0) {
            const float li = pli, lf = plf;
            float bc = lf;
#pragma unroll
            for (int d = 1; d < 64; d <<= 1) { const float v = __shfl_up(bc, d); if (lane >= d) bc += v; }
            const float ib = li - bc; float pm = ib;
#pragma unroll
            for (int d = 1; d < 64; d <<= 1) { const float v = __shfl_up(pm, d); if (lane >= d) pm = fmaxf(pm, v); }
            const float Mt = fmaxf(m_cur, pm), M63 = __shfl(Mt, 63), bl = __shfl(bc, 63);
            lds_st<float>(L, IBo + lane * 4, ib); lds_st<float>(L, MTo + lane * 4, Mt); lds_st<float>(L, WIo + lane * 4, __expf(m_cur - Mt)); lds_st<float>(L, EMo + lane * 4, __expf(-(bc + Mt)));
            lds_st<float>(L, WSo + lane * 4, __expf(ib - M63)); lds_st<float>(L, DNo + lane * 4, 0.f);
            if (lane == 0) { lds_st<float>(L, MIo, __expf(m_cur - M63)); lds_st<float>(L, MIo + 4, bl + M63); }
        }
        if (tid < 384) {
            u32x4 late[4];
#pragma unroll
            for (int it = 0; it < 4; ++it) late[it] = *(const u32x4*)(XC + (size_t)(r0 + rg * 8 + 4 + it) * MIXW + hh * 384 + 8 * cg);
#pragma unroll
            for (int bk = 0; bk < 2; ++bk) {
                f32x4 wqv[4], wkv[4];
#pragma unroll
                for (int i = 0; i < 4; ++i) { wqv[i] = lds_ld<f32x4>(L, WQKo + (2 * cg + bk) * 128 + i * 16); wkv[i] = lds_ld<f32x4>(L, WQKo + (2 * cg + bk) * 128 + 64 + i * 16); }
#pragma unroll
                for (int it = 0; it < 8; ++it) { const int t = rg * 8 + it; const u32x4 raw = it < 4 ? pre[it] : late[it - 4];
                    const unsigned w0 = bk ? raw.z : raw.x, w1 = bk ? raw.w : raw.y;
                    const float x0 = bflo(w0), x1 = bfhi(w0), x2 = bflo(w1), x3 = bfhi(w1);
                    const f32x4 aq = wqv[0] * x0 + wqv[1] * x1 + wqv[2] * x2 + wqv[3] * x3;
                    const f32x4 ak = (wkv[0] * x0 + wkv[1] * x1 + wkv[2] * x2 + wkv[3] * x3) * 0.05103103630798288f;
                    u32x2 qw, kw; qw.x = cvt_pk_bf16(aq[0], aq[1]); qw.y = cvt_pk_bf16(aq[2], aq[3]); kw.x = cvt_pk_bf16(ak[0], ak[1]); kw.y = cvt_pk_bf16(ak[2], ak[3]);
                    lds_st<u32x2>(L, QIo + t * 784 + cg * 16 + bk * 8, qw); lds_st<u32x2>(L, KIo + t * 784 + cg * 16 + bk * 8, kw);
                    if ((it & 1) == 1) __builtin_amdgcn_sched_barrier(0); }
            }
        } else {
#pragma unroll 4
            for (int it = 0; it < 8; ++it) { const int e = (tid - 384) + 128 * it, t = e >> 4, jb = e & 15;
                const u32x2 raw = *(const u32x2*)(U + (size_t)(r0 + t) * INW + hh * 384 + vb * 64 + 4 * jb);
                const float x[4] = {bflo(raw.x), bfhi(raw.x), bflo(raw.y), bfhi(raw.y)};
                f32x4 av = lds_ld<f32x4>(L, WVo + jb * 64) * x[0];
#pragma unroll
                for (int i = 1; i < 4; ++i) av = av + lds_ld<f32x4>(L, WVo + jb * 64 + i * 16) * x[i];
                u32x2 w; w.x = cvt_pk_bf16(av[0], av[1]); w.y = cvt_pk_bf16(av[2], av[3]); lds_st<u32x2>(L, VIo + t * 144 + jb * 8, w); }
        }
        __syncthreads();
        const float decay = lds_ld<float>(L, MIo), m_new = lds_ld<float>(L, MIo + 4);
        {
            const int tt = wid & 3, hf = wid >> 2;
            f32x4 s0 = (f32x4){0.f, 0.f, 0.f, 0.f}, s1 = s0;
            const bool do0 = (2 * hf) <= tt, do1 = (2 * hf + 1) <= tt;
            if (do0) {
#pragma unroll
                for (int ks = 0; ks < 12; ++ks) { const bf16x8 bq = lds_ld<bf16x8>(L, QIo + (16 * tt + fr) * 784 + (32 * ks + 8 * fq) * 2);
                    s0 = MFMA16(lds_ld<bf16x8>(L, KIo + (32 * hf + fr) * 784 + (32 * ks + 8 * fq) * 2), bq, s0);
                    if (do1) s1 = MFMA16(lds_ld<bf16x8>(L, KIo + (32 * hf + 16 + fr) * 784 + (32 * ks + 8 * fq) * 2), bq, s1);
                    if ((ks & 3) == 3) __builtin_amdgcn_sched_barrier(0); } }
            const int t = 16 * tt + fr; const float Mt = lds_ld<float>(L, MTo + t * 4); float psum = 0.f;
#pragma unroll
            for (int sti = 0; sti < 2; ++sti) { const int sb = 32 * hf + 16 * sti + 4 * fq; const f32x4 ibv = lds_ld<f32x4>(L, IBo + sb * 4); f32x4 sv = sti ? s1 : s0; float pv[4];
#pragma unroll
                for (int rg = 0; rg < 4; ++rg) { const int s = sb + rg; pv[rg] = (s <= t) ? sv[rg] * __expf(ibv[rg] - Mt) : 0.f; psum += pv[rg]; }
                u32x2 w; w.x = cvt_pk_bf16(pv[0], pv[1]); w.y = cvt_pk_bf16(pv[2], pv[3]); lds_st<u32x2>(L, PTo + t * 144 + sb * 2, w); }
            psum += __shfl_xor(psum, 16); psum += __shfl_xor(psum, 32);
            if (fq == 0) __hip_atomic_fetch_add((LAS float*)(L + DNo + t * 4), psum, __ATOMIC_RELAXED, __HIP_MEMORY_SCOPE_WORKGROUP);
        }
        f32x4 ao[4];
#pragma unroll
        for (int i = 0; i < 4; ++i) ao[i] = (f32x4){0.f, 0.f, 0.f, 0.f};
#pragma unroll
        for (int i = 0; i < 6; ++i) { const bf16x8 af = pack8(CT[2 * i], CT[2 * i + 1]);
#pragma unroll
            for (int t2 = 0; t2 < 4; ++t2) { const int qo = QIo + (16 * t2 + fr) * 784 + (192 * kh + 32 * i + 4 * fq) * 2;
                const s16x4 lo = lds_ld<s16x4>(L, qo), hi = lds_ld<s16x4>(L, qo + 32);
                ao[t2] = MFMA16(af, __builtin_shufflevector(lo, hi, 0, 1, 2, 3, 4, 5, 6, 7), ao[t2]); }
            __builtin_amdgcn_sched_barrier(0); }
#pragma unroll
        for (int t2 = 0; t2 < 4; ++t2) { const float wi = lds_ld<float>(L, WIo + (16 * t2 + fr) * 4); ao[t2] = ao[t2] * wi; }
        {
            const int t = tid >> 3, part = tid & 7; float s = 0.f;
#pragma unroll
            for (int i = 0; i < 6; ++i) { const u32x4 raw = lds_ld<u32x4>(L, QIo + t * 784 + part * 96 + i * 16);
                const f32x4 n0 = lds_ld<f32x4>(L, NSo + (part * 48 + i * 8) * 4), n1 = lds_ld<f32x4>(L, NSo + (part * 48 + i * 8 + 4) * 4);
                s += bflo(raw.x) * n0[0] + bfhi(raw.x) * n0[1] + bflo(raw.y) * n0[2] + bfhi(raw.y) * n0[3] + bflo(raw.z) * n1[0] + bfhi(raw.z) * n1[1] + bflo(raw.w) * n1[2] + bfhi(raw.w) * n1[3]; }
            s += __shfl_xor(s, 1); s += __shfl_xor(s, 2); s += __shfl_xor(s, 4);
            if (part == 0) lds_st<float>(L, NQo + t * 4, s);
        }
        __syncthreads();
        if (c + 1 < 32) {
            if (tid < 384) {
#pragma unroll
                for (int it = 0; it < 4; ++it) pre[it] = *(const u32x4*)(XC + (size_t)(r0 + 64 + rg * 8 + it) * MIXW + hh * 384 + 8 * cg);
            }
            if (wid == 0) { pli = G[(size_t)(r0 + 64 + lane) * 8 + hh]; plf = G[(size_t)(r0 + 64 + lane) * 8 + 4 + hh]; }
        }
        {
            const int o0 = VIo + (32 * kh + 8 * fq + (fr >> 2)) * 144 + (16 * vt + 4 * (fr & 3)) * 2;
            const bf16x8 av = tr_pair(L, o0, o0 + 4 * 144);
#pragma unroll
            for (int t2 = 0; t2 < 4; ++t2) ao[t2] = MFMA16(av, lds_ld<bf16x8>(L, PTo + (16 * t2 + fr) * 144 + (32 * kh + 8 * fq) * 2), ao[t2]);
        }
        if (kh == 1) {
#pragma unroll
            for (int t2 = 0; t2 < 4; ++t2)
#pragma unroll
                for (int rg = 0; rg < 4; ++rg) lds_st<float>(L, OXo + ((vt * 16 + 4 * fq + rg) * 64 + 16 * t2 + fr) * 4, ao[t2][rg]);
        }
        {
            bf16x8 bv[2];
#pragma unroll
            for (int ks = 0; ks < 2; ++ks) { const int o0 = VIo + (32 * ks + 8 * fq + (fr >> 2)) * 144 + (16 * vt + 4 * (fr & 3)) * 2;
                const bf16x8 raw = tr_pair(L, o0, o0 + 4 * 144); const u32x4 rw = __builtin_bit_cast(u32x4, raw);
                const f32x4 w0 = lds_ld<f32x4>(L, WSo + (32 * ks + 8 * fq) * 4), w1 = lds_ld<f32x4>(L, WSo + (32 * ks + 8 * fq + 4) * 4);
                u32x4 o; o.x = cvt_pk_bf16(bflo(rw.x) * w0[0], bfhi(rw.x) * w0[1]); o.y = cvt_pk_bf16(bflo(rw.y) * w0[2], bfhi(rw.y) * w0[3]);
                o.z = cvt_pk_bf16(bflo(rw.z) * w1[0], bfhi(rw.z) * w1[1]); o.w = cvt_pk_bf16(bflo(rw.w) * w1[2], bfhi(rw.w) * w1[3]);
                bv[ks] = __builtin_bit_cast(bf16x8, o); }
#pragma unroll
            for (int kt = 0; kt < 12; ++kt) { f32x4 a = CT[kt] * decay;
#pragma unroll
                for (int ks = 0; ks < 2; ++ks) { const int o0 = KIo + (32 * ks + 8 * fq + (fr >> 2)) * 784 + (192 * kh + 16 * kt + 4 * (fr & 3)) * 2;
                    a = MFMA16(tr_pair(L, o0, o0 + 4 * 784), bv[ks], a); }
                CT[kt] = a; if ((kt & 1) == 1) __builtin_amdgcn_sched_barrier(0); }
        }
        if (tid < 192) { float n0 = decay * lds_ld<float>(L, NSo + tid * 8), n1 = decay * lds_ld<float>(L, NSo + tid * 8 + 4);
#pragma unroll 4
            for (int s4 = 0; s4 < 16; ++s4) { const f32x4 w4 = lds_ld<f32x4>(L, WSo + s4 * 16);
#pragma unroll
                for (int j = 0; j < 4; ++j) { const unsigned kk = lds_ld<unsigned>(L, KIo + (4 * s4 + j) * 784 + tid * 4); n0 += w4[j] * bflo(kk); n1 += w4[j] * bfhi(kk); } }
            lds_st<float>(L, NSo + tid * 8, n0); lds_st<float>(L, NSo + tid * 8 + 4, n1); }
        __syncthreads();
        if (kh == 0) {
#pragma unroll
            for (int t2 = 0; t2 < 4; ++t2) { const int t = 16 * t2 + fr;
                const float dn = fmaxf(fabsf(lds_ld<float>(L, DNo + t * 4) + lds_ld<float>(L, WIo + t * 4) * lds_ld<float>(L, NQo + t * 4)), lds_ld<float>(L, EMo + t * 4));
                const float inv = frcp_(dn); float hv[4];
#pragma unroll
                for (int rg = 0; rg < 4; ++rg) hv[rg] = (ao[t2][rg] + lds_ld<float>(L, OXo + ((vt * 16 + 4 * fq + rg) * 64 + t) * 4)) * inv;
                u32x2 w; w.x = cvt_pk_bf16(hv[0], hv[1]); w.y = cvt_pk_bf16(hv[2], hv[3]);
                *(u32x2*)(HO + (size_t)(r0 + t) * MIXW + hh * 384 + vb * 64 + 16 * vt + 4 * fq) = w; }
        }
        m_cur = m_new;
    }
}

__device__ __forceinline__ void phase_ml3(CP& p, int jl) {
    int tid_ = threadIdx.x; asm volatile("" : "+v"(tid_)); const int tid = tid_, lane = tid & 63, wid = tid >> 6;
    bf16_t* U = (bf16_t*)(p.ws + WS_U); const bf16_t* XC = (const bf16_t*)(p.ws + WS_XC); const bf16_t* HO = (const bf16_t*)(p.ws + WS_HOUT);
    const int gw = blockIdx.x * 8 + wid, nw = gridDim.x * 8, hh = gw & 3;
    float lg[6], sk[6];
#pragma unroll
    for (int i = 0; i < 3; ++i) { const int c = jl * MIXW + hh * 384 + 128 * i + 2 * lane; lg[2 * i] = p.in[29][c]; lg[2 * i + 1] = p.in[29][c + 1]; sk[2 * i] = p.in[30][c]; sk[2 * i + 1] = p.in[30][c + 1]; }
    for (int rb = (gw >> 2) * 4; rb < T_; rb += (nw >> 2) * 4) {
        unsigned hr[4][3], xr[4][3], gr[4][3];
#pragma unroll
        for (int r = 0; r < 4; ++r)
#pragma unroll
            for (int i = 0; i < 3; ++i) { const int c = hh * 384 + 128 * i + 2 * lane; const size_t row = (size_t)(rb + r);
                hr[r][i] = *(const unsigned*)(HO + row * MIXW + c); xr[r][i] = *(const unsigned*)(XC + row * MIXW + c); gr[r][i] = *(const unsigned*)(U + row * INW + MIXW + c); }
#pragma unroll
        for (int r = 0; r < 4; ++r) { float h[6]; float s = 0.f;
#pragma unroll
            for (int i = 0; i < 3; ++i) { h[2 * i] = bflo(hr[r][i]); h[2 * i + 1] = bfhi(hr[r][i]); s += h[2 * i] + h[2 * i + 1]; }
            const float mu = wave_sum(s) * (1.0f / 384.0f); float v2 = 0.f;
#pragma unroll
            for (int i = 0; i < 6; ++i) { h[i] -= mu; v2 += h[i] * h[i]; }
            const float rstd = rsqrtf(wave_sum(v2) * (1.0f / 384.0f) + EPS_);
#pragma unroll
            for (int i = 0; i < 3; ++i) { const int c = hh * 384 + 128 * i + 2 * lane;
                const float y0 = (h[2 * i] * rstd * lg[2 * i] + sk[2 * i] * bflo(xr[r][i])) * siluf_(bflo(gr[r][i]));
                const float y1 = (h[2 * i + 1] * rstd * lg[2 * i + 1] + sk[2 * i + 1] * bfhi(xr[r][i])) * siluf_(bfhi(gr[r][i]));
                *(unsigned*)(U + (size_t)(rb + r) * INW + MIXW + c) = cvt_pk_bf16(y0, y1); } }
    }
}

__device__ __forceinline__ void phase_final(CP& p) {
    int tid_ = threadIdx.x; asm volatile("" : "+v"(tid_)); const int tid = tid_, lane = tid & 63, wid = tid >> 6; float* out = p.out; const float* g = p.in[31]; const bf16_t* HB = (const bf16_t*)(p.ws + WS_HB);
    for (int row = blockIdx.x * 8 + wid; row < T_; row += gridDim.x * 8) { float v[16]; float s2 = 0.f;
#pragma unroll
        for (int i = 0; i < 2; ++i) { const u32x4 hw = *(const u32x4*)(HB + (size_t)row * D_ + i * 512 + lane * 8);
            v[8 * i + 0] = bflo(hw.x); v[8 * i + 1] = bfhi(hw.x); v[8 * i + 2] = bflo(hw.y); v[8 * i + 3] = bfhi(hw.y); v[8 * i + 4] = bflo(hw.z); v[8 * i + 5] = bfhi(hw.z); v[8 * i + 6] = bflo(hw.w); v[8 * i + 7] = bfhi(hw.w); }
#pragma unroll
        for (int i = 0; i < 16; ++i) s2 += v[i] * v[i];
        const float rs = rsqrtf(wave_sum(s2) * (1.0f / 1024.0f) + EPS_);
#pragma unroll
        for (int i = 0; i < 2; ++i) { const int c = i * 512 + lane * 8; const f32x4 g0 = *(const f32x4*)(g + c), g1 = *(const f32x4*)(g + c + 4);
            *(f32x4*)(out + (size_t)row * D_ + c) = (f32x4){v[8 * i] * rs * g0[0], v[8 * i + 1] * rs * g0[1], v[8 * i + 2] * rs * g0[2], v[8 * i + 3] * rs * g0[3]};
            *(f32x4*)(out + (size_t)row * D_ + c + 4) = (f32x4){v[8 * i + 4] * rs * g1[0], v[8 * i + 5] * rs * g1[1], v[8 * i + 6] * rs * g1[2], v[8 * i + 7] * rs * g1[3]}; } }
}

constexpr int MK_PRO = 1, MK_GEMM = 2, MK_LRU = 4, MK_XA = 8, MK_ML1 = 16, MK_ML2 = 32, MK_ML3 = 64, MK_FIN = 128, MK_ALL = 255;
template <int MASK>
__global__ void __launch_bounds__(NTHR, 2) mega(P p_arg) {
    extern __shared__ __attribute__((aligned(16))) unsigned char shm[];
    lds_t L = (lds_t)shm;
    cg::grid_group grid = cg::this_grid();
    CP* kp0 = (CP*)__builtin_amdgcn_kernarg_segment_ptr();
    const int G = (int)gridDim.x, bid = (int)blockIdx.x;
    const int ph_lo = p_arg.ph_lo, ph_hi = p_arg.ph_hi, coop = p_arg.coop, sub = p_arg.pad;
    __builtin_amdgcn_fence(__ATOMIC_ACQUIRE, "agent");
    if (threadIdx.x < 4) *(volatile LAS unsigned*)(L + LDS_BYTES - 16 + 4 * threadIdx.x) = 0u;
    __syncthreads();
    XcdBarrier xbar = xcd_barrier_post((unsigned*)(p_arg.ws + WS_BAR), (volatile LAS unsigned*)(L + LDS_BYTES - 16));
    for (int ph = ph_lo; ph < ph_hi; ++ph) {
        CP* kp = kp0; asm volatile("" : "+s"(kp)); CP& p = *kp; unsigned char* ws = p.ws;
        int type, l = 0;
        if (ph == 0) type = 0; else if (ph == 33) type = 11;
        else { const int q = ph - 1, pr = q >> 4, r = q & 15;
            if (r < 7) { l = 2 * pr; type = r < 3 ? r + 1 : (r == 3 ? 4 : r + 4); }
            else { l = 2 * pr + 1; const int r2 = r - 7; type = r2 < 3 ? r2 + 1 : r2 + 2; } }
        const unsigned char* wb = ws + WS_WB + (size_t)l * WL_LAYER; const int jl = l >> 1;
        float* SS = (float*)(ws + WS_SS); bf16_t* HB = (bf16_t*)(ws + WS_HB); bf16_t* U = (bf16_t*)(ws + WS_U);
#ifdef PROBE_REP_TYPES
        const int nrep = ((PROBE_REP_TYPES >> type) & 1) ? 2 : 1;
#else
        const int nrep = 1;
#endif
        for (int rep = 0; rep < nrep; ++rep) {
        if (type == 0) { if constexpr ((MASK & MK_PRO) != 0) phase_prologue(p, L); }
        else {
        const bool split = (l == 3) && coop && G == 256;
        const int tbase = (l + 1) * 5888;
        const bool gemm_now = (type == 1 || type == 9 || type == 2 || type == 8 || type == 10 || type == 3) || (type == 6 && split && bid >= 192);
        if (gemm_now) {
            if constexpr ((MASK & MK_GEMM) != 0) {
            const int npass = ((type == 3 && !split) || (type == 1 && split)) ? 2 : 1;
            for (int pass = 0; pass < npass; ++pass) {
                pg8::Gemm g; pg8::EpiAll E; int c = bid, Ge = G, sf = 1 << 30, sl = 0;
                g.M = T_; g.N = 1024; g.K = 1024; g.lda = 1024; g.A = HB; E.O = U; E.ldc = INW; E.H = p.out; E.ssn = SS; E.ss = SS;
                const bool kvpass = (type == 3 && !split && pass == 0) || (type == 1 && split && pass == 1);
                if (kvpass) { E.mode = 1; g.A = (const bf16_t*)(ws + WS_MEMB); g.Bt = (const bf16_t*)(wb + WL_KV); g.M = MEMT; E.O = (bf16_t*)(ws + WS_KVM); E.ldc = 1024; E.ss = (const float*)(ws + WS_SSM);
                    if (type == 1) c = bid >= 128 ? bid - 128 : (1 << 20); }
                else if (type == 1 || type == 9) { g.Bt = (const bf16_t*)(wb + (type == 1 ? WL_GU1 : WL_GU2)); g.N = 5632; E.mode = 0; }
                else if (type == 3) { E.mode = 1; g.Bt = (const bf16_t*)(wb + WL_IN);
                    if (split) { g.N = 2048; sf = 6; sl = 6; }
                    else { g.N = INW; c = (bid + (G / 16) * 8) % G; } }
                else if (type == 6) { E.mode = 1; g.Bt = (const bf16_t*)(wb + WL_IN); g.N = 1536; sf = 0; sl = 6; Ge = 64; c = bid - 192; }
                else { E.mode = 2; E.O = HB; E.ssn = SS;
                    if (type == 8) { g.A = U + MIXW; g.Bt = (const bf16_t*)(wb + WL_OUT); g.K = OUTW; g.lda = INW; }
                    else { g.A = U; g.Bt = (const bf16_t*)(wb + (type == 2 ? WL_D1 : WL_D2)); g.K = FF_; g.lda = FF_; } }
                pg8::StaticOrder S; S.init(g.M, g.N, Ge, c); S.sf = sf; S.sl = sl; pg8::gemm_phase(L, g, S, E);
            }
            if constexpr ((MASK & MK_PRO) != 0) {
                if (l < 3 && G == 256) {
                    if (type == 1 && bid >= 128) transpose_range(p, L, tbase + (bid - 128), tbase + 2200, 128);
                    else if (type == 3 && bid >= 32 && bid < 128) transpose_range(p, L, tbase + 2200 + (bid - 32), tbase + 3688, 96);
                    else if (type == 9 && bid >= 128) transpose_range(p, L, tbase + 3688 + (bid - 128), tbase + 5888, 128);
                } else if (l < 3 && type == 9) transpose_range(p, L, tbase + bid, tbase + 5888, G);
            } }
        }
        if (type == 4) {

            if constexpr ((MASK & MK_LRU) != 0) { if (sub != 2) for (int it = bid; it < 256; it += G) lru_item(p, jl, it, L); }
            if constexpr ((MASK & MK_XA) != 0) { if (sub != 1) { for (int it = bid; it < 512; it += G) xattn_item(p, it, L);
#ifdef DBG_THRASH
                { const u32x4* src = (const u32x4*)(ws + WS_WB) + (size_t)bid * 131072; unsigned acc = 0;
                  for (int i = threadIdx.x; i < 131072; i += NTHR) { const u32x4 v = src[i]; acc ^= v.x ^ v.y ^ v.z ^ v.w; }
                  if (acc == 0x12345u) ((unsigned*)(ws + WS_G))[0] = acc; }
#endif
            } }
        } else if (type == 5) { if constexpr ((MASK & MK_ML1) != 0) for (int it = bid; it < 256; it += G) ml1_item(p, jl, it, L); }
        else if (type == 6) {
            if (sub == 0 && G > 192) {
                if (bid < 192) { if constexpr ((MASK & MK_ML2) != 0) for (int r2_ = 0; r2_ < PROBE_ML2_REP; ++r2_) ml2_item(p, jl, bid, L); }
                else { if constexpr ((MASK & MK_XA) != 0) for (int it = bid - 192; it < 512; it += G - 192) xattn_item(p, it, L);
                }
            } else {
                if constexpr ((MASK & MK_ML2) != 0) { if (sub != 2) for (int it = bid; it < 192; it += G) ml2_item(p, jl, it, L); }
                if constexpr ((MASK & MK_XA) != 0) { if (sub != 1) for (int it = bid; it < 512; it += G) xattn_item(p, it, L); }
            }
        } else if (type == 7) { if constexpr ((MASK & MK_ML3) != 0) phase_ml3(p, jl); }
        else if (type == 11) { if constexpr ((MASK & MK_FIN) != 0) phase_final(p); }
        }
        }
#ifdef PROBE_XSYNC
        if (coop) for (int xs = 0; xs < PROBE_XSYNC; ++xs) grid.sync();
#endif
        if (coop && ph + 1 < ph_hi) {
            if (coop == 2) grid.sync();
            else xcd_barrier(xbar);
        }
    }
    __builtin_amdgcn_fence(__ATOMIC_RELEASE, "agent");
}
constexpr int NPH = 1 + 4 * 7 + 2 * 2 + 1;

#define DBG_NOXA 0
#define DBG_NOLRU 0
#define DBG_SKIP 0x0
#ifndef MK_LAUNCHES
#define MK_LAUNCHES 1
#endif

template <int MASK> static bool prep(int& per_cu) {
    if (hipFuncSetAttribute((const void*)mega<MASK>, hipFuncAttributeMaxDynamicSharedMemorySize, LDS_BYTES) != hipSuccess) { fprintf(stderr, "kernel_launch: hipFuncSetAttribute failed (mask %d)\n", MASK); return false; }
    if (hipOccupancyMaxActiveBlocksPerMultiprocessor(&per_cu, (const void*)mega<MASK>, NTHR, LDS_BYTES) != hipSuccess || per_cu < 1) { fprintf(stderr, "kernel_launch: occupancy query says %d (mask %d)\n", per_cu, MASK); per_cu = 1; }
    (void)hipGetLastError();
    return true;
}
template <int MASK> static void launch1(const P& p, int grid, hipStream_t stream) { hipLaunchKernelGGL(mega<MASK>, dim3(grid), dim3(NTHR), LDS_BYTES, stream, p); }

extern "C" void kernel_launch(void* const* d_in, const int* in_sizes, int n_in, void* d_out, int out_size, void* d_ws, size_t ws_size, hipStream_t stream) {
    static int grid = 0;
    if (grid == 0) {
        if (n_in != 32 || out_size != T_ * D_ || ws_size < WS_END) { fprintf(stderr, "kernel_launch: unexpected shapes (n_in %d out %d ws %zu need %zu)\n", n_in, out_size, ws_size, (size_t)WS_END); grid = -1; return; }
        int dev = 0, cus = 0, per_cu = 0;
        (void)hipGetDevice(&dev); (void)hipDeviceGetAttribute(&cus, hipDeviceAttributeMultiprocessorCount, dev);
        bool ok = true;
#if MK_LAUNCHES == 1
        ok = prep<MK_ALL>(per_cu);
#else
        ok = prep<MK_PRO>(per_cu) && prep<MK_GEMM>(per_cu) && prep<MK_LRU>(per_cu) && prep<MK_XA>(per_cu) && prep<MK_ML1>(per_cu) && prep<MK_ML2>(per_cu) && prep<MK_ML3>(per_cu) && prep<MK_FIN>(per_cu);
#endif
        if (!ok) { grid = -1; return; }
        grid = cus > 0 ? cus : 256;
    }
    if (grid < 0) return;
    P p{};
    for (int i = 0; i < 32; ++i) p.in[i] = (const float*)d_in[i];
    p.out = (float*)d_out; p.ws = (unsigned char*)d_ws;
#if MK_LAUNCHES == 1
    p.ph_lo = 0; p.ph_hi = NPH; p.coop = 1; p.pad = 0;
    (void)hipMemsetAsync((unsigned char*)d_ws + WS_BAR, 0, XCD_BAR_WORDS * 4, stream);
    void* args[] = {&p};
    hipError_t e = hipLaunchCooperativeKernel((const void*)mega<MK_ALL>, dim3(grid), dim3(NTHR), args, LDS_BYTES, stream);
    if (e != hipSuccess) fprintf(stderr, "cooperative launch failed: %s (grid %d)\n", hipGetErrorString(e), grid);
#else
    for (int i = 0; i < NPH; ++i) { p.ph_lo = i; p.ph_hi = i + 1; p.coop = 0; p.pad = 0;
        int type;
        if (i == 0) type = 0; else if (i == 33) type = 11; else { const int q = i - 1, r = q & 15; if (r < 7) type = r < 3 ? r + 1 : (r == 3 ? 4 : r + 4); else { const int r2 = r - 7; type = r2 < 3 ? r2 + 1 : r2 + 2; } }
        if (type == 0) launch1<MK_PRO>(p, grid, stream);
#ifdef DBG_SKIP
        else if (((DBG_SKIP >> type) & 1) != 0) {}
#endif
        else if (type == 4) { p.pad = 1; if (!DBG_NOLRU) launch1<MK_LRU>(p, grid, stream); p.pad = 2; if (!DBG_NOXA) launch1<MK_XA>(p, grid, stream); }
        else if (type == 5) launch1<MK_ML1>(p, grid, stream);
        else if (type == 6) { p.pad = 1; launch1<MK_ML2>(p, grid, stream); p.pad = 2; launch1<MK_XA>(p, grid, stream); }
        else if (type == 7) launch1<MK_ML3>(p, grid, stream);
        else if (type == 11) launch1<MK_FIN>(p, grid, stream);
        else launch1<MK_GEMM>(p, grid, stream);
    }
#endif
}
```

```cpp
#include <hip/hip_runtime.h>
#include <hip/hip_cooperative_groups.h>
#include <cstdio>
namespace cg = cooperative_groups;

#define PROBE_ML2_REP 1
#define LAS __attribute__((address_space(3)))
typedef unsigned short bf16_t;
typedef short bf16x8 __attribute__((ext_vector_type(8)));
typedef short s16x4 __attribute__((ext_vector_type(4)));
typedef float f32x4 __attribute__((ext_vector_type(4)));
typedef unsigned u32x4 __attribute__((ext_vector_type(4)));
typedef unsigned u32x2 __attribute__((ext_vector_type(2)));
typedef LAS unsigned char* lds_t;

constexpr int T_ = 16384, D_ = 1024, SEQ_ = 2048, NB_ = 8, FF_ = 2816, MIXW = 1536, INW = 3584, OUTW = 2048, MEMT = 2048;
constexpr float EPS_ = 1e-6f;
constexpr int NTHR = 512;
constexpr int LDS_BYTES = 152 * 1024;

constexpr size_t SZ_GU = (size_t)5632 * 1024 * 2, SZ_DN = (size_t)1024 * 2816 * 2, SZ_IN = (size_t)3584 * 1024 * 2, SZ_KV = (size_t)1024 * 1024 * 2, SZ_OUT = (size_t)1024 * 2048 * 2;
constexpr size_t WL_GU1 = 0, WL_D1 = WL_GU1 + SZ_GU, WL_IN = WL_D1 + SZ_DN, WL_KV = WL_IN + SZ_IN, WL_OUT = WL_KV + SZ_KV, WL_GU2 = WL_OUT + SZ_OUT, WL_D2 = WL_GU2 + SZ_GU, WL_LAYER = WL_D2 + SZ_DN;
constexpr size_t WS_WB = 0;
constexpr size_t WS_U = WS_WB + 4 * WL_LAYER;
constexpr size_t WS_XC = WS_U + (size_t)T_ * INW * 2;
constexpr size_t WS_HOUT = WS_XC + (size_t)T_ * MIXW * 2;
constexpr size_t WS_HB = WS_HOUT + (size_t)T_ * MIXW * 2;
constexpr size_t WS_MEMB = WS_HB + (size_t)T_ * D_ * 2;
constexpr size_t WS_KVM = WS_MEMB + (size_t)MEMT * D_ * 2;
constexpr size_t WS_G = WS_KVM + (size_t)MEMT * D_ * 2;
constexpr size_t WS_SS = WS_G + (size_t)T_ * 8 * 4;
constexpr size_t WS_SSM = WS_SS + (size_t)16 * T_ * 4;
constexpr size_t WS_BAR = WS_SSM + (size_t)MEMT * 16 * 4;
constexpr size_t WS_END = WS_BAR + 16384;

struct P {
    const float* in[32];
    float* out;
    unsigned char* ws;
    int ph_lo, ph_hi, coop, pad;
};
typedef const __attribute__((address_space(4))) P CP;

__device__ __forceinline__ unsigned cvt_pk_bf16(float lo, float hi) { unsigned r; asm("v_cvt_pk_bf16_f32 %0, %1, %2" : "=v"(r) : "v"(lo), "v"(hi)); return r; }
__device__ __forceinline__ float bflo(unsigned w) { return __uint_as_float(w << 16); }
__device__ __forceinline__ float bfhi(unsigned w) { return __uint_as_float(w & 0xffff0000u); }
__device__ __forceinline__ float bf2f(bf16_t b) { return __uint_as_float(((unsigned)b) << 16); }
__device__ __forceinline__ float frcp_(float x) { return __builtin_amdgcn_rcpf(x); }
__device__ __forceinline__ float sigmoidf_(float x) { return frcp_(1.0f + __expf(-x)); }
__device__ __forceinline__ float siluf_(float x) { return x * frcp_(1.0f + __expf(-x)); }
__device__ __forceinline__ float gelu_tanh_(float x) { const float u = 1.5957691216f * (x + 0.044715f * x * x * x); return x * frcp_(1.0f + __expf(-u)); }
__device__ __forceinline__ float softplusf_(float x) { return fmaxf(x, 0.f) + log1pf(__expf(-fabsf(x))); }
__device__ __forceinline__ float wave_sum(float v) {
#pragma unroll
    for (int d = 32; d >= 1; d >>= 1) v += __shfl_xor(v, d);
    return v;
}
template <class Tt> __device__ __forceinline__ Tt lds_ld(lds_t L, int off) { return *(const LAS Tt*)(L + off); }
template <class Tt> __device__ __forceinline__ void lds_st(lds_t L, int off, Tt v) { *(LAS Tt*)(L + off) = v; }
__device__ __forceinline__ bf16x8 tr_pair(lds_t L, int off0, int off1) {
    s16x4 a = __builtin_amdgcn_ds_read_tr16_b64_v4i16((LAS s16x4*)(L + off0));
    s16x4 b = __builtin_amdgcn_ds_read_tr16_b64_v4i16((LAS s16x4*)(L + off1));
    return __builtin_shufflevector(a, b, 0, 1, 2, 3, 4, 5, 6, 7);
}
__device__ __forceinline__ bf16x8 pack8(f32x4 a, f32x4 b) {
    u32x4 w; w.x = cvt_pk_bf16(a[0], a[1]); w.y = cvt_pk_bf16(a[2], a[3]); w.z = cvt_pk_bf16(b[0], b[1]); w.w = cvt_pk_bf16(b[2], b[3]);
    return __builtin_bit_cast(bf16x8, w);
}
__device__ __forceinline__ void st16_sc1(void* ptr, u32x4 v) { asm volatile("global_store_dwordx4 %0, %1, off sc1\n\ts_nop 2" :: "v"(ptr), "v"(v) : "memory"); }
#define MFMA16(a, b, c) __builtin_amdgcn_mfma_f32_16x16x32_bf16((a), (b), (c), 0, 0, 0)

#define XB_TMO      128
#define XB_XCNT(j)  (256  + 64 * (j))
#define XB_XSUB(j)  (1280 + 64 * (j))
#define XB_XGEN(j)  (2304 + 64 * (j))
#define XB_TOP      3328
#define XB_TOPGEN   3392
#define XCD_BAR_WORDS 3456
#define XB_SPIN_CAP (1u << 18)

__device__ __forceinline__ unsigned xb_ld(unsigned* p)              { return __hip_atomic_load(p, __ATOMIC_RELAXED, __HIP_MEMORY_SCOPE_AGENT); }
__device__ __forceinline__ unsigned xb_add(unsigned* p, unsigned v) { return __hip_atomic_fetch_add(p, v, __ATOMIC_RELAXED, __HIP_MEMORY_SCOPE_AGENT); }
__device__ __forceinline__ unsigned xb_xcc_id() { return (unsigned)__builtin_amdgcn_s_getreg((3 << 11) | 20) & 0xFu; }
#define XB_SPIN(cond, bar) do { unsigned _sp = 0; while (cond) { __builtin_amdgcn_s_sleep(1); \
    if ((++_sp & 255u) == 0u) { if (xb_ld(&(bar)[XB_TMO])) break; if (_sp > XB_SPIN_CAP) { atomicAdd(&(bar)[XB_TMO], 1u); break; } } } } while (0)

struct XcdBarrier {
    unsigned* bar; unsigned x;
    volatile LAS unsigned* st;
};

__device__ __forceinline__ XcdBarrier xcd_barrier_post(unsigned* bar, volatile LAS unsigned* st) {
    XcdBarrier b; b.bar = bar; b.x = xb_xcc_id(); b.st = st;
    if (threadIdx.x == 0) (void)xb_add(&bar[XB_XCNT(b.x)], 1u);
    return b;
}
__device__ __forceinline__ void xcd_barrier_complete(unsigned* bar, unsigned x, unsigned& nloc, unsigned& nx) {
    const unsigned G = gridDim.x * gridDim.y * gridDim.z;
    unsigned sum, cnt, mine, sp = 0u;
    for (;;) {
        sum = 0u; cnt = 0u; mine = 0u;
#pragma unroll
        for (unsigned j = 0; j < 16; ++j) { const unsigned c = xb_ld(&bar[XB_XCNT(j)]); sum += c; cnt += (c > 0u) ? 1u : 0u; mine = (j == x) ? c : mine; }
        if (sum == G) break;
        __builtin_amdgcn_s_sleep(1);
        if ((++sp & 255u) == 0u) { if (xb_ld(&bar[XB_TMO])) break; if (sp > XB_SPIN_CAP) { atomicAdd(&bar[XB_TMO], 1u); break; } }
    }
    nloc = mine > 0u ? mine : 1u; nx = cnt > 0u ? cnt : 1u;
}

__device__ __forceinline__ void xcd_barrier(const XcdBarrier& b) {
    asm volatile("s_waitcnt vmcnt(0)" ::: "memory");
    __syncthreads();
    if (threadIdx.x == 0) {
        unsigned* bar = b.bar;
        __builtin_amdgcn_s_waitcnt(0);
        unsigned nloc = b.st[0], nx = b.st[1];
        if (nloc == 0u) { xcd_barrier_complete(bar, b.x, nloc, nx); b.st[0] = nloc; b.st[1] = nx; }
        const unsigned old = xb_add(&bar[XB_XSUB(b.x)], 1u);
        const unsigned gen = old / nloc;
        if (old + 1u == (gen + 1u) * nloc) {
            __builtin_amdgcn_fence(__ATOMIC_RELEASE, "agent");
            asm volatile("s_waitcnt vmcnt(0)" ::: "memory");
            const unsigned og = xb_add(&bar[XB_TOP], 1u);
            const unsigned tg = og / nx;
            if (og + 1u == (tg + 1u) * nx) xb_add(&bar[XB_TOPGEN], 1u);
            else XB_SPIN(xb_ld(&bar[XB_TOPGEN]) == tg, bar);
            __builtin_amdgcn_fence(__ATOMIC_ACQUIRE, "agent");
            xb_add(&bar[XB_XGEN(b.x)], 1u);
            asm volatile("s_waitcnt vmcnt(0)" ::: "memory");
        } else {
            XB_SPIN(xb_ld(&bar[XB_XGEN(b.x)]) == gen, bar);
            __builtin_amdgcn_fence(__ATOMIC_ACQUIRE, "agent");
            asm volatile("s_waitcnt vmcnt(0)" ::: "memory");
        }
    }
    __syncthreads();
}


namespace pg8 {
constexpr int BM = 256, BK = 64, HALF = 128, HTB = HALF * BK * 2, NXCD = 8, WGM = 8;
__device__ __forceinline__ int lds_byte(int r, int c) { const int st = (r >> 4) * 2 + (c >> 5), rr = r & 15, cc = c & 31, ob = rr * 64 + cc * 2; return st * 1024 + (ob ^ (((ob >> 9) & 1) << 5)); }
__device__ __forceinline__ void stage_rc(int b, int& R, int& C) { const int st = b / 1024, sb = b % 1024, swz = sb ^ (((sb >> 9) & 1) << 5); R = (st >> 1) * 16 + swz / 64; C = (st & 1) * 32 + (swz % 64) / 2; }
__device__ __forceinline__ int perm32(int rho) { const int n = rho >> 4, i = rho & 15; return 8 * (i >> 2) + 4 * n + (i & 3); }
struct Unit { int pm, pn; };
struct Gemm { const bf16_t* A; const bf16_t* Bt; int M, N, K, lda; };
struct StaticOrder {
    int nM, nN, nwg, G, c, sf, sl;
    __device__ void init(int M, int N, int G_, int c_) { nM = M / BM; nN = N / BM; nwg = nM * nN; G = G_; c = c_; sf = 1 << 30; sl = 0; }
    __device__ bool next(int i, Unit& u) const {
        const long L = (long)i * G + c; if (L >= nwg) return false;
        int wgid = (int)L; { const int q = nwg / NXCD, r = nwg % NXCD, xcd = wgid % NXCD, off = wgid / NXCD; wgid = (xcd < r ? xcd * (q + 1) : r * (q + 1) + (xcd - r) * q) + off; }
        const int nig = WGM * nN, gid = wgid / nig, fm = gid * WGM, gsz = (nM - fm) < WGM ? (nM - fm) : WGM;
        u.pm = fm + ((wgid % nig) % gsz); u.pn = (wgid % nig) / gsz; if (u.pn >= sf) u.pn += sl; return true;
    }
};

template <class Epi>
__device__ __forceinline__ void gemm_phase(lds_t lds, const Gemm g, const StaticOrder& S, const Epi& E) {
    int tid_ = threadIdx.x; asm volatile("" : "+v"(tid_)); const int tid = tid_, wid = __builtin_amdgcn_readfirstlane(tid >> 6), lane = tid & 63, wr = wid >> 2, wc = wid & 3, fr = lane & 15, fq = lane >> 4;
    const int K = g.K, nt = K / BK, lda = g.lda;
    unsigned voffA[2], voffB[2];
#pragma unroll
    for (int i = 0; i < 2; ++i) { int R, C; stage_rc(tid * 16 + i * 8192, R, C); const int Rb = Epi::PERM ? ((R & ~31) + perm32(R & 31)) : R;
        voffA[i] = (unsigned)(R * lda + C) * 2u; voffB[i] = (unsigned)(Rb * K + C) * 2u; }
    const size_t kstep = (size_t)(BK * 2);
    const size_t hstepA = (size_t)HALF * lda * 2, hstepB = (size_t)HALF * K * 2;
    const size_t tstepA = 2 * hstepA, tstepB = 2 * hstepB;
    const unsigned ldsw = (unsigned)wid * 1024u;
    const int aoff = lds_byte(wr * 64 + fr, fq * 8), boff = lds_byte(wc * 32 + fr, fq * 8);
#define PG8_SA(b, h) (((b) * 2 + (h)) * HTB)
#define PG8_SB(b, h) ((4 + (b) * 2 + (h)) * HTB)
#define PG8_STAGE(bufoff, gbase, voff) do { _Pragma("unroll") for (int _i = 0; _i < 2; ++_i) \
        __builtin_amdgcn_global_load_lds((const unsigned*)((const char*)(gbase) + (voff)[_i]), (LAS unsigned*)(lds + (bufoff) + ldsw + _i * 8192), 16, 0, 0); } while (0)
#define PG8_LDA(dst, b, h) do { _Pragma("unroll") for (int m = 0; m < 4; ++m) _Pragma("unroll") for (int k = 0; k < 2; ++k) dst[m][k] = *(const LAS bf16x8*)(lds + PG8_SA(b, h) + aoff + m * 2048 + k * 1024); } while (0)
#define PG8_LDB(dst, b, h) do { _Pragma("unroll") for (int n = 0; n < 2; ++n) _Pragma("unroll") for (int k = 0; k < 2; ++k) dst[n][k] = *(const LAS bf16x8*)(lds + PG8_SB(b, h) + boff + n * 2048 + k * 1024); } while (0)
#define PG8_MMA(ai, bj, At, Bt) do { __builtin_amdgcn_s_setprio(1); _Pragma("unroll") for (int m = 0; m < 4; ++m) _Pragma("unroll") for (int n = 0; n < 2; ++n) _Pragma("unroll") for (int k = 0; k < 2; ++k) \
        acc[ai][bj][m][n] = __builtin_amdgcn_mfma_f32_16x16x32_bf16(Bt[n][k], At[m][k], acc[ai][bj][m][n], 0, 0, 0); __builtin_amdgcn_s_setprio(0); } while (0)
#define PG8_WAIT_V(n) asm volatile("s_waitcnt vmcnt(" #n ")" ::: "memory")
#define PG8_WAIT_L(n) asm volatile("s_waitcnt lgkmcnt(" #n ")" ::: "memory")
#define PG8_BAR __builtin_amdgcn_s_barrier()
#define PG8_SCHED __builtin_amdgcn_sched_barrier(0)
    Unit cur, nxt; int ui = 0;
    if (!S.next(0, cur)) return;
    f32x4 acc[2][2][4][2];
    E.init(acc, cur, wr, wc, fr, fq);
    bf16x8 At[4][2], B0[2][2], B1[2][2];
    E.rowscales(lds, tid * 32, cur.pm, wr, fr, fq);
    const char* cA = (const char*)g.A + (size_t)cur.pm * tstepA; const char* cB = (const char*)g.Bt + (size_t)cur.pn * tstepB;
    PG8_STAGE(PG8_SB(0, 0), cB, voffB); PG8_STAGE(PG8_SA(0, 0), cA, voffA); PG8_STAGE(PG8_SB(0, 1), cB + hstepB, voffB); PG8_STAGE(PG8_SA(0, 1), cA + hstepA, voffA);
    if (wr == 1) PG8_BAR;
    PG8_WAIT_V(4); PG8_BAR;
    PG8_STAGE(PG8_SB(1, 0), cB + kstep, voffB); PG8_STAGE(PG8_SA(1, 0), cA + kstep, voffA); PG8_STAGE(PG8_SB(1, 1), cB + hstepB + kstep, voffB);
    PG8_WAIT_V(6); PG8_BAR;
    for (;;) {
        const bool has_next = S.next(ui + 1, nxt);
        const char* nA = has_next ? (const char*)g.A + (size_t)nxt.pm * tstepA : cA; const char* nB = has_next ? (const char*)g.Bt + (size_t)nxt.pn * tstepB : cB;
        for (int t = 0; t < nt; t += 2) {
            const bool last = (t == nt - 2);
            const char* a1 = cA + (size_t)(t + 1) * kstep;
            const char* a2 = last ? nA : cA + (size_t)(t + 2) * kstep; const char* b2 = last ? nB : cB + (size_t)(t + 2) * kstep;
            const char* a3 = a2 + kstep; const char* b3 = b2 + kstep;
            PG8_LDB(B0, 0, 0); PG8_SCHED; PG8_LDA(At, 0, 0); PG8_STAGE(PG8_SA(1, 1), a1 + hstepA, voffA);
            PG8_WAIT_L(8); PG8_BAR; PG8_WAIT_L(0); PG8_MMA(0, 0, At, B0); PG8_BAR; PG8_SCHED;
            PG8_LDB(B1, 0, 1); PG8_STAGE(PG8_SB(0, 0), b2, voffB);
            PG8_BAR; PG8_WAIT_L(0); PG8_MMA(0, 1, At, B1); PG8_BAR;
            PG8_LDA(At, 0, 1); PG8_STAGE(PG8_SA(0, 0), a2, voffA);
            PG8_BAR; PG8_WAIT_L(0); PG8_MMA(1, 0, At, B0); PG8_BAR; PG8_SCHED;
            PG8_STAGE(PG8_SB(0, 1), b2 + hstepB, voffB);
            PG8_WAIT_V(6); PG8_BAR; PG8_MMA(1, 1, At, B1); PG8_BAR;
            PG8_LDB(B0, 1, 0); PG8_SCHED; PG8_LDA(At, 1, 0); PG8_STAGE(PG8_SA(0, 1), a2 + hstepA, voffA);
            PG8_WAIT_L(8); PG8_BAR; PG8_WAIT_L(0); PG8_MMA(0, 0, At, B0); PG8_BAR; PG8_SCHED;
            PG8_LDB(B1, 1, 1); PG8_STAGE(PG8_SB(1, 0), b3, voffB);
            PG8_BAR; PG8_WAIT_L(0); PG8_MMA(0, 1, At, B1); PG8_BAR;
            PG8_LDA(At, 1, 1); PG8_STAGE(PG8_SA(1, 0), a3, voffA);
            PG8_BAR; PG8_WAIT_L(0); PG8_MMA(1, 0, At, B0); PG8_BAR; PG8_SCHED;
            PG8_STAGE(PG8_SB(1, 1), b3 + hstepB, voffB);
            PG8_WAIT_V(6); PG8_BAR; PG8_MMA(1, 1, At, B1); PG8_BAR;
        }
        E(acc, lds, tid * 32, cur, wr, wc, fr, fq);
        if (!has_next) break;
        E.init(acc, nxt, wr, wc, fr, fq);
        if (nxt.pm != cur.pm) E.rowscales(lds, tid * 32, nxt.pm, wr, fr, fq);
        cur = nxt; cA = nA; cB = nB; ++ui;
    }
    PG8_WAIT_V(0);
    if (wr == 0) PG8_BAR;
    PG8_BAR;
#undef PG8_SA
#undef PG8_SB
#undef PG8_STAGE
#undef PG8_LDA
#undef PG8_LDB
#undef PG8_MMA
#undef PG8_WAIT_V
#undef PG8_WAIT_L
#undef PG8_BAR
#undef PG8_SCHED
}

__device__ __forceinline__ float rowscale(const float* ss, int row) {
    const f32x4 a = *(const f32x4*)(ss + (size_t)row * 16), b = *(const f32x4*)(ss + (size_t)row * 16 + 4), c = *(const f32x4*)(ss + (size_t)row * 16 + 8), d = *(const f32x4*)(ss + (size_t)row * 16 + 12);
    const float s = ((a[0] + a[1]) + (a[2] + a[3])) + ((b[0] + b[1]) + (b[2] + b[3])) + ((c[0] + c[1]) + (c[2] + c[3])) + ((d[0] + d[1]) + (d[2] + d[3]));
    return rsqrtf(s * (1.0f / 1024.0f) + EPS_); }

struct EpiAll {
    static constexpr bool PERM = true;
    int mode; bf16_t* O; int ldc; const float* ss; float* H; float* ssn;
    __device__ __forceinline__ void init(f32x4 (&acc)[2][2][4][2], const Unit& u, int wr, int wc, int fr, int fq) const {
        if (mode == 2) {
            const int row0 = u.pm * BM + wr * 64 + fr, col0 = u.pn * BM + wc * 32 + 8 * fq;
#pragma unroll
            for (int ai = 0; ai < 2; ++ai)
#pragma unroll
                for (int m = 0; m < 4; ++m)
#pragma unroll
                    for (int bj = 0; bj < 2; ++bj) { const u32x4 hw = *(const u32x4*)(O + (size_t)(row0 + ai * HALF + m * 16) * D_ + col0 + bj * HALF);
                        acc[ai][bj][m][0] = (f32x4){bflo(hw.x), bfhi(hw.x), bflo(hw.y), bfhi(hw.y)}; acc[ai][bj][m][1] = (f32x4){bflo(hw.z), bfhi(hw.z), bflo(hw.w), bfhi(hw.w)}; }
        } else {
#pragma unroll
            for (int a = 0; a < 2; ++a)
#pragma unroll
                for (int b = 0; b < 2; ++b)
#pragma unroll
                    for (int m = 0; m < 4; ++m)
#pragma unroll
                        for (int n = 0; n < 2; ++n) acc[a][b][m][n] = (f32x4){0.f, 0.f, 0.f, 0.f};
        }
    }
    __device__ __forceinline__ void rowscales(lds_t lds, int tslot, int pm, int wr, int fr, int fq) const {
        float rs[2][4];
        if (mode != 2) { const int row0 = pm * BM + wr * 64 + fr; f32x4 t[2][4];
#pragma unroll
            for (int ai = 0; ai < 2; ++ai)
#pragma unroll
                for (int m = 0; m < 4; ++m) t[ai][m] = *(const f32x4*)(ss + (size_t)(row0 + ai * HALF + m * 16) * 16 + 4 * fq);
#pragma unroll
            for (int ai = 0; ai < 2; ++ai)
#pragma unroll
                for (int m = 0; m < 4; ++m) { float sm = (t[ai][m][0] + t[ai][m][1]) + (t[ai][m][2] + t[ai][m][3]);
                    sm += __shfl_xor(sm, 16); sm += __shfl_xor(sm, 32);
                    rs[ai][m] = rsqrtf(sm * (1.0f / 1024.0f) + EPS_); }
            *(LAS f32x4*)(lds + 131072 + tslot) = (f32x4){rs[0][0], rs[0][1], rs[0][2], rs[0][3]};
            *(LAS f32x4*)(lds + 131072 + tslot + 16) = (f32x4){rs[1][0], rs[1][1], rs[1][2], rs[1][3]}; }
    }
    __device__ __forceinline__ void operator()(const f32x4 (&acc)[2][2][4][2], lds_t lds, int tslot, const Unit& u, int wr, int wc, int fr, int fq) const {
        const int row0 = u.pm * BM + wr * 64 + fr;
        if (mode != 2) {
            float rs[2][4];
            { const f32x4 r0 = *(const LAS f32x4*)(lds + 131072 + tslot), r1 = *(const LAS f32x4*)(lds + 131072 + tslot + 16);
              rs[0][0] = r0[0]; rs[0][1] = r0[1]; rs[0][2] = r0[2]; rs[0][3] = r0[3]; rs[1][0] = r1[0]; rs[1][1] = r1[1]; rs[1][2] = r1[2]; rs[1][3] = r1[3]; }
            if (mode == 0) {
                const int col0 = u.pn * 128 + wc * 32 + 8 * fq;
#pragma unroll
                for (int ai = 0; ai < 2; ++ai)
#pragma unroll
                    for (int m = 0; m < 4; ++m) { const int row = row0 + ai * HALF + m * 16; const float r1 = rs[ai][m];
                        float v[8];
#pragma unroll
                        for (int n = 0; n < 2; ++n)
#pragma unroll
                            for (int j = 0; j < 4; ++j) { const float gt = acc[ai][0][m][n][j] * r1, up = acc[ai][1][m][n][j] * r1; v[n * 4 + j] = siluf_(gt) * up; }
                        u32x4 w; w.x = cvt_pk_bf16(v[0], v[1]); w.y = cvt_pk_bf16(v[2], v[3]); w.z = cvt_pk_bf16(v[4], v[5]); w.w = cvt_pk_bf16(v[6], v[7]);
                        st16_sc1(O + (size_t)row * FF_ + col0, w); }
            } else {
                const int col0 = u.pn * BM + wc * 32 + 8 * fq;
#pragma unroll
                for (int ai = 0; ai < 2; ++ai)
#pragma unroll
                    for (int m = 0; m < 4; ++m) { const int row = row0 + ai * HALF + m * 16; const float r1 = rs[ai][m];
#pragma unroll
                        for (int bj = 0; bj < 2; ++bj) { const f32x4 v0 = acc[ai][bj][m][0] * r1, v1 = acc[ai][bj][m][1] * r1;
                            u32x4 w; w.x = cvt_pk_bf16(v0[0], v0[1]); w.y = cvt_pk_bf16(v0[2], v0[3]); w.z = cvt_pk_bf16(v1[0], v1[1]); w.w = cvt_pk_bf16(v1[2], v1[3]);
                            st16_sc1(O + (size_t)row * ldc + col0 + bj * HALF, w); } }
            }
        } else {
            const int col0 = u.pn * BM + wc * 32 + 8 * fq;
#pragma unroll
            for (int ai = 0; ai < 2; ++ai)
#pragma unroll
                for (int m = 0; m < 4; ++m) { const int row = row0 + ai * HALF + m * 16; float s2 = 0.f;
#pragma unroll
                    for (int bj = 0; bj < 2; ++bj) { const size_t o = (size_t)row * D_ + col0 + bj * HALF;
                        const f32x4 h0 = acc[ai][bj][m][0], h1 = acc[ai][bj][m][1];
                        u32x4 w; w.x = cvt_pk_bf16(h0[0], h0[1]); w.y = cvt_pk_bf16(h0[2], h0[3]); w.z = cvt_pk_bf16(h1[0], h1[1]); w.w = cvt_pk_bf16(h1[2], h1[3]);
                        st16_sc1(O + o, w);
                        s2 += h0[0] * h0[0] + h0[1] * h0[1] + h0[2] * h0[2] + h0[3] * h0[3] + h1[0] * h1[0] + h1[1] * h1[1] + h1[2] * h1[2] + h1[3] * h1[3]; }
                    s2 += __shfl_xor(s2, 16); s2 += __shfl_xor(s2, 32);
                    if (fq == 0) ssn[(size_t)row * 16 + u.pn * 4 + wc] = s2; }
        }
    }
};
}

struct TileDesc { const float* src; const float* gain; bf16_t* dst; float base; };
__device__ __forceinline__ int dim_of(int code) { return code == 0 ? FF_ : (code == 1 ? D_ : (code == 2 ? INW : OUTW)); }
__device__ __forceinline__ TileDesc tile_desc(CP& p, int g, int tid) {
    constexpr int TPL = 5888;
    const int l = g / TPL, r = g % TPL;
    const int seg = (r >= 704) + (r >= 1408) + (r >= 2112) + (r >= 3008) + (r >= 3264) + (r >= 3776) + (r >= 4480) + (r >= 5184);
    const int start = seg < 3 ? seg * 704 : (seg == 3 ? 2112 : (seg == 4 ? 3008 : (seg == 5 ? 3264 : 3776 + (seg - 6) * 704)));
    const int sh = 4 * seg;
    const int in_idx = (int)((0xEDCA97543ull >> sh) & 15), gidx = (int)((0x0CC097033ull >> sh) & 15), mode = (int)((0x021000021ull >> sh) & 15);
    const int N = dim_of((int)((0x100112100ull >> sh) & 15)), K = dim_of((int)((0x011311011ull >> sh) & 15));
    const size_t wl = seg < 2 ? WL_GU1 : (seg == 2 ? WL_D1 : (seg == 3 ? WL_IN : (seg == 4 ? WL_KV : (seg == 5 ? WL_OUT : (seg < 8 ? WL_GU2 : WL_D2)))));
    const int rr = r - start, ntn = N >> 6, kt = rr / ntn, nt = rr - kt * ntn;
    const float* W = p.in[in_idx] + (size_t)l * K * N;
    TileDesc d;
    d.src = W + (size_t)(kt * 64 + (tid >> 3)) * N + nt * 64 + (tid & 7) * 8;
    d.gain = gidx ? p.in[gidx - 1] + l * D_ + kt * 64 + (tid >> 3) : nullptr;
    const int nn = nt * 64 + (tid >> 3); const int drow = mode == 0 ? nn : ((nn >> 7) * 256 + (mode == 2 ? 128 : 0) + (nn & 127));
    d.dst = (bf16_t*)(p.ws + WS_WB + (size_t)l * WL_LAYER + wl) + (size_t)drow * K + kt * 64 + 8 * (tid & 7);
    d.base = (seg == 2 || seg == 8) ? 0.5f : 1.0f;
    return d;
}
__device__ __forceinline__ void transpose_range(CP& p, lds_t L, int g0, int gend, int stride) {
    int tid_ = threadIdx.x; asm volatile("" : "+v"(tid_)); const int tid = tid_;
    int g = g0; asm volatile("" : "+s"(g));
    f32x4 a = (f32x4){0.f, 0.f, 0.f, 0.f}, b = a; float gn = 1.f; TileDesc cur; cur.dst = nullptr;
    __syncthreads();
    if (g < gend) { cur = tile_desc(p, g, tid); a = *(const f32x4*)cur.src; b = *(const f32x4*)(cur.src + 4); gn = cur.base * (cur.gain ? *cur.gain : 1.0f); }
    for (; g < gend; g += stride) {
        const int gnx = g + stride; TileDesc nxt; nxt.dst = nullptr; f32x4 na = a, nb = b; float ng = 1.f;
        if (gnx < gend) { nxt = tile_desc(p, gnx, tid); na = *(const f32x4*)nxt.src; nb = *(const f32x4*)(nxt.src + 4); ng = nxt.base * (nxt.gain ? *nxt.gain : 1.0f); }
        { const int r = tid >> 3, c8 = (tid & 7) * 8, o = (r * 65 + c8) * 4;
          lds_st<float>(L, o, a[0] * gn); lds_st<float>(L, o + 4, a[1] * gn); lds_st<float>(L, o + 8, a[2] * gn); lds_st<float>(L, o + 12, a[3] * gn);
          lds_st<float>(L, o + 16, b[0] * gn); lds_st<float>(L, o + 20, b[1] * gn); lds_st<float>(L, o + 24, b[2] * gn); lds_st<float>(L, o + 28, b[3] * gn); }
        __syncthreads();
        { const int n = tid >> 3, kc = tid & 7; float v[8];
#pragma unroll
          for (int j = 0; j < 8; ++j) v[j] = lds_ld<float>(L, ((8 * kc + j) * 65 + n) * 4);
          u32x4 w; w.x = cvt_pk_bf16(v[0], v[1]); w.y = cvt_pk_bf16(v[2], v[3]); w.z = cvt_pk_bf16(v[4], v[5]); w.w = cvt_pk_bf16(v[6], v[7]);
          *(u32x4*)cur.dst = w; }
        __syncthreads();
        cur = nxt; a = na; b = nb; gn = ng;
    }
}

__device__ __forceinline__ void phase_prologue(CP& p, lds_t L) {
    int tid_ = threadIdx.x; asm volatile("" : "+v"(tid_)); const int tid = tid_, lane = tid & 63, wid = tid >> 6;
    unsigned char* ws = p.ws;
    { bf16_t* HB = (bf16_t*)(ws + WS_HB); float* ss = (float*)(ws + WS_SS); bf16_t* MB = (bf16_t*)(ws + WS_MEMB); float* ssm = (float*)(ws + WS_SSM);
      for (int row = blockIdx.x * 8 + wid; row < T_ + MEMT; row += gridDim.x * 8) {
          const bool isx = row < T_; const int r = isx ? row : row - T_;
          const float* src = (isx ? p.in[0] : p.in[1]) + (size_t)r * D_; float s2 = 0.f;
#pragma unroll
          for (int i = 0; i < 4; ++i) { const int c = i * 256 + lane * 4; const f32x4 v = *(const f32x4*)(src + c);
              s2 += v[0] * v[0] + v[1] * v[1] + v[2] * v[2] + v[3] * v[3];
              u32x2 w; w.x = cvt_pk_bf16(v[0], v[1]); w.y = cvt_pk_bf16(v[2], v[3]);
              if (isx) { *(u32x2*)(HB + (size_t)r * D_ + c) = w; } else { *(u32x2*)(MB + (size_t)r * D_ + c) = w; } }
          s2 = wave_sum(s2);
          if (lane < 16) { const float v = lane == 0 ? s2 : 0.f; if (isx) ss[(size_t)r * 16 + lane] = v; else ssm[(size_t)r * 16 + lane] = v; } } }
    transpose_range(p, L, blockIdx.x, 5888, gridDim.x);
}

__device__ __forceinline__ void lru_item(CP& p, int jl, int item, lds_t L) {
    constexpr int WLo = 0, XCo = 38400, AAo = 89600, UUo = 114176, SEGo = 138752, CARo = 141824;
    int tid_ = threadIdx.x; asm volatile("" : "+v"(tid_)); const int tid = tid_, lane = tid & 63, wid = tid >> 6, fr = lane & 15, fq = lane >> 4;
    const int pair_ = (item & 7) * 8 + (item >> 5), b = pair_ >> 3, n = pair_ & 7, q4 = (item >> 3) & 3;
    bf16_t* U = (bf16_t*)(p.ws + WS_U);
    const float* w_r = p.in[17] + ((size_t)(jl * 8 + n) * 192) * 192; const float* w_i = p.in[19] + ((size_t)(jl * 8 + n) * 192) * 192;
    __syncthreads();
#pragma unroll 1
    for (int r3 = 0; r3 < 3; ++r3) {
        float v[12];
#pragma unroll
        for (int k = 0; k < 12; ++k) { const int idx = tid + NTHR * (12 * r3 + k), i = idx / 96, oo = idx % 96; v[k] = (oo < 48 ? w_r : w_i)[(size_t)i * 192 + 48 * q4 + (oo % 48)]; }
#pragma unroll
        for (int k = 0; k < 12; ++k) { const int idx = tid + NTHR * (12 * r3 + k), i = idx / 96, oo = idx % 96; lds_st<bf16_t>(L, WLo + oo * 400 + i * 2, (bf16_t)(cvt_pk_bf16(v[k], 0.f) & 0xffffu)); }
    }
    if (tid < 96) lds_st<float>(L, CARo + tid * 4, 0.f);
    float br[3], bi[3], sp[3];
#pragma unroll
    for (int t3 = 0; t3 < 3; ++t3) { const int c = jl * MIXW + n * 192 + 48 * q4 + 16 * t3 + fr; br[t3] = p.in[18][c]; bi[t3] = p.in[20][c]; sp[t3] = softplusf_(-p.in[21][c]); }
    const int cg = tid % 24, trow = tid / 24; float cw[4][8], cb[8];
    { const int c0 = jl * MIXW + n * 192 + 8 * cg;
#pragma unroll
      for (int j = 0; j < 4; ++j)
#pragma unroll
          for (int e = 0; e < 8; ++e) cw[j][e] = p.in[15][(size_t)jl * 4 * MIXW + (size_t)j * MIXW + n * 192 + 8 * cg + e];
#pragma unroll
      for (int e = 0; e < 8; ++e) cb[e] = p.in[16][c0 + e]; }
    for (int ck = 0; ck < 16; ++ck) {
        const int t0 = ck * 128;
        u32x4 gpre[2];
#pragma unroll
        for (int k = 0; k < 2; ++k) { const int e = tid + NTHR * k; if (e < 128 * 6) gpre[k] = *(const u32x4*)(U + (size_t)(b * SEQ_ + t0 + e / 6) * INW + MIXW + n * 192 + 48 * q4 + 8 * (e % 6)); }
        if (tid < 384) {
            u32x4 raw[11];
#pragma unroll
            for (int j = 0; j < 11; ++j) { const int tt = t0 + trow * 8 - 3 + j;
                raw[j] = tt >= 0 ? *(const u32x4*)(U + (size_t)(b * SEQ_ + tt) * INW + n * 192 + 8 * cg) : (u32x4){0u, 0u, 0u, 0u}; }
#pragma unroll
            for (int it = 0; it < 8; ++it) { const int t = trow * 8 + it; float acc[8];
#pragma unroll
                for (int e = 0; e < 8; ++e) acc[e] = cb[e];
#pragma unroll
                for (int j = 0; j < 4; ++j) { const u32x4 rw = raw[it + j];
                    acc[0] += cw[j][0] * bflo(rw.x); acc[1] += cw[j][1] * bfhi(rw.x); acc[2] += cw[j][2] * bflo(rw.y); acc[3] += cw[j][3] * bfhi(rw.y);
                    acc[4] += cw[j][4] * bflo(rw.z); acc[5] += cw[j][5] * bfhi(rw.z); acc[6] += cw[j][6] * bflo(rw.w); acc[7] += cw[j][7] * bfhi(rw.w); }
                u32x4 w; w.x = cvt_pk_bf16(acc[0], acc[1]); w.y = cvt_pk_bf16(acc[2], acc[3]); w.z = cvt_pk_bf16(acc[4], acc[5]); w.w = cvt_pk_bf16(acc[6], acc[7]);
                lds_st<u32x4>(L, XCo + t * 400 + cg * 16, w); }
        }
        __syncthreads();
        {
            f32x4 acc[6];
#pragma unroll
            for (int i = 0; i < 6; ++i) acc[i] = (f32x4){0.f, 0.f, 0.f, 0.f};
#pragma unroll
            for (int ks = 0; ks < 6; ++ks) { const bf16x8 a = lds_ld<bf16x8>(L, XCo + (16 * wid + fr) * 400 + (32 * ks + 8 * fq) * 2);
#pragma unroll
                for (int nt = 0; nt < 6; ++nt) { const bf16x8 bb = lds_ld<bf16x8>(L, WLo + (16 * nt + fr) * 400 + (32 * ks + 8 * fq) * 2); acc[nt] = MFMA16(a, bb, acc[nt]); } }
#pragma unroll
            for (int t3 = 0; t3 < 3; ++t3) { const int oc = 16 * t3 + fr;
#pragma unroll
                for (int rg = 0; rg < 4; ++rg) { const int t = 16 * wid + 4 * fq + rg;
                    const float r = sigmoidf_(acc[t3][rg] + br[t3]), gi = sigmoidf_(acc[t3 + 3][rg] + bi[t3]);
                    const float la = -8.0f * r * sp[t3], a = __expf(la), mult = __builtin_amdgcn_sqrtf(fmaxf(1.0f - a * a, 0.f));
                    const float xc = bf2f(lds_ld<bf16_t>(L, XCo + t * 400 + (48 * q4 + oc) * 2));
                    lds_st<float>(L, AAo + (t * 48 + oc) * 4, a); lds_st<float>(L, UUo + (t * 48 + oc) * 4, mult * gi * xc); } }
        }
        __syncthreads();
        const int ch = tid % 48, sg = tid / 48;
        if (tid < 384) { float A = 1.f, Hh = 0.f;
#pragma unroll
            for (int i = 0; i < 16; ++i) { const int t = 16 * sg + i; const float a = lds_ld<float>(L, AAo + (t * 48 + ch) * 4), uu = lds_ld<float>(L, UUo + (t * 48 + ch) * 4); Hh = a * Hh + uu; A *= a; }
            lds_st<float>(L, SEGo + (sg * 48 + ch) * 4, A); lds_st<float>(L, SEGo + 1536 + (sg * 48 + ch) * 4, Hh); }
        __syncthreads();
        if (tid < 384) { float h = lds_ld<float>(L, CARo + ((ck & 1) * 48 + ch) * 4);
            for (int s2 = 0; s2 < sg; ++s2) h = lds_ld<float>(L, SEGo + (s2 * 48 + ch) * 4) * h + lds_ld<float>(L, SEGo + 1536 + (s2 * 48 + ch) * 4);
#pragma unroll
            for (int i = 0; i < 16; ++i) { const int t = 16 * sg + i; const float a = lds_ld<float>(L, AAo + (t * 48 + ch) * 4), uu = lds_ld<float>(L, UUo + (t * 48 + ch) * 4); h = a * h + uu; lds_st<float>(L, UUo + (t * 48 + ch) * 4, h); }
            if (sg == 7) lds_st<float>(L, CARo + (((ck + 1) & 1) * 48 + ch) * 4, h); }
        __syncthreads();
#pragma unroll
        for (int k = 0; k < 2; ++k) { const int e = tid + NTHR * k;
            if (e < 128 * 6) { const int t = e / 6, c8 = e % 6;
                const f32x4 h0 = lds_ld<f32x4>(L, UUo + (t * 48 + 8 * c8) * 4), h1 = lds_ld<f32x4>(L, UUo + (t * 48 + 8 * c8 + 4) * 4);
                bf16_t* gp = U + (size_t)(b * SEQ_ + t0 + t) * INW + MIXW + n * 192 + 48 * q4 + 8 * c8; const u32x4 g = gpre[k];
                u32x4 w; w.x = cvt_pk_bf16(h0[0] * gelu_tanh_(bflo(g.x)), h0[1] * gelu_tanh_(bfhi(g.x))); w.y = cvt_pk_bf16(h0[2] * gelu_tanh_(bflo(g.y)), h0[3] * gelu_tanh_(bfhi(g.y)));
                w.z = cvt_pk_bf16(h1[0] * gelu_tanh_(bflo(g.z)), h1[1] * gelu_tanh_(bfhi(g.z))); w.w = cvt_pk_bf16(h1[2] * gelu_tanh_(bflo(g.w)), h1[3] * gelu_tanh_(bfhi(g.w)));
                st16_sc1(gp, w); } }
    }
}

__device__ __forceinline__ void xattn_item(CP& p, int item, lds_t L) {
    constexpr int KMo = 0, VMo = 69632;
    int tid_ = threadIdx.x; asm volatile("" : "+v"(tid_)); const int tid = tid_, lane = tid & 63, wid = tid >> 6, fr = lane & 15, fq = lane >> 4;
    const int slotx_ = item >> 3, pairx_ = (item & 7) * 4 + (slotx_ >> 4), b = pairx_ >> 2, hx = pairx_ & 3, qt = slotx_ & 15;
    bf16_t* U = (bf16_t*)(p.ws + WS_U); const bf16_t* KV = (const bf16_t*)(p.ws + WS_KVM);
    __syncthreads();
    for (int e = tid; e < 4096; e += NTHR) { const int key = e >> 4, ch = e & 15; const bf16_t* src = KV + (size_t)(b * 256 + key) * 1024 + hx * 128 + ch * 8;
        lds_st<u32x4>(L, KMo + key * 272 + ch * 16, *(const u32x4*)src); lds_st<u32x4>(L, VMo + key * 288 + ch * 16, *(const u32x4*)(src + 512)); }
    bf16_t* qrow = U + (size_t)(b * SEQ_ + qt * 128 + 16 * wid + fr) * INW + 2 * MIXW + hx * 128;
    bf16x8 Bq[4];
#pragma unroll
    for (int ks = 0; ks < 4; ++ks) Bq[ks] = *(const bf16x8*)(qrow + 32 * ks + 8 * fq);
    __syncthreads();
    f32x4 S[16];
#pragma unroll
    for (int kt = 0; kt < 16; ++kt) { f32x4 a = (f32x4){0.f, 0.f, 0.f, 0.f};
#pragma unroll
        for (int ks = 0; ks < 4; ++ks) a = MFMA16(lds_ld<bf16x8>(L, KMo + (16 * kt + fr) * 272 + (32 * ks + 8 * fq) * 2), Bq[ks], a);
        S[kt] = a; }
    float mx = -3.0e38f;
#pragma unroll
    for (int kt = 0; kt < 16; ++kt)
#pragma unroll
        for (int j = 0; j < 4; ++j) mx = fmaxf(mx, S[kt][j]);
    mx = fmaxf(mx, __shfl_xor(mx, 16)); mx = fmaxf(mx, __shfl_xor(mx, 32));
    const float sc = 0.08838834764831845f; float lsum = 0.f;
#pragma unroll
    for (int kt = 0; kt < 16; ++kt)
#pragma unroll
        for (int j = 0; j < 4; ++j) { const float e = __expf((S[kt][j] - mx) * sc); S[kt][j] = e; lsum += e; }
    lsum += __shfl_xor(lsum, 16); lsum += __shfl_xor(lsum, 32);
    f32x4 O[8];
#pragma unroll
    for (int dt = 0; dt < 8; ++dt) O[dt] = (f32x4){0.f, 0.f, 0.f, 0.f};
#pragma unroll
    for (int i = 0; i < 8; ++i) { const bf16x8 bp = pack8(S[2 * i], S[2 * i + 1]);
#pragma unroll
        for (int dt = 0; dt < 8; ++dt) { const int o0 = VMo + (32 * i + 4 * fq + (fr >> 2)) * 288 + (16 * dt + 4 * (fr & 3)) * 2;
#ifdef DBG_NOTR
            u32x4 af;
            { unsigned e[8];
#pragma unroll
              for (int j = 0; j < 8; ++j) { const int key = 32 * i + (j < 4 ? 4 * fq + j : 16 + 4 * fq + (j - 4)); e[j] = lds_ld<bf16_t>(L, VMo + key * 288 + (16 * dt + fr) * 2); }
              af.x = e[0] | (e[1] << 16); af.y = e[2] | (e[3] << 16); af.z = e[4] | (e[5] << 16); af.w = e[6] | (e[7] << 16); }
            (void)o0; O[dt] = MFMA16(__builtin_bit_cast(bf16x8, af), bp, O[dt]); } }
#else
            O[dt] = MFMA16(tr_pair(L, o0, o0 + 16 * 288), bp, O[dt]); } }
#endif
    float inv = frcp_(lsum);
#ifdef DBG_IDENT
    { const u32x4 q0 = __builtin_bit_cast(u32x4, Bq[0]);
#pragma unroll
      for (int dt = 0; dt < 8; ++dt) { O[dt][0] = bflo(q0.x) + dt; O[dt][1] = bfhi(q0.x); O[dt][2] = bflo(q0.y); O[dt][3] = bfhi(q0.y); } inv = 1.0f; }
#endif
#pragma unroll
    for (int dt = 0; dt < 8; ++dt) { u32x2 w; w.x = cvt_pk_bf16(O[dt][0] * inv, O[dt][1] * inv); w.y = cvt_pk_bf16(O[dt][2] * inv, O[dt][3] * inv);
        *(u32x2*)(qrow + 16 * dt + 4 * fq) = w; }
}

__device__ __forceinline__ void ml1_item(CP& p, int jl, int item, lds_t L) {
    int tid_ = threadIdx.x; asm volatile("" : "+v"(tid_)); const int tid = tid_, lane = tid & 63, wid = tid >> 6;
    const bf16_t* U = (const bf16_t*)(p.ws + WS_U); bf16_t* QB = (bf16_t*)(p.ws + WS_XC); bf16_t* KB = (bf16_t*)p.out; float* G = (float*)(p.ws + WS_G);
    const int j = tid < 384 ? tid : 0;
    float cw[4][4], cb[4], Wx[4][8], Wm[4][8];
    f32x4 wq4[4], wk4[4];
    { const float* wqp = p.in[24] + ((size_t)jl * 384 + j) * 16; const float* wkp = p.in[25] + ((size_t)jl * 384 + j) * 16;
#pragma unroll
      for (int i = 0; i < 4; ++i) { wq4[i] = *(const f32x4*)(wqp + 4 * i); wk4[i] = *(const f32x4*)(wkp + 4 * i); } }
    {
#pragma unroll
        for (int k = 0; k < 4; ++k)
#pragma unroll
            for (int c = 0; c < 4; ++c) cw[k][c] = p.in[22][(size_t)jl * 4 * MIXW + (size_t)k * MIXW + 4 * j + c];
#pragma unroll
        for (int c = 0; c < 4; ++c) cb[c] = p.in[23][jl * MIXW + 4 * j + c];
        const float* wq = p.in[24] + ((size_t)jl * 384 + j) * 16; const float* wk = p.in[25] + ((size_t)jl * 384 + j) * 16; const float* wv = p.in[26] + ((size_t)jl * 384 + j) * 16;
        const float* Wg = p.in[27] + (size_t)jl * 4608 * 8;
#pragma unroll
        for (int i = 0; i < 4; ++i)
#pragma unroll
            for (int g = 0; g < 8; ++g) { Wx[i][g] = 0.f; Wm[i][g] = 0.f; }
#pragma unroll 1
        for (int o = 0; o < 4; ++o) {
            float gq[8], gk[8], gv[8];
#pragma unroll
            for (int g = 0; g < 8; ++g) { gq[g] = Wg[(size_t)(4 * j + o) * 8 + g]; gk[g] = Wg[(size_t)(MIXW + 4 * j + o) * 8 + g]; gv[g] = Wg[(size_t)(2 * MIXW + 4 * j + o) * 8 + g]; }
#pragma unroll
            for (int i = 0; i < 4; ++i) { const float a = wq[i * 4 + o], bk = wk[i * 4 + o], cv = wv[i * 4 + o];
#pragma unroll
                for (int g = 0; g < 8; ++g) { Wx[i][g] += a * gq[g] + bk * gk[g]; Wm[i][g] += cv * gv[g]; } } }
    }
    const int r0 = item * 64, tm0 = r0 % SEQ_;
    float x3[4], x2[4], x1[4], x0[4];
    auto ldx = [&](int row, float* x) { const u32x2 raw = *(const u32x2*)(U + (size_t)row * INW + 4 * j); x[0] = bflo(raw.x); x[1] = bfhi(raw.x); x[2] = bflo(raw.y); x[3] = bfhi(raw.y); };
#pragma unroll
    for (int c = 0; c < 4; ++c) { x3[c] = 0.f; x2[c] = 0.f; x1[c] = 0.f; }
    if (tm0 > 0) { ldx(r0 - 3, x3); ldx(r0 - 2, x2); ldx(r0 - 1, x1); }
    for (int tb = 0; tb < 8; ++tb) {
        __syncthreads();
        if (tid < 384) {
            u32x2 xraw[8];
#pragma unroll
            for (int tt = 0; tt < 8; ++tt) xraw[tt] = *(const u32x2*)(U + (size_t)(r0 + tb * 8 + tt) * INW + 4 * j);
#pragma unroll
            for (int tt = 0; tt < 8; ++tt) { const int row = r0 + tb * 8 + tt; x0[0] = bflo(xraw[tt].x); x0[1] = bfhi(xraw[tt].x); x0[2] = bflo(xraw[tt].y); x0[3] = bfhi(xraw[tt].y); float xc[4];
#pragma unroll
                for (int c = 0; c < 4; ++c) xc[c] = siluf_(cb[c] + cw[0][c] * x3[c] + cw[1][c] * x2[c] + cw[2][c] * x1[c] + cw[3][c] * x0[c]);
                { const f32x4 q = wq4[0] * xc[0] + wq4[1] * xc[1] + wq4[2] * xc[2] + wq4[3] * xc[3];
                  const f32x4 k = (wk4[0] * xc[0] + wk4[1] * xc[1] + wk4[2] * xc[2] + wk4[3] * xc[3]) * 0.05103103630798288f;
                  u32x2 w; w.x = cvt_pk_bf16(q[0], q[1]); w.y = cvt_pk_bf16(q[2], q[3]); *(u32x2*)(QB + (size_t)row * MIXW + 4 * j) = w;
                  w.x = cvt_pk_bf16(k[0], k[1]); w.y = cvt_pk_bf16(k[2], k[3]); *(u32x2*)(KB + (size_t)row * MIXW + 4 * j) = w; }
#pragma unroll
                for (int g = 0; g < 8; ++g) { float s = 0.f;
#pragma unroll
                    for (int i = 0; i < 4; ++i) s += xc[i] * Wx[i][g] + x0[i] * Wm[i][g];
                    lds_st<float>(L, ((tt * 8 + g) * 388 + tid) * 4, s); }
#pragma unroll
                for (int c = 0; c < 4; ++c) { x3[c] = x2[c]; x2[c] = x1[c]; x1[c] = x0[c]; } }
        }
        __syncthreads();
        {
            const int row = tid >> 3, part = tid & 7; float s = 0.f;
#pragma unroll
            for (int i = 0; i < 12; ++i) { const f32x4 v = lds_ld<f32x4>(L, (row * 388 + part * 48 + 4 * i) * 4); s += (v[0] + v[1]) + (v[2] + v[3]); }
            s += __shfl_xor(s, 1); s += __shfl_xor(s, 2); s += __shfl_xor(s, 4);
            if (part == 0) { const int g = row & 7; const float v = s + p.in[28][jl * 8 + g]; G[(size_t)(r0 + tb * 8 + (row >> 3)) * 8 + g] = g < 4 ? v : -softplusf_(-v); }
        }
    }
}

__device__ __forceinline__ void ml2_item(CP& p, int jl, int item, lds_t L) {
    constexpr int QIo = 0, KIo = 50176, VIo = 100352, PTo = 109568, WQKo = 118784, WVo = 131072, SCo = 132096, NSo = 134144, OXo = 0;
    constexpr int IBo = SCo, MTo = SCo + 256, WIo = SCo + 512, EMo = SCo + 768, WSo = SCo + 1024, DNo = SCo + 1280, NQo = SCo + 1536, MIo = SCo + 1792;
    int tid_ = threadIdx.x; asm volatile("" : "+v"(tid_)); const int tid = tid_, lane = tid & 63, wid = tid >> 6, fr = lane & 15, fq = lane >> 4;
    const int slot_ = item >> 3, pair_ = (item & 7) * 4 + slot_ / 6, b = pair_ >> 2, hh = pair_ & 3, vb = slot_ % 6;
    const int vt = wid & 3, kh = wid >> 2;
    const bf16_t* U = (const bf16_t*)(p.ws + WS_U); const bf16_t* QB = (const bf16_t*)(p.ws + WS_XC); const bf16_t* KB = (const bf16_t*)p.out; const float* G = (const float*)(p.ws + WS_G); bf16_t* HO = (bf16_t*)(p.ws + WS_HOUT);
    __syncthreads();
    if (tid < 256) lds_st<float>(L, WVo + tid * 4, p.in[26][((size_t)jl * 384 + hh * 96 + vb * 16 + (tid >> 4)) * 16 + (tid & 15)]);
    if (tid < 384) lds_st<float>(L, NSo + tid * 4, 0.f);
    f32x4 CT[12];
#pragma unroll
    for (int i = 0; i < 12; ++i) CT[i] = (f32x4){0.f, 0.f, 0.f, 0.f};
    float m_cur = 0.f;
    const int cg = tid % 48, rg = (tid / 48) & 7;
    u32x4 pre[8]; float pli = 0.f, plf = 0.f;
    if (tid < 384) {
#pragma unroll
        for (int it = 0; it < 4; ++it) { pre[it] = *(const u32x4*)(QB + (size_t)(b * SEQ_ + rg * 8 + it) * MIXW + hh * 384 + 8 * cg); pre[4 + it] = *(const u32x4*)(KB + (size_t)(b * SEQ_ + rg * 8 + it) * MIXW + hh * 384 + 8 * cg); }
    } else {
#pragma unroll
        for (int it = 0; it < 4; ++it) { const int e = (tid - 384) + 128 * it; pre[it] = *(const u32x4*)(U + (size_t)(b * SEQ_ + (e >> 3)) * INW + hh * 384 + vb * 64 + 8 * (e & 7)); }
    }
    if (wid == 0) { pli = G[(size_t)(b * SEQ_ + lane) * 8 + hh]; plf = G[(size_t)(b * SEQ_ + lane) * 8 + 4 + hh]; }
    for (int c = 0; c < 32; ++c) {
        const int r0 = b * SEQ_ + 64 * c;
        __syncthreads();
        if (wid == 0) {
            const float li = pli, lf = plf;
            float bc = lf;
#pragma unroll
            for (int d = 1; d < 64; d <<= 1) { const float v = __shfl_up(bc, d); if (lane >= d) bc += v; }
            const float ib = li - bc; float pm = ib;
#pragma unroll
            for (int d = 1; d < 64; d <<= 1) { const float v = __shfl_up(pm, d); if (lane >= d) pm = fmaxf(pm, v); }
            const float Mt = fmaxf(m_cur, pm), M63 = __shfl(Mt, 63), bl = __shfl(bc, 63);
            lds_st<float>(L, IBo + lane * 4, ib); lds_st<float>(L, MTo + lane * 4, Mt); lds_st<float>(L, WIo + lane * 4, __expf(m_cur - Mt)); lds_st<float>(L, EMo + lane * 4, __expf(-(bc + Mt)));
            lds_st<float>(L, WSo + lane * 4, __expf(ib - M63)); lds_st<float>(L, DNo + lane * 4, 0.f);
            if (lane == 0) { lds_st<float>(L, MIo, __expf(m_cur - M63)); lds_st<float>(L, MIo + 4, bl + M63); }
        }
        if (tid < 384) {
            u32x4 lq[4], lk[4];
#pragma unroll
            for (int it = 0; it < 4; ++it) { lq[it] = *(const u32x4*)(QB + (size_t)(r0 + rg * 8 + 4 + it) * MIXW + hh * 384 + 8 * cg); lk[it] = *(const u32x4*)(KB + (size_t)(r0 + rg * 8 + 4 + it) * MIXW + hh * 384 + 8 * cg); }
#pragma unroll
            for (int it = 0; it < 8; ++it) { const int t = rg * 8 + it;
                lds_st<u32x4>(L, QIo + t * 784 + cg * 16, it < 4 ? pre[it] : lq[it - 4]); lds_st<u32x4>(L, KIo + t * 784 + cg * 16, it < 4 ? pre[4 + it] : lk[it - 4]); }
        } else {
#pragma unroll
            for (int it = 0; it < 4; ++it) { const int e = (tid - 384) + 128 * it, t = e >> 3, cp = e & 7; const u32x4 raw = pre[it];
                const float x[8] = {bflo(raw.x), bfhi(raw.x), bflo(raw.y), bfhi(raw.y), bflo(raw.z), bfhi(raw.z), bflo(raw.w), bfhi(raw.w)};
                f32x4 av0 = lds_ld<f32x4>(L, WVo + (2 * cp) * 64) * x[0], av1 = lds_ld<f32x4>(L, WVo + (2 * cp + 1) * 64) * x[4];
#pragma unroll
                for (int i = 1; i < 4; ++i) { av0 = av0 + lds_ld<f32x4>(L, WVo + (2 * cp) * 64 + i * 16) * x[i]; av1 = av1 + lds_ld<f32x4>(L, WVo + (2 * cp + 1) * 64 + i * 16) * x[4 + i]; }
                lds_st<bf16x8>(L, VIo + t * 144 + cp * 16, pack8(av0, av1)); }
        }
        __syncthreads();
        const float decay = lds_ld<float>(L, MIo), m_new = lds_ld<float>(L, MIo + 4);
        {
            const int tt = wid & 3, hf = wid >> 2;
            f32x4 s0 = (f32x4){0.f, 0.f, 0.f, 0.f}, s1 = s0;
            const bool do0 = (2 * hf) <= tt, do1 = (2 * hf + 1) <= tt;
            if (do0) {
#pragma unroll
                for (int ks = 0; ks < 12; ++ks) { const bf16x8 bq = lds_ld<bf16x8>(L, QIo + (16 * tt + fr) * 784 + (32 * ks + 8 * fq) * 2);
                    s0 = MFMA16(lds_ld<bf16x8>(L, KIo + (32 * hf + fr) * 784 + (32 * ks + 8 * fq) * 2), bq, s0);
                    if (do1) s1 = MFMA16(lds_ld<bf16x8>(L, KIo + (32 * hf + 16 + fr) * 784 + (32 * ks + 8 * fq) * 2), bq, s1);
                    if ((ks & 3) == 3) __builtin_amdgcn_sched_barrier(0); } }
            const int t = 16 * tt + fr; const float Mt = lds_ld<float>(L, MTo + t * 4); float psum = 0.f;
#pragma unroll
            for (int sti = 0; sti < 2; ++sti) { const int sb = 32 * hf + 16 * sti + 4 * fq; const f32x4 ibv = lds_ld<f32x4>(L, IBo + sb * 4); f32x4 sv = sti ? s1 : s0; float pv[4];
#pragma unroll
                for (int rg = 0; rg < 4; ++rg) { const int s = sb + rg; pv[rg] = (s <= t) ? sv[rg] * __expf(ibv[rg] - Mt) : 0.f; psum += pv[rg]; }
                u32x2 w; w.x = cvt_pk_bf16(pv[0], pv[1]); w.y = cvt_pk_bf16(pv[2], pv[3]); lds_st<u32x2>(L, PTo + t * 144 + sb * 2, w); }
            psum += __shfl_xor(psum, 16); psum += __shfl_xor(psum, 32);
            if (fq == 0) __hip_atomic_fetch_add((LAS float*)(L + DNo + t * 4), psum, __ATOMIC_RELAXED, __HIP_MEMORY_SCOPE_WORKGROUP);
        }
        f32x4 ao[4];
#pragma unroll
        for (int i = 0; i < 4; ++i) ao[i] = (f32x4){0.f, 0.f, 0.f, 0.f};
#pragma unroll
        for (int i = 0; i < 6; ++i) { const bf16x8 af = pack8(CT[2 * i], CT[2 * i + 1]);
#pragma unroll
            for (int t2 = 0; t2 < 4; ++t2) { const int qo = QIo + (16 * t2 + fr) * 784 + (192 * kh + 32 * i + 4 * fq) * 2;
                const s16x4 lo = lds_ld<s16x4>(L, qo), hi = lds_ld<s16x4>(L, qo + 32);
                ao[t2] = MFMA16(af, __builtin_shufflevector(lo, hi, 0, 1, 2, 3, 4, 5, 6, 7), ao[t2]); }
            __builtin_amdgcn_sched_barrier(0); }
#pragma unroll
        for (int t2 = 0; t2 < 4; ++t2) { const float wi = lds_ld<float>(L, WIo + (16 * t2 + fr) * 4); ao[t2] = ao[t2] * wi; }
        {
            const int t = tid >> 3, part = tid & 7; float s = 0.f;
#pragma unroll
            for (int i = 0; i < 6; ++i) { const u32x4 raw = lds_ld<u32x4>(L, QIo + t * 784 + part * 96 + i * 16);
                const f32x4 n0 = lds_ld<f32x4>(L, NSo + (part * 48 + i * 8) * 4), n1 = lds_ld<f32x4>(L, NSo + (part * 48 + i * 8 + 4) * 4);
                s += bflo(raw.x) * n0[0] + bfhi(raw.x) * n0[1] + bflo(raw.y) * n0[2] + bfhi(raw.y) * n0[3] + bflo(raw.z) * n1[0] + bfhi(raw.z) * n1[1] + bflo(raw.w) * n1[2] + bfhi(raw.w) * n1[3]; }
            s += __shfl_xor(s, 1); s += __shfl_xor(s, 2); s += __shfl_xor(s, 4);
            if (part == 0) lds_st<float>(L, NQo + t * 4, s);
        }
        __syncthreads();
        if (c + 1 < 32) {
            if (tid < 384) {
#pragma unroll
                for (int it = 0; it < 4; ++it) { pre[it] = *(const u32x4*)(QB + (size_t)(r0 + 64 + rg * 8 + it) * MIXW + hh * 384 + 8 * cg); pre[4 + it] = *(const u32x4*)(KB + (size_t)(r0 + 64 + rg * 8 + it) * MIXW + hh * 384 + 8 * cg); }
            } else {
#pragma unroll
                for (int it = 0; it < 4; ++it) { const int e = (tid - 384) + 128 * it; pre[it] = *(const u32x4*)(U + (size_t)(r0 + 64 + (e >> 3)) * INW + hh * 384 + vb * 64 + 8 * (e & 7)); }
            }
            if (wid == 0) { pli = G[(size_t)(r0 + 64 + lane) * 8 + hh]; plf = G[(size_t)(r0 + 64 + lane) * 8 + 4 + hh]; }
        }
        {
            const int o0 = VIo + (32 * kh + 8 * fq + (fr >> 2)) * 144 + (16 * vt + 4 * (fr & 3)) * 2;
            const bf16x8 av = tr_pair(L, o0, o0 + 4 * 144);
#pragma unroll
            for (int t2 = 0; t2 < 4; ++t2) ao[t2] = MFMA16(av, lds_ld<bf16x8>(L, PTo + (16 * t2 + fr) * 144 + (32 * kh + 8 * fq) * 2), ao[t2]);
        }
        if (kh == 1) {
#pragma unroll
            for (int t2 = 0; t2 < 4; ++t2)
#pragma unroll
                for (int rg = 0; rg < 4; ++rg) lds_st<float>(L, OXo + ((vt * 16 + 4 * fq + rg) * 64 + 16 * t2 + fr) * 4, ao[t2][rg]);
        }
        {
            bf16x8 bv[2];
#pragma unroll
            for (int ks = 0; ks < 2; ++ks) { const int o0 = VIo + (32 * ks + 8 * fq + (fr >> 2)) * 144 + (16 * vt + 4 * (fr & 3)) * 2;
                const bf16x8 raw = tr_pair(L, o0, o0 + 4 * 144); const u32x4 rw = __builtin_bit_cast(u32x4, raw);
                const f32x4 w0 = lds_ld<f32x4>(L, WSo + (32 * ks + 8 * fq) * 4), w1 = lds_ld<f32x4>(L, WSo + (32 * ks + 8 * fq + 4) * 4);
                u32x4 o; o.x = cvt_pk_bf16(bflo(rw.x) * w0[0], bfhi(rw.x) * w0[1]); o.y = cvt_pk_bf16(bflo(rw.y) * w0[2], bfhi(rw.y) * w0[3]);
                o.z = cvt_pk_bf16(bflo(rw.z) * w1[0], bfhi(rw.z) * w1[1]); o.w = cvt_pk_bf16(bflo(rw.w) * w1[2], bfhi(rw.w) * w1[3]);
                bv[ks] = __builtin_bit_cast(bf16x8, o); }
#pragma unroll
            for (int kt = 0; kt < 12; ++kt) { f32x4 a = CT[kt] * decay;
#pragma unroll
                for (int ks = 0; ks < 2; ++ks) { const int o0 = KIo + (32 * ks + 8 * fq + (fr >> 2)) * 784 + (192 * kh + 16 * kt + 4 * (fr & 3)) * 2;
                    a = MFMA16(tr_pair(L, o0, o0 + 4 * 784), bv[ks], a); }
                CT[kt] = a; if ((kt & 1) == 1) __builtin_amdgcn_sched_barrier(0); }
        }
        if (tid < 192) { float n0 = decay * lds_ld<float>(L, NSo + tid * 8), n1 = decay * lds_ld<float>(L, NSo + tid * 8 + 4);
#pragma unroll 4
            for (int s4 = 0; s4 < 16; ++s4) { const f32x4 w4 = lds_ld<f32x4>(L, WSo + s4 * 16);
#pragma unroll
                for (int j = 0; j < 4; ++j) { const unsigned kk = lds_ld<unsigned>(L, KIo + (4 * s4 + j) * 784 + tid * 4); n0 += w4[j] * bflo(kk); n1 += w4[j] * bfhi(kk); } }
            lds_st<float>(L, NSo + tid * 8, n0); lds_st<float>(L, NSo + tid * 8 + 4, n1); }
        __syncthreads();
        if (kh == 0) {
#pragma unroll
            for (int t2 = 0; t2 < 4; ++t2) { const int t = 16 * t2 + fr;
                const float dn = fmaxf(fabsf(lds_ld<float>(L, DNo + t * 4) + lds_ld<float>(L, WIo + t * 4) * lds_ld<float>(L, NQo + t * 4)), lds_ld<float>(L, EMo + t * 4));
                const float inv = frcp_(dn); float hv[4];
#pragma unroll
                for (int rg = 0; rg < 4; ++rg) hv[rg] = (ao[t2][rg] + lds_ld<float>(L, OXo + ((vt * 16 + 4 * fq + rg) * 64 + t) * 4)) * inv;
                u32x2 w; w.x = cvt_pk_bf16(hv[0], hv[1]); w.y = cvt_pk_bf16(hv[2], hv[3]);
                *(u32x2*)(HO + (size_t)(r0 + t) * MIXW + hh * 384 + vb * 64 + 16 * vt + 4 * fq) = w; }
        }
        m_cur = m_new;
    }
}

__device__ __forceinline__ void phase_ml3(CP& p, int jl) {
    int tid_ = threadIdx.x; asm volatile("" : "+v"(tid_)); const int tid = tid_, lane = tid & 63, wid = tid >> 6;
    bf16_t* U = (bf16_t*)(p.ws + WS_U); const bf16_t* HO = (const bf16_t*)(p.ws + WS_HOUT);
    const int gw = blockIdx.x * 8 + wid, nw = gridDim.x * 8, hh = gw & 3;
    float lg[6], sk[6], cw[4][6], cb[6];
#pragma unroll
    for (int i = 0; i < 3; ++i) { const int c = jl * MIXW + hh * 384 + 128 * i + 2 * lane; lg[2 * i] = p.in[29][c]; lg[2 * i + 1] = p.in[29][c + 1]; sk[2 * i] = p.in[30][c]; sk[2 * i + 1] = p.in[30][c + 1];
        cb[2 * i] = p.in[23][c]; cb[2 * i + 1] = p.in[23][c + 1];
#pragma unroll
        for (int k = 0; k < 4; ++k) { cw[k][2 * i] = p.in[22][(size_t)jl * 4 * MIXW + (size_t)k * MIXW + hh * 384 + 128 * i + 2 * lane]; cw[k][2 * i + 1] = p.in[22][(size_t)jl * 4 * MIXW + (size_t)k * MIXW + hh * 384 + 128 * i + 2 * lane + 1]; } }
    for (int rb = (gw >> 2) * 4; rb < T_; rb += (nw >> 2) * 4) {
        unsigned hr[4][3], gr[4][3], mr[7][3];
        const int tm = rb % SEQ_;
#pragma unroll
        for (int r = 0; r < 4; ++r)
#pragma unroll
            for (int i = 0; i < 3; ++i) { const int c = hh * 384 + 128 * i + 2 * lane; const size_t row = (size_t)(rb + r);
                hr[r][i] = *(const unsigned*)(HO + row * MIXW + c); gr[r][i] = *(const unsigned*)(U + row * INW + MIXW + c); }
#pragma unroll
        for (int q = 0; q < 7; ++q)
#pragma unroll
            for (int i = 0; i < 3; ++i) { const int c = hh * 384 + 128 * i + 2 * lane;
                mr[q][i] = (tm + q - 3 >= 0) ? *(const unsigned*)(U + (size_t)(rb + q - 3) * INW + c) : 0u; }
#pragma unroll
        for (int r = 0; r < 4; ++r) { float h[6]; float s = 0.f;
#pragma unroll
            for (int i = 0; i < 3; ++i) { h[2 * i] = bflo(hr[r][i]); h[2 * i + 1] = bfhi(hr[r][i]); s += h[2 * i] + h[2 * i + 1]; }
            const float mu = wave_sum(s) * (1.0f / 384.0f); float v2 = 0.f;
#pragma unroll
            for (int i = 0; i < 6; ++i) { h[i] -= mu; v2 += h[i] * h[i]; }
            const float rstd = rsqrtf(wave_sum(v2) * (1.0f / 384.0f) + EPS_);
#pragma unroll
            for (int i = 0; i < 3; ++i) { const int c = hh * 384 + 128 * i + 2 * lane;
                float x0 = cb[2 * i], x1 = cb[2 * i + 1];
#pragma unroll
                for (int k = 0; k < 4; ++k) { x0 += cw[k][2 * i] * bflo(mr[r + k][i]); x1 += cw[k][2 * i + 1] * bfhi(mr[r + k][i]); }
                x0 = siluf_(x0); x1 = siluf_(x1);
                const float y0 = (h[2 * i] * rstd * lg[2 * i] + sk[2 * i] * x0) * siluf_(bflo(gr[r][i]));
                const float y1 = (h[2 * i + 1] * rstd * lg[2 * i + 1] + sk[2 * i + 1] * x1) * siluf_(bfhi(gr[r][i]));
                *(unsigned*)(U + (size_t)(rb + r) * INW + MIXW + c) = cvt_pk_bf16(y0, y1); } }
    }
}

__device__ __forceinline__ void phase_final(CP& p) {
    int tid_ = threadIdx.x; asm volatile("" : "+v"(tid_)); const int tid = tid_, lane = tid & 63, wid = tid >> 6; float* out = p.out; const float* g = p.in[31]; const bf16_t* HB = (const bf16_t*)(p.ws + WS_HB);
    for (int row = blockIdx.x * 8 + wid; row < T_; row += gridDim.x * 8) { float v[16]; float s2 = 0.f;
#pragma unroll
        for (int i = 0; i < 2; ++i) { const u32x4 hw = *(const u32x4*)(HB + (size_t)row * D_ + i * 512 + lane * 8);
            v[8 * i + 0] = bflo(hw.x); v[8 * i + 1] = bfhi(hw.x); v[8 * i + 2] = bflo(hw.y); v[8 * i + 3] = bfhi(hw.y); v[8 * i + 4] = bflo(hw.z); v[8 * i + 5] = bfhi(hw.z); v[8 * i + 6] = bflo(hw.w); v[8 * i + 7] = bfhi(hw.w); }
#pragma unroll
        for (int i = 0; i < 16; ++i) s2 += v[i] * v[i];
        const float rs = rsqrtf(wave_sum(s2) * (1.0f / 1024.0f) + EPS_);
#pragma unroll
        for (int i = 0; i < 2; ++i) { const int c = i * 512 + lane * 8; const f32x4 g0 = *(const f32x4*)(g + c), g1 = *(const f32x4*)(g + c + 4);
            *(f32x4*)(out + (size_t)row * D_ + c) = (f32x4){v[8 * i] * rs * g0[0], v[8 * i + 1] * rs * g0[1], v[8 * i + 2] * rs * g0[2], v[8 * i + 3] * rs * g0[3]};
            *(f32x4*)(out + (size_t)row * D_ + c + 4) = (f32x4){v[8 * i + 4] * rs * g1[0], v[8 * i + 5] * rs * g1[1], v[8 * i + 6] * rs * g1[2], v[8 * i + 7] * rs * g1[3]}; } }
}

constexpr int MK_PRO = 1, MK_GEMM = 2, MK_LRU = 4, MK_XA = 8, MK_ML1 = 16, MK_ML2 = 32, MK_ML3 = 64, MK_FIN = 128, MK_ALL = 255;
template <int MASK>
__global__ void __launch_bounds__(NTHR, 2) mega(P p_arg) {
    extern __shared__ __attribute__((aligned(16))) unsigned char shm[];
    lds_t L = (lds_t)shm;
    cg::grid_group grid = cg::this_grid();
    CP* kp0 = (CP*)__builtin_amdgcn_kernarg_segment_ptr();
    const int G = (int)gridDim.x, bid = (int)blockIdx.x;
    const int ph_lo = p_arg.ph_lo, ph_hi = p_arg.ph_hi, coop = p_arg.coop, sub = p_arg.pad;
    __builtin_amdgcn_fence(__ATOMIC_ACQUIRE, "agent");
    if (threadIdx.x < 4) *(volatile LAS unsigned*)(L + LDS_BYTES - 16 + 4 * threadIdx.x) = 0u;
    __syncthreads();
    XcdBarrier xbar = xcd_barrier_post((unsigned*)(p_arg.ws + WS_BAR), (volatile LAS unsigned*)(L + LDS_BYTES - 16));
    for (int ph = ph_lo; ph < ph_hi; ++ph) {
        CP* kp = kp0; asm volatile("" : "+s"(kp)); CP& p = *kp; unsigned char* ws = p.ws;
        int type, l = 0;
        if (ph == 0) type = 0; else if (ph == 33) type = 11;
        else { const int q = ph - 1, pr = q >> 4, r = q & 15;
            if (r < 7) { l = 2 * pr; type = r < 3 ? r + 1 : (r == 3 ? 4 : r + 4); }
            else { l = 2 * pr + 1; const int r2 = r - 7; type = r2 < 3 ? r2 + 1 : r2 + 2; } }
        const unsigned char* wb = ws + WS_WB + (size_t)l * WL_LAYER; const int jl = l >> 1;
        float* SS = (float*)(ws + WS_SS); bf16_t* HB = (bf16_t*)(ws + WS_HB); bf16_t* U = (bf16_t*)(ws + WS_U);
#ifdef PROBE_REP_TYPES
        const int nrep = ((PROBE_REP_TYPES >> type) & 1) ? 2 : 1;
#else
        const int nrep = 1;
#endif
        for (int rep = 0; rep < nrep; ++rep) {
        if (type == 0) { if constexpr ((MASK & MK_PRO) != 0) phase_prologue(p, L); }
        else {
        const bool split = (l == 3) && coop && G == 256;
        const int tbase = (l + 1) * 5888;
        const bool gemm_now = (type == 1 || type == 9 || type == 2 || type == 8 || type == 10 || type == 3) || (type == 6 && split && bid >= 192);
        if (gemm_now) {
            if constexpr ((MASK & MK_GEMM) != 0) {
            const int npass = ((type == 3 && !split) || (type == 1 && split)) ? 2 : 1;
            for (int pass = 0; pass < npass; ++pass) {
                pg8::Gemm g; pg8::EpiAll E; int c = bid, Ge = G, sf = 1 << 30, sl = 0;
                g.M = T_; g.N = 1024; g.K = 1024; g.lda = 1024; g.A = HB; E.O = U; E.ldc = INW; E.H = p.out; E.ssn = SS; E.ss = SS;
                const bool kvpass = (type == 3 && !split && pass == 0) || (type == 1 && split && pass == 1);
                if (kvpass) { E.mode = 1; g.A = (const bf16_t*)(ws + WS_MEMB); g.Bt = (const bf16_t*)(wb + WL_KV); g.M = MEMT; E.O = (bf16_t*)(ws + WS_KVM); E.ldc = 1024; E.ss = (const float*)(ws + WS_SSM);
                    if (type == 1) c = bid >= 128 ? bid - 128 : (1 << 20); }
                else if (type == 1 || type == 9) { g.Bt = (const bf16_t*)(wb + (type == 1 ? WL_GU1 : WL_GU2)); g.N = 5632; E.mode = 0; }
                else if (type == 3) { E.mode = 1; g.Bt = (const bf16_t*)(wb + WL_IN);
                    if (split) { g.N = 2048; sf = 6; sl = 6; }
                    else { g.N = INW; c = (bid + (G / 16) * 8) % G; } }
                else if (type == 6) { E.mode = 1; g.Bt = (const bf16_t*)(wb + WL_IN); g.N = 1536; sf = 0; sl = 6; Ge = 64; c = bid - 192; }
                else { E.mode = 2; E.O = HB; E.ssn = SS;
                    if (type == 8) { g.A = U + MIXW; g.Bt = (const bf16_t*)(wb + WL_OUT); g.K = OUTW; g.lda = INW; }
                    else { g.A = U; g.Bt = (const bf16_t*)(wb + (type == 2 ? WL_D1 : WL_D2)); g.K = FF_; g.lda = FF_; } }
                pg8::StaticOrder S; S.init(g.M, g.N, Ge, c); S.sf = sf; S.sl = sl; pg8::gemm_phase(L, g, S, E);
            }
            if constexpr ((MASK & MK_PRO) != 0) {
                if (l < 3 && G == 256) {
                    if (type == 1 && bid >= 128) transpose_range(p, L, tbase + (bid - 128), tbase + 2200, 128);
                    else if (type == 3 && bid >= 32 && bid < 128) transpose_range(p, L, tbase + 2200 + (bid - 32), tbase + 3688, 96);
                    else if (type == 9 && bid >= 128) transpose_range(p, L, tbase + 3688 + (bid - 128), tbase + 5888, 128);
                } else if (l < 3 && type == 9) transpose_range(p, L, tbase + bid, tbase + 5888, G);
            } }
        }
        if (type == 4) {

            if constexpr ((MASK & MK_LRU) != 0) { if (sub != 2) for (int it = bid; it < 256; it += G) lru_item(p, jl, it, L); }
            if constexpr ((MASK & MK_XA) != 0) { if (sub != 1) { for (int it = bid; it < 512; it += G) xattn_item(p, it, L);
#ifdef DBG_THRASH
                { const u32x4* src = (const u32x4*)(ws + WS_WB) + (size_t)bid * 131072; unsigned acc = 0;
                  for (int i = threadIdx.x; i < 131072; i += NTHR) { const u32x4 v = src[i]; acc ^= v.x ^ v.y ^ v.z ^ v.w; }
                  if (acc == 0x12345u) ((unsigned*)(ws + WS_G))[0] = acc; }
#endif
            } }
        } else if (type == 5) { if constexpr ((MASK & MK_ML1) != 0) for (int it = bid; it < 256; it += G) ml1_item(p, jl, it, L); }
        else if (type == 6) {
            if (sub == 0 && G > 192) {
                if (bid < 192) { if constexpr ((MASK & MK_ML2) != 0) for (int r2_ = 0; r2_ < PROBE_ML2_REP; ++r2_) ml2_item(p, jl, bid, L); }
                else { if constexpr ((MASK & MK_XA) != 0) for (int it = bid - 192; it < 512; it += G - 192) xattn_item(p, it, L);
                }
            } else {
                if constexpr ((MASK & MK_ML2) != 0) { if (sub != 2) for (int it = bid; it < 192; it += G) ml2_item(p, jl, it, L); }
                if constexpr ((MASK & MK_XA) != 0) { if (sub != 1) for (int it = bid; it < 512; it += G) xattn_item(p, it, L); }
            }
        } else if (type == 7) { if constexpr ((MASK & MK_ML3) != 0) phase_ml3(p, jl); }
        else if (type == 11) { if constexpr ((MASK & MK_FIN) != 0) phase_final(p); }
        }
        }
#ifdef PROBE_XSYNC
        if (coop) for (int xs = 0; xs < PROBE_XSYNC; ++xs) grid.sync();
#endif
        if (coop && ph + 1 < ph_hi) {
            if (coop == 2) grid.sync();
            else xcd_barrier(xbar);
        }
    }
    __builtin_amdgcn_fence(__ATOMIC_RELEASE, "agent");
}
constexpr int NPH = 1 + 4 * 7 + 2 * 2 + 1;

#define DBG_NOXA 0
#define DBG_NOLRU 0
#define DBG_SKIP 0x0
#ifndef MK_LAUNCHES
#define MK_LAUNCHES 1
#endif

template <int MASK> static bool prep(int& per_cu) {
    if (hipFuncSetAttribute((const void*)mega<MASK>, hipFuncAttributeMaxDynamicSharedMemorySize, LDS_BYTES) != hipSuccess) { fprintf(stderr, "kernel_launch: hipFuncSetAttribute failed (mask %d)\n", MASK); return false; }
    if (hipOccupancyMaxActiveBlocksPerMultiprocessor(&per_cu, (const void*)mega<MASK>, NTHR, LDS_BYTES) != hipSuccess || per_cu < 1) { fprintf(stderr, "kernel_launch: occupancy query says %d (mask %d)\n", per_cu, MASK); per_cu = 1; }
    (void)hipGetLastError();
    return true;
}
template <int MASK> static void launch1(const P& p, int grid, hipStream_t stream) { hipLaunchKernelGGL(mega<MASK>, dim3(grid), dim3(NTHR), LDS_BYTES, stream, p); }

extern "C" void kernel_launch(void* const* d_in, const int* in_sizes, int n_in, void* d_out, int out_size, void* d_ws, size_t ws_size, hipStream_t stream) {
    static int grid = 0;
    if (grid == 0) {
        if (n_in != 32 || out_size != T_ * D_ || ws_size < WS_END) { fprintf(stderr, "kernel_launch: unexpected shapes (n_in %d out %d ws %zu need %zu)\n", n_in, out_size, ws_size, (size_t)WS_END); grid = -1; return; }
        int dev = 0, cus = 0, per_cu = 0;
        (void)hipGetDevice(&dev); (void)hipDeviceGetAttribute(&cus, hipDeviceAttributeMultiprocessorCount, dev);
        bool ok = true;
#if MK_LAUNCHES == 1
        ok = prep<MK_ALL>(per_cu);
#else
        ok = prep<MK_PRO>(per_cu) && prep<MK_GEMM>(per_cu) && prep<MK_LRU>(per_cu) && prep<MK_XA>(per_cu) && prep<MK_ML1>(per_cu) && prep<MK_ML2>(per_cu) && prep<MK_ML3>(per_cu) && prep<MK_FIN>(per_cu);
#endif
        if (!ok) { grid = -1; return; }
        grid = cus > 0 ? cus : 256;
    }
    if (grid < 0) return;
    P p{};
    for (int i = 0; i < 32; ++i) p.in[i] = (const float*)d_in[i];
    p.out = (float*)d_out; p.ws = (unsigned char*)d_ws;
#if MK_LAUNCHES == 1
    p.ph_lo = 0; p.ph_hi = NPH; p.coop = 1; p.pad = 0;
    (void)hipMemsetAsync((unsigned char*)d_ws + WS_BAR, 0, XCD_BAR_WORDS * 4, stream);
    void* args[] = {&p};
    hipError_t e = hipLaunchCooperativeKernel((const void*)mega<MK_ALL>, dim3(grid), dim3(NTHR), args, LDS_BYTES, stream);
    if (e != hipSuccess) fprintf(stderr, "cooperative launch failed: %s (grid %d)\n", hipGetErrorString(e), grid);
#else
    for (int i = 0; i < NPH; ++i) { p.ph_lo = i; p.ph_hi = i + 1; p.coop = 0; p.pad = 0;
        int type;
        if (i == 0) type = 0; else if (i == 33) type = 11; else { const int q = i - 1, r = q & 15; if (r < 7) type = r < 3 ? r + 1 : (r == 3 ? 4 : r + 4); else { const int r2 = r - 7; type = r2 < 3 ? r2 + 1 : r2 + 2; } }
        if (type == 0) launch1<MK_PRO>(p, grid, stream);
#ifdef DBG_SKIP
        else if (((DBG_SKIP >> type) & 1) != 0) {}
#endif
        else if (type == 4) { p.pad = 1; if (!DBG_NOLRU) launch1<MK_LRU>(p, grid, stream); p.pad = 2; if (!DBG_NOXA) launch1<MK_XA>(p, grid, stream); }
        else if (type == 5) launch1<MK_ML1>(p, grid, stream);
        else if (type == 6) { p.pad = 1; launch1<MK_ML2>(p, grid, stream); p.pad = 2; launch1<MK_XA>(p, grid, stream); }
        else if (type == 7) launch1<MK_ML3>(p, grid, stream);
        else if (type == 11) launch1<MK_FIN>(p, grid, stream);
        else launch1<MK_GEMM>(p, grid, stream);
    }
#endif
}
```

```cpp
#include <hip/hip_runtime.h>
#include <hip/hip_cooperative_groups.h>
#include <cstdio>
namespace cg = cooperative_groups;

#define PROBE_ML2_REP 1
#define LAS __attribute__((address_space(3)))
typedef unsigned short bf16_t;
typedef short bf16x8 __attribute__((ext_vector_type(8)));
typedef short s16x4 __attribute__((ext_vector_type(4)));
typedef float f32x4 __attribute__((ext_vector_type(4)));
typedef unsigned u32x4 __attribute__((ext_vector_type(4)));
typedef unsigned u32x2 __attribute__((ext_vector_type(2)));
typedef LAS unsigned char* lds_t;

constexpr int T_ = 16384, D_ = 1024, SEQ_ = 2048, NB_ = 8, FF_ = 2816, MIXW = 1536, INW = 3584, OUTW = 2048, MEMT = 2048;
constexpr float EPS_ = 1e-6f;
constexpr int NTHR = 512;
constexpr int LDS_BYTES = 152 * 1024;

constexpr size_t SZ_GU = (size_t)5632 * 1024 * 2, SZ_DN = (size_t)1024 * 2816 * 2, SZ_IN = (size_t)3584 * 1024 * 2, SZ_KV = (size_t)1024 * 1024 * 2, SZ_OUT = (size_t)1024 * 2048 * 2;
constexpr size_t WL_GU1 = 0, WL_D1 = WL_GU1 + SZ_GU, WL_IN = WL_D1 + SZ_DN, WL_KV = WL_IN + SZ_IN, WL_OUT = WL_KV + SZ_KV, WL_GU2 = WL_OUT + SZ_OUT, WL_D2 = WL_GU2 + SZ_GU, WL_LAYER = WL_D2 + SZ_DN;
constexpr size_t WS_WB = 0;
constexpr size_t WS_U = WS_WB + 4 * WL_LAYER;
constexpr size_t WS_XC = WS_U + (size_t)T_ * INW * 2;
constexpr size_t WS_HOUT = WS_XC + (size_t)T_ * MIXW * 2;
constexpr size_t WS_HB = WS_HOUT + (size_t)T_ * MIXW * 2;
constexpr size_t WS_MEMB = WS_HB + (size_t)T_ * D_ * 2;
constexpr size_t WS_KVM = WS_MEMB + (size_t)MEMT * D_ * 2;
constexpr size_t WS_G = WS_KVM + (size_t)MEMT * D_ * 2;
constexpr size_t WS_SS = WS_G + (size_t)T_ * 8 * 4;
constexpr size_t WS_SSM = WS_SS + (size_t)16 * T_ * 4;
constexpr size_t WS_BAR = WS_SSM + (size_t)MEMT * 16 * 4;
constexpr size_t WS_END = WS_BAR + 16384;

struct P {
    const float* in[32];
    float* out;
    unsigned char* ws;
    int ph_lo, ph_hi, coop, pad;
};
typedef const __attribute__((address_space(4))) P CP;

__device__ __forceinline__ unsigned cvt_pk_bf16(float lo, float hi) { unsigned r; asm("v_cvt_pk_bf16_f32 %0, %1, %2" : "=v"(r) : "v"(lo), "v"(hi)); return r; }
__device__ __forceinline__ float bflo(unsigned w) { return __uint_as_float(w << 16); }
__device__ __forceinline__ float bfhi(unsigned w) { return __uint_as_float(w & 0xffff0000u); }
__device__ __forceinline__ float bf2f(bf16_t b) { return __uint_as_float(((unsigned)b) << 16); }
__device__ __forceinline__ float frcp_(float x) { return __builtin_amdgcn_rcpf(x); }
__device__ __forceinline__ float sigmoidf_(float x) { return frcp_(1.0f + __expf(-x)); }
__device__ __forceinline__ float siluf_(float x) { return x * frcp_(1.0f + __expf(-x)); }
__device__ __forceinline__ float gelu_tanh_(float x) { const float u = 1.5957691216f * (x + 0.044715f * x * x * x); return x * frcp_(1.0f + __expf(-u)); }
__device__ __forceinline__ float softplusf_(float x) { return fmaxf(x, 0.f) + log1pf(__expf(-fabsf(x))); }
__device__ __forceinline__ float wave_sum(float v) {
#pragma unroll
    for (int d = 32; d >= 1; d >>= 1) v += __shfl_xor(v, d);
    return v;
}
template <class Tt> __device__ __forceinline__ Tt lds_ld(lds_t L, int off) { return *(const LAS Tt*)(L + off); }
template <class Tt> __device__ __forceinline__ void lds_st(lds_t L, int off, Tt v) { *(LAS Tt*)(L + off) = v; }
__device__ __forceinline__ bf16x8 tr_pair(lds_t L, int off0, int off1) {
    s16x4 a = __builtin_amdgcn_ds_read_tr16_b64_v4i16((LAS s16x4*)(L + off0));
    s16x4 b = __builtin_amdgcn_ds_read_tr16_b64_v4i16((LAS s16x4*)(L + off1));
    return __builtin_shufflevector(a, b, 0, 1, 2, 3, 4, 5, 6, 7);
}
__device__ __forceinline__ bf16x8 pack8(f32x4 a, f32x4 b) {
    u32x4 w; w.x = cvt_pk_bf16(a[0], a[1]); w.y = cvt_pk_bf16(a[2], a[3]); w.z = cvt_pk_bf16(b[0], b[1]); w.w = cvt_pk_bf16(b[2], b[3]);
    return __builtin_bit_cast(bf16x8, w);
}
__device__ __forceinline__ void st16_sc1(void* ptr, u32x4 v) { asm volatile("global_store_dwordx4 %0, %1, off sc1\n\ts_nop 2" :: "v"(ptr), "v"(v) : "memory"); }
#define MFMA16(a, b, c) __builtin_amdgcn_mfma_f32_16x16x32_bf16((a), (b), (c), 0, 0, 0)

#define XB_TMO      128
#define XB_XCNT(j)  (256  + 64 * (j))
#define XB_XSUB(j)  (1280 + 64 * (j))
#define XB_XGEN(j)  (2304 + 64 * (j))
#define XB_TOP      3328
#define XB_TOPGEN   3392
#define XCD_BAR_WORDS 3456
#define XB_SPIN_CAP (1u << 18)

__device__ __forceinline__ unsigned xb_ld(unsigned* p)              { return __hip_atomic_load(p, __ATOMIC_RELAXED, __HIP_MEMORY_SCOPE_AGENT); }
__device__ __forceinline__ unsigned xb_add(unsigned* p, unsigned v) { return __hip_atomic_fetch_add(p, v, __ATOMIC_RELAXED, __HIP_MEMORY_SCOPE_AGENT); }
__device__ __forceinline__ unsigned xb_xcc_id() { return (unsigned)__builtin_amdgcn_s_getreg((3 << 11) | 20) & 0xFu; }
#define XB_SPIN(cond, bar) do { unsigned _sp = 0; while (cond) { __builtin_amdgcn_s_sleep(1); \
    if ((++_sp & 255u) == 0u) { if (xb_ld(&(bar)[XB_TMO])) break; if (_sp > XB_SPIN_CAP) { atomicAdd(&(bar)[XB_TMO], 1u); break; } } } } while (0)

struct XcdBarrier {
    unsigned* bar; unsigned x;
    volatile LAS unsigned* st;
};

__device__ __forceinline__ XcdBarrier xcd_barrier_post(unsigned* bar, volatile LAS unsigned* st) {
    XcdBarrier b; b.bar = bar; b.x = xb_xcc_id(); b.st = st;
    if (threadIdx.x == 0) (void)xb_add(&bar[XB_XCNT(b.x)], 1u);
    return b;
}
__device__ __forceinline__ void xcd_barrier_complete(unsigned* bar, unsigned x, unsigned& nloc, unsigned& nx) {
    const unsigned G = gridDim.x * gridDim.y * gridDim.z;
    unsigned sum, cnt, mine, sp = 0u;
    for (;;) {
        sum = 0u; cnt = 0u; mine = 0u;
#pragma unroll
        for (unsigned j = 0; j < 16; ++j) { const unsigned c = xb_ld(&bar[XB_XCNT(j)]); sum += c; cnt += (c > 0u) ? 1u : 0u; mine = (j == x) ? c : mine; }
        if (sum == G) break;
        __builtin_amdgcn_s_sleep(1);
        if ((++sp & 255u) == 0u) { if (xb_ld(&bar[XB_TMO])) break; if (sp > XB_SPIN_CAP) { atomicAdd(&bar[XB_TMO], 1u); break; } }
    }
    nloc = mine > 0u ? mine : 1u; nx = cnt > 0u ? cnt : 1u;
}

__device__ __forceinline__ void xcd_barrier(const XcdBarrier& b) {
    asm volatile("s_waitcnt vmcnt(0)" ::: "memory");
    __syncthreads();
    if (threadIdx.x == 0) {
        unsigned* bar = b.bar;
        __builtin_amdgcn_s_waitcnt(0);
        unsigned nloc = b.st[0], nx = b.st[1];
        if (nloc == 0u) { xcd_barrier_complete(bar, b.x, nloc, nx); b.st[0] = nloc; b.st[1] = nx; }
        const unsigned old = xb_add(&bar[XB_XSUB(b.x)], 1u);
        const unsigned gen = old / nloc;
        if (old + 1u == (gen + 1u) * nloc) {
            __builtin_amdgcn_fence(__ATOMIC_RELEASE, "agent");
            asm volatile("s_waitcnt vmcnt(0)" ::: "memory");
            const unsigned og = xb_add(&bar[XB_TOP], 1u);
            const unsigned tg = og / nx;
            if (og + 1u == (tg + 1u) * nx) xb_add(&bar[XB_TOPGEN], 1u);
            else XB_SPIN(xb_ld(&bar[XB_TOPGEN]) == tg, bar);
            __builtin_amdgcn_fence(__ATOMIC_ACQUIRE, "agent");
            xb_add(&bar[XB_XGEN(b.x)], 1u);
            asm volatile("s_waitcnt vmcnt(0)" ::: "memory");
        } else {
            XB_SPIN(xb_ld(&bar[XB_XGEN(b.x)]) == gen, bar);
            __builtin_amdgcn_fence(__ATOMIC_ACQUIRE, "agent");
            asm volatile("s_waitcnt vmcnt(0)" ::: "memory");
        }
    }
    __syncthreads();
}


namespace pg8 {
constexpr int BM = 256, BK = 64, HALF = 128, HTB = HALF * BK * 2, NXCD = 8, WGM = 8;
__device__ __forceinline__ int lds_byte(int r, int c) { const int st = (r >> 4) * 2 + (c >> 5), rr = r & 15, cc = c & 31, ob = rr * 64 + cc * 2; return st * 1024 + (ob ^ (((ob >> 9) & 1) << 5)); }
__device__ __forceinline__ void stage_rc(int b, int& R, int& C) { const int st = b / 1024, sb = b % 1024, swz = sb ^ (((sb >> 9) & 1) << 5); R = (st >> 1) * 16 + swz / 64; C = (st & 1) * 32 + (swz % 64) / 2; }
__device__ __forceinline__ int perm32(int rho) { const int n = rho >> 4, i = rho & 15; return 8 * (i >> 2) + 4 * n + (i & 3); }
struct Unit { int pm, pn; };
struct Gemm { const bf16_t* A; const bf16_t* Bt; int M, N, K, lda; };
struct StaticOrder {
    int nM, nN, nwg, G, c, sf, sl;
    __device__ void init(int M, int N, int G_, int c_) { nM = M / BM; nN = N / BM; nwg = nM * nN; G = G_; c = c_; sf = 1 << 30; sl = 0; }
    __device__ bool next(int i, Unit& u) const {
        const long L = (long)i * G + c; if (L >= nwg) return false;
        int wgid = (int)L; { const int q = nwg / NXCD, r = nwg % NXCD, xcd = wgid % NXCD, off = wgid / NXCD; wgid = (xcd < r ? xcd * (q + 1) : r * (q + 1) + (xcd - r) * q) + off; }
        const int nig = WGM * nN, gid = wgid / nig, fm = gid * WGM, gsz = (nM - fm) < WGM ? (nM - fm) : WGM;
        u.pm = fm + ((wgid % nig) % gsz); u.pn = (wgid % nig) / gsz; if (u.pn >= sf) u.pn += sl; return true;
    }
};

template <class Epi>
__device__ __forceinline__ void gemm_phase(lds_t lds, const Gemm g, const StaticOrder& S, const Epi& E) {
    int tid_ = threadIdx.x; asm volatile("" : "+v"(tid_)); const int tid = tid_, wid = __builtin_amdgcn_readfirstlane(tid >> 6), lane = tid & 63, wr = wid >> 2, wc = wid & 3, fr = lane & 15, fq = lane >> 4;
    const int K = g.K, nt = K / BK, lda = g.lda;
    unsigned voffA[2], voffB[2];
#pragma unroll
    for (int i = 0; i < 2; ++i) { int R, C; stage_rc(tid * 16 + i * 8192, R, C); const int Rb = Epi::PERM ? ((R & ~31) + perm32(R & 31)) : R;
        voffA[i] = (unsigned)(R * lda + C) * 2u; voffB[i] = (unsigned)(Rb * K + C) * 2u; }
    const size_t kstep = (size_t)(BK * 2);
    const size_t hstepA = (size_t)HALF * lda * 2, hstepB = (size_t)HALF * K * 2;
    const size_t tstepA = 2 * hstepA, tstepB = 2 * hstepB;
    const unsigned ldsw = (unsigned)wid * 1024u;
    const int aoff = lds_byte(wr * 64 + fr, fq * 8), boff = lds_byte(wc * 32 + fr, fq * 8);
#define PG8_SA(b, h) (((b) * 2 + (h)) * HTB)
#define PG8_SB(b, h) ((4 + (b) * 2 + (h)) * HTB)
#define PG8_STAGE(bufoff, gbase, voff) do { _Pragma("unroll") for (int _i = 0; _i < 2; ++_i) \
        __builtin_amdgcn_global_load_lds((const unsigned*)((const char*)(gbase) + (voff)[_i]), (LAS unsigned*)(lds + (bufoff) + ldsw + _i * 8192), 16, 0, 0); } while (0)
#define PG8_LDA(dst, b, h) do { _Pragma("unroll") for (int m = 0; m < 4; ++m) _Pragma("unroll") for (int k = 0; k < 2; ++k) dst[m][k] = *(const LAS bf16x8*)(lds + PG8_SA(b, h) + aoff + m * 2048 + k * 1024); } while (0)
#define PG8_LDB(dst, b, h) do { _Pragma("unroll") for (int n = 0; n < 2; ++n) _Pragma("unroll") for (int k = 0; k < 2; ++k) dst[n][k] = *(const LAS bf16x8*)(lds + PG8_SB(b, h) + boff + n * 2048 + k * 1024); } while (0)
#define PG8_MMA(ai, bj, At, Bt) do { __builtin_amdgcn_s_setprio(1); _Pragma("unroll") for (int m = 0; m < 4; ++m) _Pragma("unroll") for (int n = 0; n < 2; ++n) _Pragma("unroll") for (int k = 0; k < 2; ++k) \
        acc[ai][bj][m][n] = __builtin_amdgcn_mfma_f32_16x16x32_bf16(Bt[n][k], At[m][k], acc[ai][bj][m][n], 0, 0, 0); __builtin_amdgcn_s_setprio(0); } while (0)
#define PG8_WAIT_V(n) asm volatile("s_waitcnt vmcnt(" #n ")" ::: "memory")
#define PG8_WAIT_L(n) asm volatile("s_waitcnt lgkmcnt(" #n ")" ::: "memory")
#define PG8_BAR __builtin_amdgcn_s_barrier()
#define PG8_SCHED __builtin_amdgcn_sched_barrier(0)
    Unit cur, nxt; int ui = 0;
    if (!S.next(0, cur)) return;
    f32x4 acc[2][2][4][2];
    E.init(acc, cur, wr, wc, fr, fq);
    bf16x8 At[4][2], B0[2][2], B1[2][2];
    E.rowscales(lds, tid * 32, cur.pm, wr, fr, fq);
    const char* cA = (const char*)g.A + (size_t)cur.pm * tstepA; const char* cB = (const char*)g.Bt + (size_t)cur.pn * tstepB;
    PG8_STAGE(PG8_SB(0, 0), cB, voffB); PG8_STAGE(PG8_SA(0, 0), cA, voffA); PG8_STAGE(PG8_SB(0, 1), cB + hstepB, voffB); PG8_STAGE(PG8_SA(0, 1), cA + hstepA, voffA);
    if (wr == 1) PG8_BAR;
    PG8_WAIT_V(4); PG8_BAR;
    PG8_STAGE(PG8_SB(1, 0), cB + kstep, voffB); PG8_STAGE(PG8_SA(1, 0), cA + kstep, voffA); PG8_STAGE(PG8_SB(1, 1), cB + hstepB + kstep, voffB);
    PG8_WAIT_V(6); PG8_BAR;
    for (;;) {
        const bool has_next = S.next(ui + 1, nxt);
        const char* nA = has_next ? (const char*)g.A + (size_t)nxt.pm * tstepA : cA; const char* nB = has_next ? (const char*)g.Bt + (size_t)nxt.pn * tstepB : cB;
        for (int t = 0; t < nt; t += 2) {
            const bool last = (t == nt - 2);
            const char* a1 = cA + (size_t)(t + 1) * kstep;
            const char* a2 = last ? nA : cA + (size_t)(t + 2) * kstep; const char* b2 = last ? nB : cB + (size_t)(t + 2) * kstep;
            const char* a3 = a2 + kstep; const char* b3 = b2 + kstep;
            PG8_LDB(B0, 0, 0); PG8_SCHED; PG8_LDA(At, 0, 0); PG8_STAGE(PG8_SA(1, 1), a1 + hstepA, voffA);
            PG8_WAIT_L(8); PG8_BAR; PG8_WAIT_L(0); PG8_MMA(0, 0, At, B0); PG8_BAR; PG8_SCHED;
            PG8_LDB(B1, 0, 1); PG8_STAGE(PG8_SB(0, 0), b2, voffB);
            PG8_BAR; PG8_WAIT_L(0); PG8_MMA(0, 1, At, B1); PG8_BAR;
            PG8_LDA(At, 0, 1); PG8_STAGE(PG8_SA(0, 0), a2, voffA);
            PG8_BAR; PG8_WAIT_L(0); PG8_MMA(1, 0, At, B0); PG8_BAR; PG8_SCHED;
            PG8_STAGE(PG8_SB(0, 1), b2 + hstepB, voffB);
            PG8_WAIT_V(6); PG8_BAR; PG8_MMA(1, 1, At, B1); PG8_BAR;
            PG8_LDB(B0, 1, 0); PG8_SCHED; PG8_LDA(At, 1, 0); PG8_STAGE(PG8_SA(0, 1), a2 + hstepA, voffA);
            PG8_WAIT_L(8); PG8_BAR; PG8_WAIT_L(0); PG8_MMA(0, 0, At, B0); PG8_BAR; PG8_SCHED;
            PG8_LDB(B1, 1, 1); PG8_STAGE(PG8_SB(1, 0), b3, voffB);
            PG8_BAR; PG8_WAIT_L(0); PG8_MMA(0, 1, At, B1); PG8_BAR;
            PG8_LDA(At, 1, 1); PG8_STAGE(PG8_SA(1, 0), a3, voffA);
            PG8_BAR; PG8_WAIT_L(0); PG8_MMA(1, 0, At, B0); PG8_BAR; PG8_SCHED;
            PG8_STAGE(PG8_SB(1, 1), b3 + hstepB, voffB);
            PG8_WAIT_V(6); PG8_BAR; PG8_MMA(1, 1, At, B1); PG8_BAR;
        }
        E(acc, lds, tid * 32, cur, wr, wc, fr, fq);
        if (!has_next) break;
        E.init(acc, nxt, wr, wc, fr, fq);
        if (nxt.pm != cur.pm) E.rowscales(lds, tid * 32, nxt.pm, wr, fr, fq);
        cur = nxt; cA = nA; cB = nB; ++ui;
    }
    PG8_WAIT_V(0);
    if (wr == 0) PG8_BAR;
    PG8_BAR;
#undef PG8_SA
#undef PG8_SB
#undef PG8_STAGE
#undef PG8_LDA
#undef PG8_LDB
#undef PG8_MMA
#undef PG8_WAIT_V
#undef PG8_WAIT_L
#undef PG8_BAR
#undef PG8_SCHED
}

__device__ __forceinline__ float rowscale(const float* ss, int row) {
    const f32x4 a = *(const f32x4*)(ss + (size_t)row * 16), b = *(const f32x4*)(ss + (size_t)row * 16 + 4), c = *(const f32x4*)(ss + (size_t)row * 16 + 8), d = *(const f32x4*)(ss + (size_t)row * 16 + 12);
    const float s = ((a[0] + a[1]) + (a[2] + a[3])) + ((b[0] + b[1]) + (b[2] + b[3])) + ((c[0] + c[1]) + (c[2] + c[3])) + ((d[0] + d[1]) + (d[2] + d[3]));
    return rsqrtf(s * (1.0f / 1024.0f) + EPS_); }

struct EpiAll {
    static constexpr bool PERM = true;
    int mode; bf16_t* O; int ldc; const float* ss; float* H; float* ssn;
    __device__ __forceinline__ void init(f32x4 (&acc)[2][2][4][2], const Unit& u, int wr, int wc, int fr, int fq) const {
        if (mode == 2) {
            const int row0 = u.pm * BM + wr * 64 + fr, col0 = u.pn * BM + wc * 32 + 8 * fq;
#pragma unroll
            for (int ai = 0; ai < 2; ++ai)
#pragma unroll
                for (int m = 0; m < 4; ++m)
#pragma unroll
                    for (int bj = 0; bj < 2; ++bj) { const u32x4 hw = *(const u32x4*)(O + (size_t)(row0 + ai * HALF + m * 16) * D_ + col0 + bj * HALF);
                        acc[ai][bj][m][0] = (f32x4){bflo(hw.x), bfhi(hw.x), bflo(hw.y), bfhi(hw.y)}; acc[ai][bj][m][1] = (f32x4){bflo(hw.z), bfhi(hw.z), bflo(hw.w), bfhi(hw.w)}; }
        } else {
#pragma unroll
            for (int a = 0; a < 2; ++a)
#pragma unroll
                for (int b = 0; b < 2; ++b)
#pragma unroll
                    for (int m = 0; m < 4; ++m)
#pragma unroll
                        for (int n = 0; n < 2; ++n) acc[a][b][m][n] = (f32x4){0.f, 0.f, 0.f, 0.f};
        }
    }
    __device__ __forceinline__ void rowscales(lds_t lds, int tslot, int pm, int wr, int fr, int fq) const {
        float rs[2][4];
        if (mode != 2) { const int row0 = pm * BM + wr * 64 + fr; f32x4 t[2][4];
#pragma unroll
            for (int ai = 0; ai < 2; ++ai)
#pragma unroll
                for (int m = 0; m < 4; ++m) t[ai][m] = *(const f32x4*)(ss + (size_t)(row0 + ai * HALF + m * 16) * 16 + 4 * fq);
#pragma unroll
            for (int ai = 0; ai < 2; ++ai)
#pragma unroll
                for (int m = 0; m < 4; ++m) { float sm = (t[ai][m][0] + t[ai][m][1]) + (t[ai][m][2] + t[ai][m][3]);
                    sm += __shfl_xor(sm, 16); sm += __shfl_xor(sm, 32);
                    rs[ai][m] = rsqrtf(sm * (1.0f / 1024.0f) + EPS_); }
            *(LAS f32x4*)(lds + 131072 + tslot) = (f32x4){rs[0][0], rs[0][1], rs[0][2], rs[0][3]};
            *(LAS f32x4*)(lds + 131072 + tslot + 16) = (f32x4){rs[1][0], rs[1][1], rs[1][2], rs[1][3]}; }
    }
    __device__ __forceinline__ void operator()(const f32x4 (&acc)[2][2][4][2], lds_t lds, int tslot, const Unit& u, int wr, int wc, int fr, int fq) const {
        const int row0 = u.pm * BM + wr * 64 + fr;
        if (mode != 2) {
            float rs[2][4];
            { const f32x4 r0 = *(const LAS f32x4*)(lds + 131072 + tslot), r1 = *(const LAS f32x4*)(lds + 131072 + tslot + 16);
              rs[0][0] = r0[0]; rs[0][1] = r0[1]; rs[0][2] = r0[2]; rs[0][3] = r0[3]; rs[1][0] = r1[0]; rs[1][1] = r1[1]; rs[1][2] = r1[2]; rs[1][3] = r1[3]; }
            if (mode == 0) {
                const int col0 = u.pn * 128 + wc * 32 + 8 * fq;
#pragma unroll
                for (int ai = 0; ai < 2; ++ai)
#pragma unroll
                    for (int m = 0; m < 4; ++m) { const int row = row0 + ai * HALF + m * 16; const float r1 = rs[ai][m];
                        float v[8];
#pragma unroll
                        for (int n = 0; n < 2; ++n)
#pragma unroll
                            for (int j = 0; j < 4; ++j) { const float gt = acc[ai][0][m][n][j] * r1, up = acc[ai][1][m][n][j] * r1; v[n * 4 + j] = siluf_(gt) * up; }
                        u32x4 w; w.x = cvt_pk_bf16(v[0], v[1]); w.y = cvt_pk_bf16(v[2], v[3]); w.z = cvt_pk_bf16(v[4], v[5]); w.w = cvt_pk_bf16(v[6], v[7]);
                        st16_sc1(O + (size_t)row * FF_ + col0, w); }
            } else {
                const int col0 = u.pn * BM + wc * 32 + 8 * fq;
#pragma unroll
                for (int ai = 0; ai < 2; ++ai)
#pragma unroll
                    for (int m = 0; m < 4; ++m) { const int row = row0 + ai * HALF + m * 16; const float r1 = rs[ai][m];
#pragma unroll
                        for (int bj = 0; bj < 2; ++bj) { const f32x4 v0 = acc[ai][bj][m][0] * r1, v1 = acc[ai][bj][m][1] * r1;
                            u32x4 w; w.x = cvt_pk_bf16(v0[0], v0[1]); w.y = cvt_pk_bf16(v0[2], v0[3]); w.z = cvt_pk_bf16(v1[0], v1[1]); w.w = cvt_pk_bf16(v1[2], v1[3]);
                            st16_sc1(O + (size_t)row * ldc + col0 + bj * HALF, w); } }
            }
        } else {
            const int col0 = u.pn * BM + wc * 32 + 8 * fq;
#pragma unroll
            for (int ai = 0; ai < 2; ++ai)
#pragma unroll
                for (int m = 0; m < 4; ++m) { const int row = row0 + ai * HALF + m * 16; float s2 = 0.f;
#pragma unroll
                    for (int bj = 0; bj < 2; ++bj) { const size_t o = (size_t)row * D_ + col0 + bj * HALF;
                        const f32x4 h0 = acc[ai][bj][m][0], h1 = acc[ai][bj][m][1];
                        u32x4 w; w.x = cvt_pk_bf16(h0[0], h0[1]); w.y = cvt_pk_bf16(h0[2], h0[3]); w.z = cvt_pk_bf16(h1[0], h1[1]); w.w = cvt_pk_bf16(h1[2], h1[3]);
                        st16_sc1(O + o, w);
                        s2 += h0[0] * h0[0] + h0[1] * h0[1] + h0[2] * h0[2] + h0[3] * h0[3] + h1[0] * h1[0] + h1[1] * h1[1] + h1[2] * h1[2] + h1[3] * h1[3]; }
                    s2 += __shfl_xor(s2, 16); s2 += __shfl_xor(s2, 32);
                    if (fq == 0) ssn[(size_t)row * 16 + u.pn * 4 + wc] = s2; }
        }
    }
};
}

struct TileDesc { const float* src; const float* gain; bf16_t* dst; float base; };
__device__ __forceinline__ int dim_of(int code) { return code == 0 ? FF_ : (code == 1 ? D_ : (code == 2 ? INW : OUTW)); }
__device__ __forceinline__ TileDesc tile_desc(CP& p, int g, int tid) {
    constexpr int TPL = 5888;
    const int l = g / TPL, r = g % TPL;
    const int seg = (r >= 704) + (r >= 1408) + (r >= 2112) + (r >= 3008) + (r >= 3264) + (r >= 3776) + (r >= 4480) + (r >= 5184);
    const int start = seg < 3 ? seg * 704 : (seg == 3 ? 2112 : (seg == 4 ? 3008 : (seg == 5 ? 3264 : 3776 + (seg - 6) * 704)));
    const int sh = 4 * seg;
    const int in_idx = (int)((0xEDCA97543ull >> sh) & 15), gidx = (int)((0x0CC097033ull >> sh) & 15), mode = (int)((0x021000021ull >> sh) & 15);
    const int N = dim_of((int)((0x100112100ull >> sh) & 15)), K = dim_of((int)((0x011311011ull >> sh) & 15));
    const size_t wl = seg < 2 ? WL_GU1 : (seg == 2 ? WL_D1 : (seg == 3 ? WL_IN : (seg == 4 ? WL_KV : (seg == 5 ? WL_OUT : (seg < 8 ? WL_GU2 : WL_D2)))));
    const int rr = r - start, ntn = N >> 6, kt = rr / ntn, nt = rr - kt * ntn;
    const float* W = p.in[in_idx] + (size_t)l * K * N;
    TileDesc d;
    d.src = W + (size_t)(kt * 64 + (tid >> 3)) * N + nt * 64 + (tid & 7) * 8;
    d.gain = gidx ? p.in[gidx - 1] + l * D_ + kt * 64 + (tid >> 3) : nullptr;
    const int nn = nt * 64 + (tid >> 3); const int drow = mode == 0 ? nn : ((nn >> 7) * 256 + (mode == 2 ? 128 : 0) + (nn & 127));
    d.dst = (bf16_t*)(p.ws + WS_WB + (size_t)l * WL_LAYER + wl) + (size_t)drow * K + kt * 64 + 8 * (tid & 7);
    d.base = (seg == 2 || seg == 8) ? 0.5f : 1.0f;
    return d;
}
__device__ __forceinline__ void transpose_range(CP& p, lds_t L, int g0, int gend, int stride) {
    int tid_ = threadIdx.x; asm volatile("" : "+v"(tid_)); const int tid = tid_;
    int g = g0; asm volatile("" : "+s"(g));
    f32x4 a = (f32x4){0.f, 0.f, 0.f, 0.f}, b = a; float gn = 1.f; TileDesc cur; cur.dst = nullptr;
    __syncthreads();
    if (g < gend) { cur = tile_desc(p, g, tid); a = *(const f32x4*)cur.src; b = *(const f32x4*)(cur.src + 4); gn = cur.base * (cur.gain ? *cur.gain : 1.0f); }
    for (; g < gend; g += stride) {
        const int gnx = g + stride; TileDesc nxt; nxt.dst = nullptr; f32x4 na = a, nb = b; float ng = 1.f;
        if (gnx < gend) { nxt = tile_desc(p, gnx, tid); na = *(const f32x4*)nxt.src; nb = *(const f32x4*)(nxt.src + 4); ng = nxt.base * (nxt.gain ? *nxt.gain : 1.0f); }
        { const int r = tid >> 3, c8 = (tid & 7) * 8, o = (r * 65 + c8) * 4;
          lds_st<float>(L, o, a[0] * gn); lds_st<float>(L, o + 4, a[1] * gn); lds_st<float>(L, o + 8, a[2] * gn); lds_st<float>(L, o + 12, a[3] * gn);
          lds_st<float>(L, o + 16, b[0] * gn); lds_st<float>(L, o + 20, b[1] * gn); lds_st<float>(L, o + 24, b[2] * gn); lds_st<float>(L, o + 28, b[3] * gn); }
        __syncthreads();
        { const int n = tid >> 3, kc = tid & 7; float v[8];
#pragma unroll
          for (int j = 0; j < 8; ++j) v[j] = lds_ld<float>(L, ((8 * kc + j) * 65 + n) * 4);
          u32x4 w; w.x = cvt_pk_bf16(v[0], v[1]); w.y = cvt_pk_bf16(v[2], v[3]); w.z = cvt_pk_bf16(v[4], v[5]); w.w = cvt_pk_bf16(v[6], v[7]);
          *(u32x4*)cur.dst = w; }
        __syncthreads();
        cur = nxt; a = na; b = nb; gn = ng;
    }
}

__device__ __forceinline__ void phase_prologue(CP& p, lds_t L) {
    int tid_ = threadIdx.x; asm volatile("" : "+v"(tid_)); const int tid = tid_, lane = tid & 63, wid = tid >> 6;
    unsigned char* ws = p.ws;
    { bf16_t* HB = (bf16_t*)(ws + WS_HB); float* ss = (float*)(ws + WS_SS); bf16_t* MB = (bf16_t*)(ws + WS_MEMB); float* ssm = (float*)(ws + WS_SSM);
      for (int row = blockIdx.x * 8 + wid; row < T_ + MEMT; row += gridDim.x * 8) {
          const bool isx = row < T_; const int r = isx ? row : row - T_;
          const float* src = (isx ? p.in[0] : p.in[1]) + (size_t)r * D_; float s2 = 0.f;
#pragma unroll
          for (int i = 0; i < 4; ++i) { const int c = i * 256 + lane * 4; const f32x4 v = *(const f32x4*)(src + c);
              s2 += v[0] * v[0] + v[1] * v[1] + v[2] * v[2] + v[3] * v[3];
              u32x2 w; w.x = cvt_pk_bf16(v[0], v[1]); w.y = cvt_pk_bf16(v[2], v[3]);
              if (isx) { *(u32x2*)(HB + (size_t)r * D_ + c) = w; } else { *(u32x2*)(MB + (size_t)r * D_ + c) = w; } }
          s2 = wave_sum(s2);
          if (lane < 16) { const float v = lane == 0 ? s2 : 0.f; if (isx) ss[(size_t)r * 16 + lane] = v; else ssm[(size_t)r * 16 + lane] = v; } } }
    transpose_range(p, L, blockIdx.x, 5888, gridDim.x);
}

__device__ __forceinline__ void lru_output(lds_t L, bf16_t* U, int b, int n, int q4, int t0, int w) {
    constexpr int UUo = 114176;
    u32x4 g[6];
#pragma unroll
    for (int k = 0; k < 6; ++k) { const int e = w + 128 * k, t = e / 6, c8 = e % 6; g[k] = *(const u32x4*)(U + (size_t)(b * SEQ_ + t0 + t) * INW + MIXW + n * 192 + 48 * q4 + 8 * c8); }
#pragma unroll
    for (int k = 0; k < 6; ++k) { const int e = w + 128 * k, t = e / 6, c8 = e % 6;
        const f32x4 h0 = lds_ld<f32x4>(L, UUo + (t * 48 + 8 * c8) * 4), h1 = lds_ld<f32x4>(L, UUo + (t * 48 + 8 * c8 + 4) * 4);
        u32x4 wv; wv.x = cvt_pk_bf16(h0[0] * gelu_tanh_(bflo(g[k].x)), h0[1] * gelu_tanh_(bfhi(g[k].x))); wv.y = cvt_pk_bf16(h0[2] * gelu_tanh_(bflo(g[k].y)), h0[3] * gelu_tanh_(bfhi(g[k].y)));
        wv.z = cvt_pk_bf16(h1[0] * gelu_tanh_(bflo(g[k].z)), h1[1] * gelu_tanh_(bfhi(g[k].z))); wv.w = cvt_pk_bf16(h1[2] * gelu_tanh_(bflo(g[k].w)), h1[3] * gelu_tanh_(bfhi(g[k].w)));
        st16_sc1(U + (size_t)(b * SEQ_ + t0 + t) * INW + MIXW + n * 192 + 48 * q4 + 8 * c8, wv); }
}

__device__ __forceinline__ void lru_item(CP& p, int jl, int item, lds_t L) {
    constexpr int WLo = 0, XCo = 38400, AAo = 89600, UUo = 114176, SEGo = 138752, CARo = 141824;
    int tid_ = threadIdx.x; asm volatile("" : "+v"(tid_)); const int tid = tid_, lane = tid & 63, wid = tid >> 6, fr = lane & 15, fq = lane >> 4;
    const int pair_ = (item & 7) * 8 + (item >> 5), b = pair_ >> 3, n = pair_ & 7, q4 = (item >> 3) & 3;
    bf16_t* U = (bf16_t*)(p.ws + WS_U);
    const float* w_r = p.in[17] + ((size_t)(jl * 8 + n) * 192) * 192; const float* w_i = p.in[19] + ((size_t)(jl * 8 + n) * 192) * 192;
    __syncthreads();
#pragma unroll 1
    for (int r3 = 0; r3 < 3; ++r3) {
        float v[12];
#pragma unroll
        for (int k = 0; k < 12; ++k) { const int idx = tid + NTHR * (12 * r3 + k), i = idx / 96, oo = idx % 96; v[k] = (oo < 48 ? w_r : w_i)[(size_t)i * 192 + 48 * q4 + (oo % 48)]; }
#pragma unroll
        for (int k = 0; k < 12; ++k) { const int idx = tid + NTHR * (12 * r3 + k), i = idx / 96, oo = idx % 96; lds_st<bf16_t>(L, WLo + oo * 400 + i * 2, (bf16_t)(cvt_pk_bf16(v[k], 0.f) & 0xffffu)); }
    }
    if (tid < 96) lds_st<float>(L, CARo + tid * 4, 0.f);
    float br[3], bi[3], sp[3];
#pragma unroll
    for (int t3 = 0; t3 < 3; ++t3) { const int c = jl * MIXW + n * 192 + 48 * q4 + 16 * t3 + fr; br[t3] = p.in[18][c]; bi[t3] = p.in[20][c]; sp[t3] = softplusf_(-p.in[21][c]); }
    const int cg = tid % 24, trow = tid / 24; float cw[4][8], cb[8];
    { const int c0 = jl * MIXW + n * 192 + 8 * cg;
#pragma unroll
      for (int j = 0; j < 4; ++j)
#pragma unroll
          for (int e = 0; e < 8; ++e) cw[j][e] = p.in[15][(size_t)jl * 4 * MIXW + (size_t)j * MIXW + n * 192 + 8 * cg + e];
#pragma unroll
      for (int e = 0; e < 8; ++e) cb[e] = p.in[16][c0 + e]; }
    for (int ck = 0; ck < 16; ++ck) {
        const int t0 = ck * 128;
        if (tid >= 384 && ck > 0) lru_output(L, U, b, n, q4, t0 - 128, tid - 384);
        if (tid < 384) {
            u32x4 raw[11];
#pragma unroll
            for (int j = 0; j < 11; ++j) { const int tt = t0 + trow * 8 - 3 + j;
                raw[j] = tt >= 0 ? *(const u32x4*)(U + (size_t)(b * SEQ_ + tt) * INW + n * 192 + 8 * cg) : (u32x4){0u, 0u, 0u, 0u}; }
#pragma unroll
            for (int it = 0; it < 8; ++it) { const int t = trow * 8 + it; float acc[8];
#pragma unroll
                for (int e = 0; e < 8; ++e) acc[e] = cb[e];
#pragma unroll
                for (int j = 0; j < 4; ++j) { const u32x4 rw = raw[it + j];
                    acc[0] += cw[j][0] * bflo(rw.x); acc[1] += cw[j][1] * bfhi(rw.x); acc[2] += cw[j][2] * bflo(rw.y); acc[3] += cw[j][3] * bfhi(rw.y);
                    acc[4] += cw[j][4] * bflo(rw.z); acc[5] += cw[j][5] * bfhi(rw.z); acc[6] += cw[j][6] * bflo(rw.w); acc[7] += cw[j][7] * bfhi(rw.w); }
                u32x4 w; w.x = cvt_pk_bf16(acc[0], acc[1]); w.y = cvt_pk_bf16(acc[2], acc[3]); w.z = cvt_pk_bf16(acc[4], acc[5]); w.w = cvt_pk_bf16(acc[6], acc[7]);
                lds_st<u32x4>(L, XCo + t * 400 + cg * 16, w); }
        }
        __syncthreads();
        {
            f32x4 acc[6];
#pragma unroll
            for (int i = 0; i < 6; ++i) acc[i] = (f32x4){0.f, 0.f, 0.f, 0.f};
#pragma unroll
            for (int ks = 0; ks < 6; ++ks) { const bf16x8 a = lds_ld<bf16x8>(L, XCo + (16 * wid + fr) * 400 + (32 * ks + 8 * fq) * 2);
#pragma unroll
                for (int nt = 0; nt < 6; ++nt) { const bf16x8 bb = lds_ld<bf16x8>(L, WLo + (16 * nt + fr) * 400 + (32 * ks + 8 * fq) * 2); acc[nt] = MFMA16(a, bb, acc[nt]); } }
#pragma unroll
            for (int t3 = 0; t3 < 3; ++t3) { const int oc = 16 * t3 + fr;
#pragma unroll
                for (int rg = 0; rg < 4; ++rg) { const int t = 16 * wid + 4 * fq + rg;
                    const float r = sigmoidf_(acc[t3][rg] + br[t3]), gi = sigmoidf_(acc[t3 + 3][rg] + bi[t3]);
                    const float la = -8.0f * r * sp[t3], a = __expf(la), mult = __builtin_amdgcn_sqrtf(fmaxf(1.0f - a * a, 0.f));
                    const float xc = bf2f(lds_ld<bf16_t>(L, XCo + t * 400 + (48 * q4 + oc) * 2));
                    lds_st<float>(L, AAo + (t * 48 + oc) * 4, a); lds_st<float>(L, UUo + (t * 48 + oc) * 4, mult * gi * xc); } }
        }
        __syncthreads();
        const int ch = tid % 48, sg = tid / 48;
        if (tid < 384) { float A = 1.f, Hh = 0.f;
#pragma unroll
            for (int i = 0; i < 16; ++i) { const int t = 16 * sg + i; const float a = lds_ld<float>(L, AAo + (t * 48 + ch) * 4), uu = lds_ld<float>(L, UUo + (t * 48 + ch) * 4); Hh = a * Hh + uu; A *= a; }
            lds_st<float>(L, SEGo + (sg * 48 + ch) * 4, A); lds_st<float>(L, SEGo + 1536 + (sg * 48 + ch) * 4, Hh); }
        __syncthreads();
        if (tid < 384) { float h = lds_ld<float>(L, CARo + ((ck & 1) * 48 + ch) * 4);
            for (int s2 = 0; s2 < sg; ++s2) h = lds_ld<float>(L, SEGo + (s2 * 48 + ch) * 4) * h + lds_ld<float>(L, SEGo + 1536 + (s2 * 48 + ch) * 4);
#pragma unroll
            for (int i = 0; i < 16; ++i) { const int t = 16 * sg + i; const float a = lds_ld<float>(L, AAo + (t * 48 + ch) * 4), uu = lds_ld<float>(L, UUo + (t * 48 + ch) * 4); h = a * h + uu; lds_st<float>(L, UUo + (t * 48 + ch) * 4, h); }
            if (sg == 7) lds_st<float>(L, CARo + (((ck + 1) & 1) * 48 + ch) * 4, h); }
        __syncthreads();
    }
    if (tid >= 384) lru_output(L, U, b, n, q4, 15 * 128, tid - 384);
}

__device__ __forceinline__ void xattn_item(CP& p, int item, lds_t L) {
    constexpr int KMo = 0, VMo = 69632;
    int tid_ = threadIdx.x; asm volatile("" : "+v"(tid_)); const int tid = tid_, lane = tid & 63, wid = tid >> 6, fr = lane & 15, fq = lane >> 4;
    const int slotx_ = item >> 3, pairx_ = (item & 7) * 4 + (slotx_ >> 4), b = pairx_ >> 2, hx = pairx_ & 3, qt = slotx_ & 15;
    bf16_t* U = (bf16_t*)(p.ws + WS_U); const bf16_t* KV = (const bf16_t*)(p.ws + WS_KVM);
    __syncthreads();
    for (int e = tid; e < 4096; e += NTHR) { const int key = e >> 4, ch = e & 15; const bf16_t* src = KV + (size_t)(b * 256 + key) * 1024 + hx * 128 + ch * 8;
        lds_st<u32x4>(L, KMo + key * 272 + ch * 16, *(const u32x4*)src); lds_st<u32x4>(L, VMo + key * 288 + ch * 16, *(const u32x4*)(src + 512)); }
    bf16_t* qrow = U + (size_t)(b * SEQ_ + qt * 128 + 16 * wid + fr) * INW + 2 * MIXW + hx * 128;
    bf16x8 Bq[4];
#pragma unroll
    for (int ks = 0; ks < 4; ++ks) Bq[ks] = *(const bf16x8*)(qrow + 32 * ks + 8 * fq);
    __syncthreads();
    f32x4 S[16];
#pragma unroll
    for (int kt = 0; kt < 16; ++kt) { f32x4 a = (f32x4){0.f, 0.f, 0.f, 0.f};
#pragma unroll
        for (int ks = 0; ks < 4; ++ks) a = MFMA16(lds_ld<bf16x8>(L, KMo + (16 * kt + fr) * 272 + (32 * ks + 8 * fq) * 2), Bq[ks], a);
        S[kt] = a; }
    float mx = -3.0e38f;
#pragma unroll
    for (int kt = 0; kt < 16; ++kt)
#pragma unroll
        for (int j = 0; j < 4; ++j) mx = fmaxf(mx, S[kt][j]);
    mx = fmaxf(mx, __shfl_xor(mx, 16)); mx = fmaxf(mx, __shfl_xor(mx, 32));
    const float sc = 0.08838834764831845f; float lsum = 0.f;
#pragma unroll
    for (int kt = 0; kt < 16; ++kt)
#pragma unroll
        for (int j = 0; j < 4; ++j) { const float e = __expf((S[kt][j] - mx) * sc); S[kt][j] = e; lsum += e; }
    lsum += __shfl_xor(lsum, 16); lsum += __shfl_xor(lsum, 32);
    f32x4 O[8];
#pragma unroll
    for (int dt = 0; dt < 8; ++dt) O[dt] = (f32x4){0.f, 0.f, 0.f, 0.f};
#pragma unroll
    for (int i = 0; i < 8; ++i) { const bf16x8 bp = pack8(S[2 * i], S[2 * i + 1]);
#pragma unroll
        for (int dt = 0; dt < 8; ++dt) { const int o0 = VMo + (32 * i + 4 * fq + (fr >> 2)) * 288 + (16 * dt + 4 * (fr & 3)) * 2;
#ifdef DBG_NOTR
            u32x4 af;
            { unsigned e[8];
#pragma unroll
              for (int j = 0; j < 8; ++j) { const int key = 32 * i + (j < 4 ? 4 * fq + j : 16 + 4 * fq + (j - 4)); e[j] = lds_ld<bf16_t>(L, VMo + key * 288 + (16 * dt + fr) * 2); }
              af.x = e[0] | (e[1] << 16); af.y = e[2] | (e[3] << 16); af.z = e[4] | (e[5] << 16); af.w = e[6] | (e[7] << 16); }
            (void)o0; O[dt] = MFMA16(__builtin_bit_cast(bf16x8, af), bp, O[dt]); } }
#else
            O[dt] = MFMA16(tr_pair(L, o0, o0 + 16 * 288), bp, O[dt]); } }
#endif
    float inv = frcp_(lsum);
#ifdef DBG_IDENT
    { const u32x4 q0 = __builtin_bit_cast(u32x4, Bq[0]);
#pragma unroll
      for (int dt = 0; dt < 8; ++dt) { O[dt][0] = bflo(q0.x) + dt; O[dt][1] = bfhi(q0.x); O[dt][2] = bflo(q0.y); O[dt][3] = bfhi(q0.y); } inv = 1.0f; }
#endif
#pragma unroll
    for (int dt = 0; dt < 8; ++dt) { u32x2 w; w.x = cvt_pk_bf16(O[dt][0] * inv, O[dt][1] * inv); w.y = cvt_pk_bf16(O[dt][2] * inv, O[dt][3] * inv);
        *(u32x2*)(qrow + 16 * dt + 4 * fq) = w; }
}

__device__ __forceinline__ void ml1_item(CP& p, int jl, int item, lds_t L) {
    int tid_ = threadIdx.x; asm volatile("" : "+v"(tid_)); const int tid = tid_, lane = tid & 63, wid = tid >> 6;
    const bf16_t* U = (const bf16_t*)(p.ws + WS_U); bf16_t* QB = (bf16_t*)(p.ws + WS_XC); bf16_t* KB = (bf16_t*)p.out; float* G = (float*)(p.ws + WS_G);
    const int j = tid < 384 ? tid : 0;
    float cw[4][4], cb[4], Wx[4][8], Wm[4][8];
    f32x4 wq4[4], wk4[4];
    { const float* wqp = p.in[24] + ((size_t)jl * 384 + j) * 16; const float* wkp = p.in[25] + ((size_t)jl * 384 + j) * 16;
#pragma unroll
      for (int i = 0; i < 4; ++i) { wq4[i] = *(const f32x4*)(wqp + 4 * i); wk4[i] = *(const f32x4*)(wkp + 4 * i); } }
    {
#pragma unroll
        for (int k = 0; k < 4; ++k)
#pragma unroll
            for (int c = 0; c < 4; ++c) cw[k][c] = p.in[22][(size_t)jl * 4 * MIXW + (size_t)k * MIXW + 4 * j + c];
#pragma unroll
        for (int c = 0; c < 4; ++c) cb[c] = p.in[23][jl * MIXW + 4 * j + c];
        const float* wq = p.in[24] + ((size_t)jl * 384 + j) * 16; const float* wk = p.in[25] + ((size_t)jl * 384 + j) * 16; const float* wv = p.in[26] + ((size_t)jl * 384 + j) * 16;
        const float* Wg = p.in[27] + (size_t)jl * 4608 * 8;
#pragma unroll
        for (int i = 0; i < 4; ++i)
#pragma unroll
            for (int g = 0; g < 8; ++g) { Wx[i][g] = 0.f; Wm[i][g] = 0.f; }
#pragma unroll 1
        for (int o = 0; o < 4; ++o) {
            float gq[8], gk[8], gv[8];
#pragma unroll
            for (int g = 0; g < 8; ++g) { gq[g] = Wg[(size_t)(4 * j + o) * 8 + g]; gk[g] = Wg[(size_t)(MIXW + 4 * j + o) * 8 + g]; gv[g] = Wg[(size_t)(2 * MIXW + 4 * j + o) * 8 + g]; }
#pragma unroll
            for (int i = 0; i < 4; ++i) { const float a = wq[i * 4 + o], bk = wk[i * 4 + o], cv = wv[i * 4 + o];
#pragma unroll
                for (int g = 0; g < 8; ++g) { Wx[i][g] += a * gq[g] + bk * gk[g]; Wm[i][g] += cv * gv[g]; } } }
    }
    const int r0 = item * 64, tm0 = r0 % SEQ_;
    float x3[4], x2[4], x1[4], x0[4];
    auto ldx = [&](int row, float* x) { const u32x2 raw = *(const u32x2*)(U + (size_t)row * INW + 4 * j); x[0] = bflo(raw.x); x[1] = bfhi(raw.x); x[2] = bflo(raw.y); x[3] = bfhi(raw.y); };
#pragma unroll
    for (int c = 0; c < 4; ++c) { x3[c] = 0.f; x2[c] = 0.f; x1[c] = 0.f; }
    if (tm0 > 0) { ldx(r0 - 3, x3); ldx(r0 - 2, x2); ldx(r0 - 1, x1); }
    for (int tb = 0; tb < 8; ++tb) {
        __syncthreads();
        if (tid < 384) {
            u32x2 xraw[8];
#pragma unroll
            for (int tt = 0; tt < 8; ++tt) xraw[tt] = *(const u32x2*)(U + (size_t)(r0 + tb * 8 + tt) * INW + 4 * j);
#pragma unroll
            for (int tt = 0; tt < 8; ++tt) { const int row = r0 + tb * 8 + tt; x0[0] = bflo(xraw[tt].x); x0[1] = bfhi(xraw[tt].x); x0[2] = bflo(xraw[tt].y); x0[3] = bfhi(xraw[tt].y); float xc[4];
#pragma unroll
                for (int c = 0; c < 4; ++c) xc[c] = siluf_(cb[c] + cw[0][c] * x3[c] + cw[1][c] * x2[c] + cw[2][c] * x1[c] + cw[3][c] * x0[c]);
                { const f32x4 q = wq4[0] * xc[0] + wq4[1] * xc[1] + wq4[2] * xc[2] + wq4[3] * xc[3];
                  const f32x4 k = (wk4[0] * xc[0] + wk4[1] * xc[1] + wk4[2] * xc[2] + wk4[3] * xc[3]) * 0.05103103630798288f;
                  u32x2 w; w.x = cvt_pk_bf16(q[0], q[1]); w.y = cvt_pk_bf16(q[2], q[3]); *(u32x2*)(QB + (size_t)row * MIXW + 4 * j) = w;
                  w.x = cvt_pk_bf16(k[0], k[1]); w.y = cvt_pk_bf16(k[2], k[3]); *(u32x2*)(KB + (size_t)row * MIXW + 4 * j) = w; }
#pragma unroll
                for (int g = 0; g < 8; ++g) { float s = 0.f;
#pragma unroll
                    for (int i = 0; i < 4; ++i) s += xc[i] * Wx[i][g] + x0[i] * Wm[i][g];
                    lds_st<float>(L, ((tt * 8 + g) * 388 + tid) * 4, s); }
#pragma unroll
                for (int c = 0; c < 4; ++c) { x3[c] = x2[c]; x2[c] = x1[c]; x1[c] = x0[c]; } }
        }
        __syncthreads();
        {
            const int row = tid >> 3, part = tid & 7; float s = 0.f;
#pragma unroll
            for (int i = 0; i < 12; ++i) { const f32x4 v = lds_ld<f32x4>(L, (row * 388 + part * 48 + 4 * i) * 4); s += (v[0] + v[1]) + (v[2] + v[3]); }
            s += __shfl_xor(s, 1); s += __shfl_xor(s, 2); s += __shfl_xor(s, 4);
            if (part == 0) { const int g = row & 7; const float v = s + p.in[28][jl * 8 + g]; G[(size_t)(r0 + tb * 8 + (row >> 3)) * 8 + g] = g < 4 ? v : -softplusf_(-v); }
        }
    }
}

__device__ __forceinline__ void ml2_item(CP& p, int jl, int item, lds_t L) {
    constexpr int QIo = 0, KIo = 50176, VIo = 100352, PTo = 109568, WQKo = 118784, WVo = 131072, SCo = 132096, NSo = 134144, OXo = 0;
    constexpr int IBo = SCo, MTo = SCo + 256, WIo = SCo + 512, EMo = SCo + 768, WSo = SCo + 1024, DNo = SCo + 1280, NQo = SCo + 1536, MIo = SCo + 1792;
    int tid_ = threadIdx.x; asm volatile("" : "+v"(tid_)); const int tid = tid_, lane = tid & 63, wid = tid >> 6, fr = lane & 15, fq = lane >> 4;
    const int slot_ = item >> 3, pair_ = (item & 7) * 4 + slot_ / 6, b = pair_ >> 2, hh = pair_ & 3, vb = slot_ % 6;
    const int vt = wid & 3, kh = wid >> 2;
    const bf16_t* U = (const bf16_t*)(p.ws + WS_U); const bf16_t* QB = (const bf16_t*)(p.ws + WS_XC); const bf16_t* KB = (const bf16_t*)p.out; const float* G = (const float*)(p.ws + WS_G); bf16_t* HO = (bf16_t*)(p.ws + WS_HOUT);
    __syncthreads();
    if (tid < 256) lds_st<float>(L, WVo + tid * 4, p.in[26][((size_t)jl * 384 + hh * 96 + vb * 16 + (tid >> 4)) * 16 + (tid & 15)]);
    if (tid < 384) lds_st<float>(L, NSo + tid * 4, 0.f);
    f32x4 CT[12];
#pragma unroll
    for (int i = 0; i < 12; ++i) CT[i] = (f32x4){0.f, 0.f, 0.f, 0.f};
    float m_cur = 0.f;
    const int cg = tid % 48, rg = (tid / 48) & 7;
    u32x4 pre[8]; float pli = 0.f, plf = 0.f;
    if (tid < 384) {
#pragma unroll
        for (int it = 0; it < 4; ++it) { pre[it] = *(const u32x4*)(QB + (size_t)(b * SEQ_ + rg * 8 + it) * MIXW + hh * 384 + 8 * cg); pre[4 + it] = *(const u32x4*)(KB + (size_t)(b * SEQ_ + rg * 8 + it) * MIXW + hh * 384 + 8 * cg); }
    } else {
#pragma unroll
        for (int it = 0; it < 4; ++it) { const int e = (tid - 384) + 128 * it; pre[it] = *(const u32x4*)(U + (size_t)(b * SEQ_ + (e >> 3)) * INW + hh * 384 + vb * 64 + 8 * (e & 7)); }
    }
    if (wid == 0) { pli = G[(size_t)(b * SEQ_ + lane) * 8 + hh]; plf = G[(size_t)(b * SEQ_ + lane) * 8 + 4 + hh]; }
    for (int c = 0; c < 32; ++c) {
        const int r0 = b * SEQ_ + 64 * c;
        __syncthreads();
        if (wid == 0) {
            const float li = pli, lf = plf;
            float bc = lf;
#pragma unroll
            for (int d = 1; d < 64; d <<= 1) { const float v = __shfl_up(bc, d); if (lane >= d) bc += v; }
            const float ib = li - bc; float pm = ib;
#pragma unroll
            for (int d = 1; d < 64; d <<= 1) { const float v = __shfl_up(pm, d); if (lane >= d) pm = fmaxf(pm, v); }
            const float Mt = fmaxf(m_cur, pm), M63 = __shfl(Mt, 63), bl = __shfl(bc, 63);
            lds_st<float>(L, IBo + lane * 4, ib); lds_st<float>(L, MTo + lane * 4, Mt); lds_st<float>(L, WIo + lane * 4, __expf(m_cur - Mt)); lds_st<float>(L, EMo + lane * 4, __expf(-(bc + Mt)));
            lds_st<float>(L, WSo + lane * 4, __expf(ib - M63)); lds_st<float>(L, DNo + lane * 4, 0.f);
            if (lane == 0) { lds_st<float>(L, MIo, __expf(m_cur - M63)); lds_st<float>(L, MIo + 4, bl + M63); }
        }
        if (tid < 384) {
            u32x4 lq[4], lk[4];
#pragma unroll
            for (int it = 0; it < 4; ++it) { lq[it] = *(const u32x4*)(QB + (size_t)(r0 + rg * 8 + 4 + it) * MIXW + hh * 384 + 8 * cg); lk[it] = *(const u32x4*)(KB + (size_t)(r0 + rg * 8 + 4 + it) * MIXW + hh * 384 + 8 * cg); }
#pragma unroll
            for (int it = 0; it < 8; ++it) { const int t = rg * 8 + it;
                lds_st<u32x4>(L, QIo + t * 784 + cg * 16, it < 4 ? pre[it] : lq[it - 4]); lds_st<u32x4>(L, KIo + t * 784 + cg * 16, it < 4 ? pre[4 + it] : lk[it - 4]); }
        } else {
#pragma unroll
            for (int it = 0; it < 4; ++it) { const int e = (tid - 384) + 128 * it, t = e >> 3, cp = e & 7; const u32x4 raw = pre[it];
                const float x[8] = {bflo(raw.x), bfhi(raw.x), bflo(raw.y), bfhi(raw.y), bflo(raw.z), bfhi(raw.z), bflo(raw.w), bfhi(raw.w)};
                f32x4 av0 = lds_ld<f32x4>(L, WVo + (2 * cp) * 64) * x[0], av1 = lds_ld<f32x4>(L, WVo + (2 * cp + 1) * 64) * x[4];
#pragma unroll
                for (int i = 1; i < 4; ++i) { av0 = av0 + lds_ld<f32x4>(L, WVo + (2 * cp) * 64 + i * 16) * x[i]; av1 = av1 + lds_ld<f32x4>(L, WVo + (2 * cp + 1) * 64 + i * 16) * x[4 + i]; }
                lds_st<bf16x8>(L, VIo + t * 144 + cp * 16, pack8(av0, av1)); }
        }
        __syncthreads();
        const float decay = lds_ld<float>(L, MIo), m_new = lds_ld<float>(L, MIo + 4);
        {
            const int tt = wid & 3, hf = wid >> 2;
            f32x4 s0 = (f32x4){0.f, 0.f, 0.f, 0.f}, s1 = s0;
            const bool do0 = (2 * hf) <= tt, do1 = (2 * hf + 1) <= tt;
            if (do0) {
#pragma unroll
                for (int ks = 0; ks < 12; ++ks) { const bf16x8 bq = lds_ld<bf16x8>(L, QIo + (16 * tt + fr) * 784 + (32 * ks + 8 * fq) * 2);
                    s0 = MFMA16(lds_ld<bf16x8>(L, KIo + (32 * hf + fr) * 784 + (32 * ks + 8 * fq) * 2), bq, s0);
                    if (do1) s1 = MFMA16(lds_ld<bf16x8>(L, KIo + (32 * hf + 16 + fr) * 784 + (32 * ks + 8 * fq) * 2), bq, s1);
                    if ((ks & 3) == 3) __builtin_amdgcn_sched_barrier(0); } }
            const int t = 16 * tt + fr; const float Mt = lds_ld<float>(L, MTo + t * 4); float psum = 0.f;
#pragma unroll
            for (int sti = 0; sti < 2; ++sti) { const int sb = 32 * hf + 16 * sti + 4 * fq; const f32x4 ibv = lds_ld<f32x4>(L, IBo + sb * 4); f32x4 sv = sti ? s1 : s0; float pv[4];
#pragma unroll
                for (int rg = 0; rg < 4; ++rg) { const int s = sb + rg; pv[rg] = (s <= t) ? sv[rg] * __expf(ibv[rg] - Mt) : 0.f; psum += pv[rg]; }
                u32x2 w; w.x = cvt_pk_bf16(pv[0], pv[1]); w.y = cvt_pk_bf16(pv[2], pv[3]); lds_st<u32x2>(L, PTo + t * 144 + sb * 2, w); }
            psum += __shfl_xor(psum, 16); psum += __shfl_xor(psum, 32);
            if (fq == 0) __hip_atomic_fetch_add((LAS float*)(L + DNo + t * 4), psum, __ATOMIC_RELAXED, __HIP_MEMORY_SCOPE_WORKGROUP);
        }
        f32x4 ao[4];
#pragma unroll
        for (int i = 0; i < 4; ++i) ao[i] = (f32x4){0.f, 0.f, 0.f, 0.f};
#pragma unroll
        for (int i = 0; i < 6; ++i) { const bf16x8 af = pack8(CT[2 * i], CT[2 * i + 1]);
#pragma unroll
            for (int t2 = 0; t2 < 4; ++t2) { const int qo = QIo + (16 * t2 + fr) * 784 + (192 * kh + 32 * i + 4 * fq) * 2;
                const s16x4 lo = lds_ld<s16x4>(L, qo), hi = lds_ld<s16x4>(L, qo + 32);
                ao[t2] = MFMA16(af, __builtin_shufflevector(lo, hi, 0, 1, 2, 3, 4, 5, 6, 7), ao[t2]); }
            __builtin_amdgcn_sched_barrier(0); }
#pragma unroll
        for (int t2 = 0; t2 < 4; ++t2) { const float wi = lds_ld<float>(L, WIo + (16 * t2 + fr) * 4); ao[t2] = ao[t2] * wi; }
        {
            const int t = tid >> 3, part = tid & 7; float s = 0.f;
#pragma unroll
            for (int i = 0; i < 6; ++i) { const u32x4 raw = lds_ld<u32x4>(L, QIo + t * 784 + part * 96 + i * 16);
                const f32x4 n0 = lds_ld<f32x4>(L, NSo + (part * 48 + i * 8) * 4), n1 = lds_ld<f32x4>(L, NSo + (part * 48 + i * 8 + 4) * 4);
                s += bflo(raw.x) * n0[0] + bfhi(raw.x) * n0[1] + bflo(raw.y) * n0[2] + bfhi(raw.y) * n0[3] + bflo(raw.z) * n1[0] + bfhi(raw.z) * n1[1] + bflo(raw.w) * n1[2] + bfhi(raw.w) * n1[3]; }
            s += __shfl_xor(s, 1); s += __shfl_xor(s, 2); s += __shfl_xor(s, 4);
            if (part == 0) lds_st<float>(L, NQo + t * 4, s);
        }
        __syncthreads();
        if (c + 1 < 32) {
            if (tid < 384) {
#pragma unroll
                for (int it = 0; it < 4; ++it) { pre[it] = *(const u32x4*)(QB + (size_t)(r0 + 64 + rg * 8 + it) * MIXW + hh * 384 + 8 * cg); pre[4 + it] = *(const u32x4*)(KB + (size_t)(r0 + 64 + rg * 8 + it) * MIXW + hh * 384 + 8 * cg); }
            } else {
#pragma unroll
                for (int it = 0; it < 4; ++it) { const int e = (tid - 384) + 128 * it; pre[it] = *(const u32x4*)(U + (size_t)(r0 + 64 + (e >> 3)) * INW + hh * 384 + vb * 64 + 8 * (e & 7)); }
            }
            if (wid == 0) { pli = G[(size_t)(r0 + 64 + lane) * 8 + hh]; plf = G[(size_t)(r0 + 64 + lane) * 8 + 4 + hh]; }
        }
        {
            const int o0 = VIo + (32 * kh + 8 * fq + (fr >> 2)) * 144 + (16 * vt + 4 * (fr & 3)) * 2;
            const bf16x8 av = tr_pair(L, o0, o0 + 4 * 144);
#pragma unroll
            for (int t2 = 0; t2 < 4; ++t2) ao[t2] = MFMA16(av, lds_ld<bf16x8>(L, PTo + (16 * t2 + fr) * 144 + (32 * kh + 8 * fq) * 2), ao[t2]);
        }
        if (kh == 1) {
#pragma unroll
            for (int t2 = 0; t2 < 4; ++t2)
#pragma unroll
                for (int rg = 0; rg < 4; ++rg) lds_st<float>(L, OXo + ((vt * 16 + 4 * fq + rg) * 64 + 16 * t2 + fr) * 4, ao[t2][rg]);
        }
        {
            bf16x8 bv[2];
#pragma unroll
            for (int ks = 0; ks < 2; ++ks) { const int o0 = VIo + (32 * ks + 8 * fq + (fr >> 2)) * 144 + (16 * vt + 4 * (fr & 3)) * 2;
                const bf16x8 raw = tr_pair(L, o0, o0 + 4 * 144); const u32x4 rw = __builtin_bit_cast(u32x4, raw);
                const f32x4 w0 = lds_ld<f32x4>(L, WSo + (32 * ks + 8 * fq) * 4), w1 = lds_ld<f32x4>(L, WSo + (32 * ks + 8 * fq + 4) * 4);
                u32x4 o; o.x = cvt_pk_bf16(bflo(rw.x) * w0[0], bfhi(rw.x) * w0[1]); o.y = cvt_pk_bf16(bflo(rw.y) * w0[2], bfhi(rw.y) * w0[3]);
                o.z = cvt_pk_bf16(bflo(rw.z) * w1[0], bfhi(rw.z) * w1[1]); o.w = cvt_pk_bf16(bflo(rw.w) * w1[2], bfhi(rw.w) * w1[3]);
                bv[ks] = __builtin_bit_cast(bf16x8, o); }
#pragma unroll
            for (int kt = 0; kt < 12; ++kt) { f32x4 a = CT[kt] * decay;
#pragma unroll
                for (int ks = 0; ks < 2; ++ks) { const int o0 = KIo + (32 * ks + 8 * fq + (fr >> 2)) * 784 + (192 * kh + 16 * kt + 4 * (fr & 3)) * 2;
                    a = MFMA16(tr_pair(L, o0, o0 + 4 * 784), bv[ks], a); }
                CT[kt] = a; if ((kt & 1) == 1) __builtin_amdgcn_sched_barrier(0); }
        }
        if (tid < 192) { float n0 = decay * lds_ld<float>(L, NSo + tid * 8), n1 = decay * lds_ld<float>(L, NSo + tid * 8 + 4);
#pragma unroll 4
            for (int s4 = 0; s4 < 16; ++s4) { const f32x4 w4 = lds_ld<f32x4>(L, WSo + s4 * 16);
#pragma unroll
                for (int j = 0; j < 4; ++j) { const unsigned kk = lds_ld<unsigned>(L, KIo + (4 * s4 + j) * 784 + tid * 4); n0 += w4[j] * bflo(kk); n1 += w4[j] * bfhi(kk); } }
            lds_st<float>(L, NSo + tid * 8, n0); lds_st<float>(L, NSo + tid * 8 + 4, n1); }
        __syncthreads();
        if (kh == 0) {
#pragma unroll
            for (int t2 = 0; t2 < 4; ++t2) { const int t = 16 * t2 + fr;
                const float dn = fmaxf(fabsf(lds_ld<float>(L, DNo + t * 4) + lds_ld<float>(L, WIo + t * 4) * lds_ld<float>(L, NQo + t * 4)), lds_ld<float>(L, EMo + t * 4));
                const float inv = frcp_(dn); float hv[4];
#pragma unroll
                for (int rg = 0; rg < 4; ++rg) hv[rg] = (ao[t2][rg] + lds_ld<float>(L, OXo + ((vt * 16 + 4 * fq + rg) * 64 + t) * 4)) * inv;
                u32x2 w; w.x = cvt_pk_bf16(hv[0], hv[1]); w.y = cvt_pk_bf16(hv[2], hv[3]);
                *(u32x2*)(HO + (size_t)(r0 + t) * MIXW + hh * 384 + vb * 64 + 16 * vt + 4 * fq) = w; }
        }
        m_cur = m_new;
    }
}

__device__ __forceinline__ void phase_ml3(CP& p, int jl) {
    int tid_ = threadIdx.x; asm volatile("" : "+v"(tid_)); const int tid = tid_, lane = tid & 63, wid = tid >> 6;
    bf16_t* U = (bf16_t*)(p.ws + WS_U); const bf16_t* HO = (const bf16_t*)(p.ws + WS_HOUT);
    const int gw = blockIdx.x * 8 + wid, nw = gridDim.x * 8, hh = gw & 3;
    float lg[6], sk[6], cw[4][6], cb[6];
#pragma unroll
    for (int i = 0; i < 3; ++i) { const int c = jl * MIXW + hh * 384 + 128 * i + 2 * lane; lg[2 * i] = p.in[29][c]; lg[2 * i + 1] = p.in[29][c + 1]; sk[2 * i] = p.in[30][c]; sk[2 * i + 1] = p.in[30][c + 1];
        cb[2 * i] = p.in[23][c]; cb[2 * i + 1] = p.in[23][c + 1];
#pragma unroll
        for (int k = 0; k < 4; ++k) { cw[k][2 * i] = p.in[22][(size_t)jl * 4 * MIXW + (size_t)k * MIXW + hh * 384 + 128 * i + 2 * lane]; cw[k][2 * i + 1] = p.in[22][(size_t)jl * 4 * MIXW + (size_t)k * MIXW + hh * 384 + 128 * i + 2 * lane + 1]; } }
    for (int rb = (gw >> 2) * 4; rb < T_; rb += (nw >> 2) * 4) {
        unsigned hr[4][3], gr[4][3], mr[7][3];
        const int tm = rb % SEQ_;
#pragma unroll
        for (int r = 0; r < 4; ++r)
#pragma unroll
            for (int i = 0; i < 3; ++i) { const int c = hh * 384 + 128 * i + 2 * lane; const size_t row = (size_t)(rb + r);
                hr[r][i] = *(const unsigned*)(HO + row * MIXW + c); gr[r][i] = *(const unsigned*)(U + row * INW + MIXW + c); }
#pragma unroll
        for (int q = 0; q < 7; ++q)
#pragma unroll
            for (int i = 0; i < 3; ++i) { const int c = hh * 384 + 128 * i + 2 * lane;
                mr[q][i] = (tm + q - 3 >= 0) ? *(const unsigned*)(U + (size_t)(rb + q - 3) * INW + c) : 0u; }
#pragma unroll
        for (int r = 0; r < 4; ++r) { float h[6]; float s = 0.f;
#pragma unroll
            for (int i = 0; i < 3; ++i) { h[2 * i] = bflo(hr[r][i]); h[2 * i + 1] = bfhi(hr[r][i]); s += h[2 * i] + h[2 * i + 1]; }
            const float mu = wave_sum(s) * (1.0f / 384.0f); float v2 = 0.f;
#pragma unroll
            for (int i = 0; i < 6; ++i) { h[i] -= mu; v2 += h[i] * h[i]; }
            const float rstd = rsqrtf(wave_sum(v2) * (1.0f / 384.0f) + EPS_);
#pragma unroll
            for (int i = 0; i < 3; ++i) { const int c = hh * 384 + 128 * i + 2 * lane;
                float x0 = cb[2 * i], x1 = cb[2 * i + 1];
#pragma unroll
                for (int k = 0; k < 4; ++k) { x0 += cw[k][2 * i] * bflo(mr[r + k][i]); x1 += cw[k][2 * i + 1] * bfhi(mr[r + k][i]); }
                x0 = siluf_(x0); x1 = siluf_(x1);
                const float y0 = (h[2 * i] * rstd * lg[2 * i] + sk[2 * i] * x0) * siluf_(bflo(gr[r][i]));
                const float y1 = (h[2 * i + 1] * rstd * lg[2 * i + 1] + sk[2 * i + 1] * x1) * siluf_(bfhi(gr[r][i]));
                *(unsigned*)(U + (size_t)(rb + r) * INW + MIXW + c) = cvt_pk_bf16(y0, y1); } }
    }
}

__device__ __forceinline__ void phase_final(CP& p) {
    int tid_ = threadIdx.x; asm volatile("" : "+v"(tid_)); const int tid = tid_, lane = tid & 63, wid = tid >> 6; float* out = p.out; const float* g = p.in[31]; const bf16_t* HB = (const bf16_t*)(p.ws + WS_HB);
    for (int row = blockIdx.x * 8 + wid; row < T_; row += gridDim.x * 8) { float v[16]; float s2 = 0.f;
#pragma unroll
        for (int i = 0; i < 2; ++i) { const u32x4 hw = *(const u32x4*)(HB + (size_t)row * D_ + i * 512 + lane * 8);
            v[8 * i + 0] = bflo(hw.x); v[8 * i + 1] = bfhi(hw.x); v[8 * i + 2] = bflo(hw.y); v[8 * i + 3] = bfhi(hw.y); v[8 * i + 4] = bflo(hw.z); v[8 * i + 5] = bfhi(hw.z); v[8 * i + 6] = bflo(hw.w); v[8 * i + 7] = bfhi(hw.w); }
#pragma unroll
        for (int i = 0; i < 16; ++i) s2 += v[i] * v[i];
        const float rs = rsqrtf(wave_sum(s2) * (1.0f / 1024.0f) + EPS_);
#pragma unroll
        for (int i = 0; i < 2; ++i) { const int c = i * 512 + lane * 8; const f32x4 g0 = *(const f32x4*)(g + c), g1 = *(const f32x4*)(g + c + 4);
            *(f32x4*)(out + (size_t)row * D_ + c) = (f32x4){v[8 * i] * rs * g0[0], v[8 * i + 1] * rs * g0[1], v[8 * i + 2] * rs * g0[2], v[8 * i + 3] * rs * g0[3]};
            *(f32x4*)(out + (size_t)row * D_ + c + 4) = (f32x4){v[8 * i + 4] * rs * g1[0], v[8 * i + 5] * rs * g1[1], v[8 * i + 6] * rs * g1[2], v[8 * i + 7] * rs * g1[3]}; } }
}

constexpr int MK_PRO = 1, MK_GEMM = 2, MK_LRU = 4, MK_XA = 8, MK_ML1 = 16, MK_ML2 = 32, MK_ML3 = 64, MK_FIN = 128, MK_ALL = 255;
template <int MASK>
__global__ void __launch_bounds__(NTHR, 2) mega(P p_arg) {
    extern __shared__ __attribute__((aligned(16))) unsigned char shm[];
    lds_t L = (lds_t)shm;
    cg::grid_group grid = cg::this_grid();
    CP* kp0 = (CP*)__builtin_amdgcn_kernarg_segment_ptr();
    const int G = (int)gridDim.x, bid = (int)blockIdx.x;
    const int ph_lo = p_arg.ph_lo, ph_hi = p_arg.ph_hi, coop = p_arg.coop, sub = p_arg.pad;
    __builtin_amdgcn_fence(__ATOMIC_ACQUIRE, "agent");
    if (threadIdx.x < 4) *(volatile LAS unsigned*)(L + LDS_BYTES - 16 + 4 * threadIdx.x) = 0u;
    __syncthreads();
    XcdBarrier xbar = xcd_barrier_post((unsigned*)(p_arg.ws + WS_BAR), (volatile LAS unsigned*)(L + LDS_BYTES - 16));
    for (int ph = ph_lo; ph < ph_hi; ++ph) {
        CP* kp = kp0; asm volatile("" : "+s"(kp)); CP& p = *kp; unsigned char* ws = p.ws;
        int type, l = 0;
        if (ph == 0) type = 0; else if (ph == 33) type = 11;
        else { const int q = ph - 1, pr = q >> 4, r = q & 15;
            if (r < 7) { l = 2 * pr; type = r < 3 ? r + 1 : (r == 3 ? 4 : r + 4); }
            else { l = 2 * pr + 1; const int r2 = r - 7; type = r2 < 3 ? r2 + 1 : r2 + 2; } }
        const unsigned char* wb = ws + WS_WB + (size_t)l * WL_LAYER; const int jl = l >> 1;
        float* SS = (float*)(ws + WS_SS); bf16_t* HB = (bf16_t*)(ws + WS_HB); bf16_t* U = (bf16_t*)(ws + WS_U);
#ifdef PROBE_REP_TYPES
        const int nrep = ((PROBE_REP_TYPES >> type) & 1) ? 2 : 1;
#else
        const int nrep = 1;
#endif
        for (int rep = 0; rep < nrep; ++rep) {
        if (type == 0) { if constexpr ((MASK & MK_PRO) != 0) phase_prologue(p, L); }
        else {
        const bool split = (l == 3) && coop && G == 256;
        const int tbase = (l + 1) * 5888;
        const bool gemm_now = (type == 1 || type == 9 || type == 2 || type == 8 || type == 10 || type == 3) || (type == 6 && split && bid >= 192);
        if (gemm_now) {
            if constexpr ((MASK & MK_GEMM) != 0) {
            const int npass = ((type == 3 && !split) || (type == 1 && split)) ? 2 : 1;
            for (int pass = 0; pass < npass; ++pass) {
                pg8::Gemm g; pg8::EpiAll E; int c = bid, Ge = G, sf = 1 << 30, sl = 0;
                g.M = T_; g.N = 1024; g.K = 1024; g.lda = 1024; g.A = HB; E.O = U; E.ldc = INW; E.H = p.out; E.ssn = SS; E.ss = SS;
                const bool kvpass = (type == 3 && !split && pass == 0) || (type == 1 && split && pass == 1);
                if (kvpass) { E.mode = 1; g.A = (const bf16_t*)(ws + WS_MEMB); g.Bt = (const bf16_t*)(wb + WL_KV); g.M = MEMT; E.O = (bf16_t*)(ws + WS_KVM); E.ldc = 1024; E.ss = (const float*)(ws + WS_SSM);
                    if (type == 1) c = bid >= 128 ? bid - 128 : (1 << 20); }
                else if (type == 1 || type == 9) { g.Bt = (const bf16_t*)(wb + (type == 1 ? WL_GU1 : WL_GU2)); g.N = 5632; E.mode = 0; }
                else if (type == 3) { E.mode = 1; g.Bt = (const bf16_t*)(wb + WL_IN);
                    if (split) { g.N = 2048; sf = 6; sl = 6; }
                    else { g.N = INW; c = (bid + (G / 16) * 8) % G; } }
                else if (type == 6) { E.mode = 1; g.Bt = (const bf16_t*)(wb + WL_IN); g.N = 1536; sf = 0; sl = 6; Ge = 64; c = bid - 192; }
                else { E.mode = 2; E.O = HB; E.ssn = SS;
                    if (type == 8) { g.A = U + MIXW; g.Bt = (const bf16_t*)(wb + WL_OUT); g.K = OUTW; g.lda = INW; }
                    else { g.A = U; g.Bt = (const bf16_t*)(wb + (type == 2 ? WL_D1 : WL_D2)); g.K = FF_; g.lda = FF_; } }
                pg8::StaticOrder S; S.init(g.M, g.N, Ge, c); S.sf = sf; S.sl = sl; pg8::gemm_phase(L, g, S, E);
            }
            if constexpr ((MASK & MK_PRO) != 0) {
                if (l < 3 && G == 256) {
                    if (type == 1 && bid >= 128) transpose_range(p, L, tbase + (bid - 128), tbase + 2200, 128);
                    else if (type == 3 && bid >= 32 && bid < 128) transpose_range(p, L, tbase + 2200 + (bid - 32), tbase + 3688, 96);
                    else if (type == 9 && bid >= 128) transpose_range(p, L, tbase + 3688 + (bid - 128), tbase + 5888, 128);
                } else if (l < 3 && type == 9) transpose_range(p, L, tbase + bid, tbase + 5888, G);
            } }
        }
        if (type == 4) {

            if constexpr ((MASK & MK_LRU) != 0) { if (sub != 2) for (int it = bid; it < 256; it += G) lru_item(p, jl, it, L); }
            if constexpr ((MASK & MK_XA) != 0) { if (sub != 1) { for (int it = bid; it < 512; it += G) xattn_item(p, it, L);
#ifdef DBG_THRASH
                { const u32x4* src = (const u32x4*)(ws + WS_WB) + (size_t)bid * 131072; unsigned acc = 0;
                  for (int i = threadIdx.x; i < 131072; i += NTHR) { const u32x4 v = src[i]; acc ^= v.x ^ v.y ^ v.z ^ v.w; }
                  if (acc == 0x12345u) ((unsigned*)(ws + WS_G))[0] = acc; }
#endif
            } }
        } else if (type == 5) { if constexpr ((MASK & MK_ML1) != 0) for (int it = bid; it < 256; it += G) ml1_item(p, jl, it, L); }
        else if (type == 6) {
            if (sub == 0 && G > 192) {
                if (bid < 192) { if constexpr ((MASK & MK_ML2) != 0) for (int r2_ = 0; r2_ < PROBE_ML2_REP; ++r2_) ml2_item(p, jl, bid, L); }
                else { if constexpr ((MASK & MK_XA) != 0) for (int it = bid - 192; it < 512; it += G - 192) xattn_item(p, it, L);
                }
            } else {
                if constexpr ((MASK & MK_ML2) != 0) { if (sub != 2) for (int it = bid; it < 192; it += G) ml2_item(p, jl, it, L); }
                if constexpr ((MASK & MK_XA) != 0) { if (sub != 1) for (int it = bid; it < 512; it += G) xattn_item(p, it, L); }
            }
        } else if (type == 7) { if constexpr ((MASK & MK_ML3) != 0) phase_ml3(p, jl); }
        else if (type == 11) { if constexpr ((MASK & MK_FIN) != 0) phase_final(p); }
        }
        }
#ifdef PROBE_XSYNC
        if (coop) for (int xs = 0; xs < PROBE_XSYNC; ++xs) grid.sync();
#endif
        if (coop && ph + 1 < ph_hi) {
            if (coop == 2) grid.sync();
            else xcd_barrier(xbar);
        }
    }
    __builtin_amdgcn_fence(__ATOMIC_RELEASE, "agent");
}
constexpr int NPH = 1 + 4 * 7 + 2 * 2 + 1;

#define DBG_NOXA 0
#define DBG_NOLRU 0
#define DBG_SKIP 0x0
#ifndef MK_LAUNCHES
#define MK_LAUNCHES 1
#endif

template <int MASK> static bool prep(int& per_cu) {
    if (hipFuncSetAttribute((const void*)mega<MASK>, hipFuncAttributeMaxDynamicSharedMemorySize, LDS_BYTES) != hipSuccess) { fprintf(stderr, "kernel_launch: hipFuncSetAttribute failed (mask %d)\n", MASK); return false; }
    if (hipOccupancyMaxActiveBlocksPerMultiprocessor(&per_cu, (const void*)mega<MASK>, NTHR, LDS_BYTES) != hipSuccess || per_cu < 1) { fprintf(stderr, "kernel_launch: occupancy query says %d (mask %d)\n", per_cu, MASK); per_cu = 1; }
    (void)hipGetLastError();
    return true;
}
template <int MASK> static void launch1(const P& p, int grid, hipStream_t stream) { hipLaunchKernelGGL(mega<MASK>, dim3(grid), dim3(NTHR), LDS_BYTES, stream, p); }

extern "C" void kernel_launch(void* const* d_in, const int* in_sizes, int n_in, void* d_out, int out_size, void* d_ws, size_t ws_size, hipStream_t stream) {
    static int grid = 0;
    if (grid == 0) {
        if (n_in != 32 || out_size != T_ * D_ || ws_size < WS_END) { fprintf(stderr, "kernel_launch: unexpected shapes (n_in %d out %d ws %zu need %zu)\n", n_in, out_size, ws_size, (size_t)WS_END); grid = -1; return; }
        int dev = 0, cus = 0, per_cu = 0;
        (void)hipGetDevice(&dev); (void)hipDeviceGetAttribute(&cus, hipDeviceAttributeMultiprocessorCount, dev);
        bool ok = true;
#if MK_LAUNCHES == 1
        ok = prep<MK_ALL>(per_cu);
#else
        ok = prep<MK_PRO>(per_cu) && prep<MK_GEMM>(per_cu) && prep<MK_LRU>(per_cu) && prep<MK_XA>(per_cu) && prep<MK_ML1>(per_cu) && prep<MK_ML2>(per_cu) && prep<MK_ML3>(per_cu) && prep<MK_FIN>(per_cu);
#endif
        if (!ok) { grid = -1; return; }
        grid = cus > 0 ? cus : 256;
    }
    if (grid < 0) return;
    P p{};
    for (int i = 0; i < 32; ++i) p.in[i] = (const float*)d_in[i];
    p.out = (float*)d_out; p.ws = (unsigned char*)d_ws;
#if MK_LAUNCHES == 1
    p.ph_lo = 0; p.ph_hi = NPH; p.coop = 1; p.pad = 0;
    (void)hipMemsetAsync((unsigned char*)d_ws + WS_BAR, 0, XCD_BAR_WORDS * 4, stream);
    void* args[] = {&p};
    hipError_t e = hipLaunchCooperativeKernel((const void*)mega<MK_ALL>, dim3(grid), dim3(NTHR), args, LDS_BYTES, stream);
    if (e != hipSuccess) fprintf(stderr, "cooperative launch failed: %s (grid %d)\n", hipGetErrorString(e), grid);
#else
    for (int i = 0; i < NPH; ++i) { p.ph_lo = i; p.ph_hi = i + 1; p.coop = 0; p.pad = 0;
        int type;
        if (i == 0) type = 0; else if (i == 33) type = 11; else { const int q = i - 1, r = q & 15; if (r < 7) type = r < 3 ? r + 1 : (r == 3 ? 4 : r + 4); else { const int r2 = r - 7; type = r2 < 3 ? r2 + 1 : r2 + 2; } }
        if (type == 0) launch1<MK_PRO>(p, grid, stream);
#ifdef DBG_SKIP
        else if (((DBG_SKIP >> type) & 1) != 0) {}
#endif
        else if (type == 4) { p.pad = 1; if (!DBG_NOLRU) launch1<MK_LRU>(p, grid, stream); p.pad = 2; if (!DBG_NOXA) launch1<MK_XA>(p, grid, stream); }
        else if (type == 5) launch1<MK_ML1>(p, grid, stream);
        else if (type == 6) { p.pad = 1; launch1<MK_ML2>(p, grid, stream); p.pad = 2; launch1<MK_XA>(p, grid, stream); }
        else if (type == 7) launch1<MK_ML3>(p, grid, stream);
        else if (type == 11) launch1<MK_FIN>(p, grid, stream);
        else launch1<MK_GEMM>(p, grid, stream);
    }
#endif
}
```

```cpp
#include <hip/hip_runtime.h>
#include <hip/hip_cooperative_groups.h>
#include <cstdio>
namespace cg = cooperative_groups;

#define PROBE_ML2_REP 1
#define LAS __attribute__((address_space(3)))
typedef unsigned short bf16_t;
typedef short bf16x8 __attribute__((ext_vector_type(8)));
typedef short s16x4 __attribute__((ext_vector_type(4)));
typedef float f32x4 __attribute__((ext_vector_type(4)));
typedef unsigned u32x4 __attribute__((ext_vector_type(4)));
typedef unsigned u32x2 __attribute__((ext_vector_type(2)));
typedef LAS unsigned char* lds_t;

constexpr int T_ = 16384, D_ = 1024, SEQ_ = 2048, NB_ = 8, FF_ = 2816, MIXW = 1536, INW = 3584, OUTW = 2048, MEMT = 2048;
constexpr float EPS_ = 1e-6f;
constexpr int NTHR = 512;
constexpr int LDS_BYTES = 152 * 1024;

constexpr size_t SZ_GU = (size_t)5632 * 1024 * 2, SZ_DN = (size_t)1024 * 2816 * 2, SZ_IN = (size_t)3584 * 1024 * 2, SZ_KV = (size_t)1024 * 1024 * 2, SZ_OUT = (size_t)1024 * 2048 * 2;
constexpr size_t WL_GU1 = 0, WL_D1 = WL_GU1 + SZ_GU, WL_IN = WL_D1 + SZ_DN, WL_KV = WL_IN + SZ_IN, WL_OUT = WL_KV + SZ_KV, WL_GU2 = WL_OUT + SZ_OUT, WL_D2 = WL_GU2 + SZ_GU, WL_LAYER = WL_D2 + SZ_DN;
constexpr size_t WS_WB = 0;
constexpr size_t WS_U = WS_WB + 4 * WL_LAYER;
constexpr size_t WS_XC = WS_U + (size_t)T_ * INW * 2;
constexpr size_t WS_HOUT = WS_XC + (size_t)T_ * MIXW * 2;
constexpr size_t WS_HB = WS_HOUT + (size_t)T_ * MIXW * 2;
constexpr size_t WS_MEMB = WS_HB + (size_t)T_ * D_ * 2;
constexpr size_t WS_KVM = WS_MEMB + (size_t)MEMT * D_ * 2;
constexpr size_t WS_G = WS_KVM + (size_t)MEMT * D_ * 2;
constexpr size_t WS_SS = WS_G + (size_t)T_ * 8 * 4;
constexpr size_t WS_SSM = WS_SS + (size_t)16 * T_ * 4;
constexpr size_t WS_BAR = WS_SSM + (size_t)MEMT * 16 * 4;
constexpr size_t WS_END = WS_BAR + 16384;

struct P {
    const float* in[32];
    float* out;
    unsigned char* ws;
    int ph_lo, ph_hi, coop, pad;
};
typedef const __attribute__((address_space(4))) P CP;

__device__ __forceinline__ unsigned cvt_pk_bf16(float lo, float hi) { unsigned r; asm("v_cvt_pk_bf16_f32 %0, %1, %2" : "=v"(r) : "v"(lo), "v"(hi)); return r; }
__device__ __forceinline__ float bflo(unsigned w) { return __uint_as_float(w << 16); }
__device__ __forceinline__ float bfhi(unsigned w) { return __uint_as_float(w & 0xffff0000u); }
__device__ __forceinline__ float bf2f(bf16_t b) { return __uint_as_float(((unsigned)b) << 16); }
__device__ __forceinline__ float frcp_(float x) { return __builtin_amdgcn_rcpf(x); }
__device__ __forceinline__ float sigmoidf_(float x) { return frcp_(1.0f + __expf(-x)); }
__device__ __forceinline__ float siluf_(float x) { return x * frcp_(1.0f + __expf(-x)); }
__device__ __forceinline__ float gelu_tanh_(float x) { const float u = 1.5957691216f * (x + 0.044715f * x * x * x); return x * frcp_(1.0f + __expf(-u)); }
__device__ __forceinline__ float softplusf_(float x) { return fmaxf(x, 0.f) + log1pf(__expf(-fabsf(x))); }
__device__ __forceinline__ float wave_sum(float v) {
#pragma unroll
    for (int d = 32; d >= 1; d >>= 1) v += __shfl_xor(v, d);
    return v;
}
template <class Tt> __device__ __forceinline__ Tt lds_ld(lds_t L, int off) { return *(const LAS Tt*)(L + off); }
template <class Tt> __device__ __forceinline__ void lds_st(lds_t L, int off, Tt v) { *(LAS Tt*)(L + off) = v; }
__device__ __forceinline__ bf16x8 tr_pair(lds_t L, int off0, int off1) {
    s16x4 a = __builtin_amdgcn_ds_read_tr16_b64_v4i16((LAS s16x4*)(L + off0));
    s16x4 b = __builtin_amdgcn_ds_read_tr16_b64_v4i16((LAS s16x4*)(L + off1));
    return __builtin_shufflevector(a, b, 0, 1, 2, 3, 4, 5, 6, 7);
}
__device__ __forceinline__ bf16x8 pack8(f32x4 a, f32x4 b) {
    u32x4 w; w.x = cvt_pk_bf16(a[0], a[1]); w.y = cvt_pk_bf16(a[2], a[3]); w.z = cvt_pk_bf16(b[0], b[1]); w.w = cvt_pk_bf16(b[2], b[3]);
    return __builtin_bit_cast(bf16x8, w);
}
__device__ __forceinline__ void st16_sc1(void* ptr, u32x4 v) { asm volatile("global_store_dwordx4 %0, %1, off sc1\n\ts_nop 2" :: "v"(ptr), "v"(v) : "memory"); }
#define MFMA16(a, b, c) __builtin_amdgcn_mfma_f32_16x16x32_bf16((a), (b), (c), 0, 0, 0)

#define XB_TMO      128
#define XB_XCNT(j)  (256  + 64 * (j))
#define XB_XSUB(j)  (1280 + 64 * (j))
#define XB_XGEN(j)  (2304 + 64 * (j))
#define XB_TOP      3328
#define XB_TOPGEN   3392
#define XCD_BAR_WORDS 3456
#define XB_SPIN_CAP (1u << 18)

__device__ __forceinline__ unsigned xb_ld(unsigned* p)              { return __hip_atomic_load(p, __ATOMIC_RELAXED, __HIP_MEMORY_SCOPE_AGENT); }
__device__ __forceinline__ unsigned xb_add(unsigned* p, unsigned v) { return __hip_atomic_fetch_add(p, v, __ATOMIC_RELAXED, __HIP_MEMORY_SCOPE_AGENT); }
__device__ __forceinline__ unsigned xb_xcc_id() { return (unsigned)__builtin_amdgcn_s_getreg((3 << 11) | 20) & 0xFu; }
#define XB_SPIN(cond, bar) do { unsigned _sp = 0; while (cond) { __builtin_amdgcn_s_sleep(1); \
    if ((++_sp & 255u) == 0u) { if (xb_ld(&(bar)[XB_TMO])) break; if (_sp > XB_SPIN_CAP) { atomicAdd(&(bar)[XB_TMO], 1u); break; } } } } while (0)

struct XcdBarrier {
    unsigned* bar; unsigned x;
    volatile LAS unsigned* st;
};

__device__ __forceinline__ XcdBarrier xcd_barrier_post(unsigned* bar, volatile LAS unsigned* st) {
    XcdBarrier b; b.bar = bar; b.x = xb_xcc_id(); b.st = st;
    if (threadIdx.x == 0) (void)xb_add(&bar[XB_XCNT(b.x)], 1u);
    return b;
}
__device__ __forceinline__ void xcd_barrier_complete(unsigned* bar, unsigned x, unsigned& nloc, unsigned& nx) {
    const unsigned G = gridDim.x * gridDim.y * gridDim.z;
    unsigned sum, cnt, mine, sp = 0u;
    for (;;) {
        sum = 0u; cnt = 0u; mine = 0u;
#pragma unroll
        for (unsigned j = 0; j < 16; ++j) { const unsigned c = xb_ld(&bar[XB_XCNT(j)]); sum += c; cnt += (c > 0u) ? 1u : 0u; mine = (j == x) ? c : mine; }
        if (sum == G) break;
        __builtin_amdgcn_s_sleep(1);
        if ((++sp & 255u) == 0u) { if (xb_ld(&bar[XB_TMO])) break; if (sp > XB_SPIN_CAP) { atomicAdd(&bar[XB_TMO], 1u); break; } }
    }
    nloc = mine > 0u ? mine : 1u; nx = cnt > 0u ? cnt : 1u;
}

__device__ __forceinline__ void xcd_barrier(const XcdBarrier& b) {
    asm volatile("s_waitcnt vmcnt(0)" ::: "memory");
    __syncthreads();
    if (threadIdx.x == 0) {
        unsigned* bar = b.bar;
        __builtin_amdgcn_s_waitcnt(0);
        unsigned nloc = b.st[0], nx = b.st[1];
        if (nloc == 0u) { xcd_barrier_complete(bar, b.x, nloc, nx); b.st[0] = nloc; b.st[1] = nx; }
        const unsigned old = xb_add(&bar[XB_XSUB(b.x)], 1u);
        const unsigned gen = old / nloc;
        if (old + 1u == (gen + 1u) * nloc) {
            __builtin_amdgcn_fence(__ATOMIC_RELEASE, "agent");
            asm volatile("s_waitcnt vmcnt(0)" ::: "memory");
            const unsigned og = xb_add(&bar[XB_TOP], 1u);
            const unsigned tg = og / nx;
            if (og + 1u == (tg + 1u) * nx) xb_add(&bar[XB_TOPGEN], 1u);
            else XB_SPIN(xb_ld(&bar[XB_TOPGEN]) == tg, bar);
            __builtin_amdgcn_fence(__ATOMIC_ACQUIRE, "agent");
            xb_add(&bar[XB_XGEN(b.x)], 1u);
            asm volatile("s_waitcnt vmcnt(0)" ::: "memory");
        } else {
            XB_SPIN(xb_ld(&bar[XB_XGEN(b.x)]) == gen, bar);
            __builtin_amdgcn_fence(__ATOMIC_ACQUIRE, "agent");
            asm volatile("s_waitcnt vmcnt(0)" ::: "memory");
        }
    }
    __syncthreads();
}


namespace pg8 {
constexpr int BM = 256, BK = 64, HALF = 128, HTB = HALF * BK * 2, NXCD = 8, WGM = 8;
__device__ __forceinline__ int lds_byte(int r, int c) { const int st = (r >> 4) * 2 + (c >> 5), rr = r & 15, cc = c & 31, ob = rr * 64 + cc * 2; return st * 1024 + (ob ^ (((ob >> 9) & 1) << 5)); }
__device__ __forceinline__ void stage_rc(int b, int& R, int& C) { const int st = b / 1024, sb = b % 1024, swz = sb ^ (((sb >> 9) & 1) << 5); R = (st >> 1) * 16 + swz / 64; C = (st & 1) * 32 + (swz % 64) / 2; }
__device__ __forceinline__ int perm32(int rho) { const int n = rho >> 4, i = rho & 15; return 8 * (i >> 2) + 4 * n + (i & 3); }
struct Unit { int pm, pn; };
struct Gemm { const bf16_t* A; const bf16_t* Bt; int M, N, K, lda; };
struct StaticOrder {
    int nM, nN, nwg, G, c, sf, sl;
    __device__ void init(int M, int N, int G_, int c_) { nM = M / BM; nN = N / BM; nwg = nM * nN; G = G_; c = c_; sf = 1 << 30; sl = 0; }
    __device__ bool next(int i, Unit& u) const {
        const long L = (long)i * G + c; if (L >= nwg) return false;
        int wgid = (int)L; { const int q = nwg / NXCD, r = nwg % NXCD, xcd = wgid % NXCD, off = wgid / NXCD; wgid = (xcd < r ? xcd * (q + 1) : r * (q + 1) + (xcd - r) * q) + off; }
        const int nig = WGM * nN, gid = wgid / nig, fm = gid * WGM, gsz = (nM - fm) < WGM ? (nM - fm) : WGM;
        u.pm = fm + ((wgid % nig) % gsz); u.pn = (wgid % nig) / gsz; if (u.pn >= sf) u.pn += sl; return true;
    }
};

template <class Epi>
__device__ __forceinline__ void gemm_phase(lds_t lds, const Gemm g, const StaticOrder& S, const Epi& E) {
    int tid_ = threadIdx.x; asm volatile("" : "+v"(tid_)); const int tid = tid_, wid = __builtin_amdgcn_readfirstlane(tid >> 6), lane = tid & 63, wr = wid >> 2, wc = wid & 3, fr = lane & 15, fq = lane >> 4;
    const int K = g.K, nt = K / BK, lda = g.lda;
    unsigned voffA[2], voffB[2];
#pragma unroll
    for (int i = 0; i < 2; ++i) { int R, C; stage_rc(tid * 16 + i * 8192, R, C); const int Rb = Epi::PERM ? ((R & ~31) + perm32(R & 31)) : R;
        voffA[i] = (unsigned)(R * lda + C) * 2u; voffB[i] = (unsigned)(Rb * K + C) * 2u; }
    const size_t kstep = (size_t)(BK * 2);
    const size_t hstepA = (size_t)HALF * lda * 2, hstepB = (size_t)HALF * K * 2;
    const size_t tstepA = 2 * hstepA, tstepB = 2 * hstepB;
    const unsigned ldsw = (unsigned)wid * 1024u;
    const int aoff = lds_byte(wr * 64 + fr, fq * 8), boff = lds_byte(wc * 32 + fr, fq * 8);
#define PG8_SA(b, h) (((b) * 2 + (h)) * HTB)
#define PG8_SB(b, h) ((4 + (b) * 2 + (h)) * HTB)
#define PG8_STAGE(bufoff, gbase, voff) do { _Pragma("unroll") for (int _i = 0; _i < 2; ++_i) \
        __builtin_amdgcn_global_load_lds((const unsigned*)((const char*)(gbase) + (voff)[_i]), (LAS unsigned*)(lds + (bufoff) + ldsw + _i * 8192), 16, 0, 0); } while (0)
#define PG8_LDA(dst, b, h) do { _Pragma("unroll") for (int m = 0; m < 4; ++m) _Pragma("unroll") for (int k = 0; k < 2; ++k) dst[m][k] = *(const LAS bf16x8*)(lds + PG8_SA(b, h) + aoff + m * 2048 + k * 1024); } while (0)
#define PG8_LDB(dst, b, h) do { _Pragma("unroll") for (int n = 0; n < 2; ++n) _Pragma("unroll") for (int k = 0; k < 2; ++k) dst[n][k] = *(const LAS bf16x8*)(lds + PG8_SB(b, h) + boff + n * 2048 + k * 1024); } while (0)
#define PG8_MMA(ai, bj, At, Bt) do { __builtin_amdgcn_s_setprio(1); _Pragma("unroll") for (int m = 0; m < 4; ++m) _Pragma("unroll") for (int n = 0; n < 2; ++n) _Pragma("unroll") for (int k = 0; k < 2; ++k) \
        acc[ai][bj][m][n] = __builtin_amdgcn_mfma_f32_16x16x32_bf16(Bt[n][k], At[m][k], acc[ai][bj][m][n], 0, 0, 0); __builtin_amdgcn_s_setprio(0); } while (0)
#define PG8_WAIT_V(n) asm volatile("s_waitcnt vmcnt(" #n ")" ::: "memory")
#define PG8_WAIT_L(n) asm volatile("s_waitcnt lgkmcnt(" #n ")" ::: "memory")
#define PG8_BAR __builtin_amdgcn_s_barrier()
#define PG8_SCHED __builtin_amdgcn_sched_barrier(0)
    Unit cur, nxt; int ui = 0;
    if (!S.next(0, cur)) return;
    f32x4 acc[2][2][4][2];
    E.init(acc, cur, wr, wc, fr, fq);
    bf16x8 At[4][2], B0[2][2], B1[2][2];
    E.rowscales(lds, tid * 32, cur.pm, wr, fr, fq);
    const char* cA = (const char*)g.A + (size_t)cur.pm * tstepA; const char* cB = (const char*)g.Bt + (size_t)cur.pn * tstepB;
    PG8_STAGE(PG8_SB(0, 0), cB, voffB); PG8_STAGE(PG8_SA(0, 0), cA, voffA); PG8_STAGE(PG8_SB(0, 1), cB + hstepB, voffB); PG8_STAGE(PG8_SA(0, 1), cA + hstepA, voffA);
    if (wr == 1) PG8_BAR;
    PG8_WAIT_V(4); PG8_BAR;
    PG8_STAGE(PG8_SB(1, 0), cB + kstep, voffB); PG8_STAGE(PG8_SA(1, 0), cA + kstep, voffA); PG8_STAGE(PG8_SB(1, 1), cB + hstepB + kstep, voffB);
    PG8_WAIT_V(6); PG8_BAR;
    for (;;) {
        const bool has_next = S.next(ui + 1, nxt);
        const char* nA = has_next ? (const char*)g.A + (size_t)nxt.pm * tstepA : cA; const char* nB = has_next ? (const char*)g.Bt + (size_t)nxt.pn * tstepB : cB;
        for (int t = 0; t < nt; t += 2) {
            const bool last = (t == nt - 2);
            const char* a1 = cA + (size_t)(t + 1) * kstep;
            const char* a2 = last ? nA : cA + (size_t)(t + 2) * kstep; const char* b2 = last ? nB : cB + (size_t)(t + 2) * kstep;
            const char* a3 = a2 + kstep; const char* b3 = b2 + kstep;
            PG8_LDB(B0, 0, 0); PG8_SCHED; PG8_LDA(At, 0, 0); PG8_STAGE(PG8_SA(1, 1), a1 + hstepA, voffA);
            PG8_WAIT_L(8); PG8_BAR; PG8_WAIT_L(0); PG8_MMA(0, 0, At, B0); PG8_BAR; PG8_SCHED;
            PG8_LDB(B1, 0, 1); PG8_STAGE(PG8_SB(0, 0), b2, voffB);
            PG8_BAR; PG8_WAIT_L(0); PG8_MMA(0, 1, At, B1); PG8_BAR;
            PG8_LDA(At, 0, 1); PG8_STAGE(PG8_SA(0, 0), a2, voffA);
            PG8_BAR; PG8_WAIT_L(0); PG8_MMA(1, 0, At, B0); PG8_BAR; PG8_SCHED;
            PG8_STAGE(PG8_SB(0, 1), b2 + hstepB, voffB);
            PG8_WAIT_V(6); PG8_BAR; PG8_MMA(1, 1, At, B1); PG8_BAR;
            PG8_LDB(B0, 1, 0); PG8_SCHED; PG8_LDA(At, 1, 0); PG8_STAGE(PG8_SA(0, 1), a2 + hstepA, voffA);
            PG8_WAIT_L(8); PG8_BAR; PG8_WAIT_L(0); PG8_MMA(0, 0, At, B0); PG8_BAR; PG8_SCHED;
            PG8_LDB(B1, 1, 1); PG8_STAGE(PG8_SB(1, 0), b3, voffB);
            PG8_BAR; PG8_WAIT_L(0); PG8_MMA(0, 1, At, B1); PG8_BAR;
            PG8_LDA(At, 1, 1); PG8_STAGE(PG8_SA(1, 0), a3, voffA);
            PG8_BAR; PG8_WAIT_L(0); PG8_MMA(1, 0, At, B0); PG8_BAR; PG8_SCHED;
            PG8_STAGE(PG8_SB(1, 1), b3 + hstepB, voffB);
            PG8_WAIT_V(6); PG8_BAR; PG8_MMA(1, 1, At, B1); PG8_BAR;
        }
        E(acc, lds, tid * 32, cur, wr, wc, fr, fq);
        if (!has_next) break;
        E.init(acc, nxt, wr, wc, fr, fq);
        if (nxt.pm != cur.pm) E.rowscales(lds, tid * 32, nxt.pm, wr, fr, fq);
        cur = nxt; cA = nA; cB = nB; ++ui;
    }
    PG8_WAIT_V(0);
    if (wr == 0) PG8_BAR;
    PG8_BAR;
#undef PG8_SA
#undef PG8_SB
#undef PG8_STAGE
#undef PG8_LDA
#undef PG8_LDB
#undef PG8_MMA
#undef PG8_WAIT_V
#undef PG8_WAIT_L
#undef PG8_BAR
#undef PG8_SCHED
}

__device__ __forceinline__ float rowscale(const float* ss, int row) {
    const f32x4 a = *(const f32x4*)(ss + (size_t)row * 16), b = *(const f32x4*)(ss + (size_t)row * 16 + 4), c = *(const f32x4*)(ss + (size_t)row * 16 + 8), d = *(const f32x4*)(ss + (size_t)row * 16 + 12);
    const float s = ((a[0] + a[1]) + (a[2] + a[3])) + ((b[0] + b[1]) + (b[2] + b[3])) + ((c[0] + c[1]) + (c[2] + c[3])) + ((d[0] + d[1]) + (d[2] + d[3]));
    return rsqrtf(s * (1.0f / 1024.0f) + EPS_); }

struct EpiAll {
    static constexpr bool PERM = true;
    int mode; bf16_t* O; int ldc; const float* ss; float* H; float* ssn;
    __device__ __forceinline__ void init(f32x4 (&acc)[2][2][4][2], const Unit& u, int wr, int wc, int fr, int fq) const {
        if (mode == 2) {
            const int row0 = u.pm * BM + wr * 64 + fr, col0 = u.pn * BM + wc * 32 + 8 * fq;
#pragma unroll
            for (int ai = 0; ai < 2; ++ai)
#pragma unroll
                for (int m = 0; m < 4; ++m)
#pragma unroll
                    for (int bj = 0; bj < 2; ++bj) { const u32x4 hw = *(const u32x4*)(O + (size_t)(row0 + ai * HALF + m * 16) * D_ + col0 + bj * HALF);
                        acc[ai][bj][m][0] = (f32x4){bflo(hw.x), bfhi(hw.x), bflo(hw.y), bfhi(hw.y)}; acc[ai][bj][m][1] = (f32x4){bflo(hw.z), bfhi(hw.z), bflo(hw.w), bfhi(hw.w)}; }
        } else {
#pragma unroll
            for (int a = 0; a < 2; ++a)
#pragma unroll
                for (int b = 0; b < 2; ++b)
#pragma unroll
                    for (int m = 0; m < 4; ++m)
#pragma unroll
                        for (int n = 0; n < 2; ++n) acc[a][b][m][n] = (f32x4){0.f, 0.f, 0.f, 0.f};
        }
    }
    __device__ __forceinline__ void rowscales(lds_t lds, int tslot, int pm, int wr, int fr, int fq) const {
        float rs[2][4];
        if (mode != 2) { const int row0 = pm * BM + wr * 64 + fr; f32x4 t[2][4];
#pragma unroll
            for (int ai = 0; ai < 2; ++ai)
#pragma unroll
                for (int m = 0; m < 4; ++m) t[ai][m] = *(const f32x4*)(ss + (size_t)(row0 + ai * HALF + m * 16) * 16 + 4 * fq);
#pragma unroll
            for (int ai = 0; ai < 2; ++ai)
#pragma unroll
                for (int m = 0; m < 4; ++m) { float sm = (t[ai][m][0] + t[ai][m][1]) + (t[ai][m][2] + t[ai][m][3]);
                    sm += __shfl_xor(sm, 16); sm += __shfl_xor(sm, 32);
                    rs[ai][m] = rsqrtf(sm * (1.0f / 1024.0f) + EPS_); }
            *(LAS f32x4*)(lds + 131072 + tslot) = (f32x4){rs[0][0], rs[0][1], rs[0][2], rs[0][3]};
            *(LAS f32x4*)(lds + 131072 + tslot + 16) = (f32x4){rs[1][0], rs[1][1], rs[1][2], rs[1][3]}; }
    }
    __device__ __forceinline__ void operator()(const f32x4 (&acc)[2][2][4][2], lds_t lds, int tslot, const Unit& u, int wr, int wc, int fr, int fq) const {
        const int row0 = u.pm * BM + wr * 64 + fr;
        if (mode != 2) {
            float rs[2][4];
            { const f32x4 r0 = *(const LAS f32x4*)(lds + 131072 + tslot), r1 = *(const LAS f32x4*)(lds + 131072 + tslot + 16);
              rs[0][0] = r0[0]; rs[0][1] = r0[1]; rs[0][2] = r0[2]; rs[0][3] = r0[3]; rs[1][0] = r1[0]; rs[1][1] = r1[1]; rs[1][2] = r1[2]; rs[1][3] = r1[3]; }
            if (mode == 0) {
                const int col0 = u.pn * 128 + wc * 32 + 8 * fq;
#pragma unroll
                for (int ai = 0; ai < 2; ++ai)
#pragma unroll
                    for (int m = 0; m < 4; ++m) { const int row = row0 + ai * HALF + m * 16; const float r1 = rs[ai][m];
                        float v[8];
#pragma unroll
                        for (int n = 0; n < 2; ++n)
#pragma unroll
                            for (int j = 0; j < 4; ++j) { const float gt = acc[ai][0][m][n][j] * r1, up = acc[ai][1][m][n][j] * r1; v[n * 4 + j] = siluf_(gt) * up; }
                        u32x4 w; w.x = cvt_pk_bf16(v[0], v[1]); w.y = cvt_pk_bf16(v[2], v[3]); w.z = cvt_pk_bf16(v[4], v[5]); w.w = cvt_pk_bf16(v[6], v[7]);
                        st16_sc1(O + (size_t)row * FF_ + col0, w); }
            } else {
                const int col0 = u.pn * BM + wc * 32 + 8 * fq;
#pragma unroll
                for (int ai = 0; ai < 2; ++ai)
#pragma unroll
                    for (int m = 0; m < 4; ++m) { const int row = row0 + ai * HALF + m * 16; const float r1 = rs[ai][m];
#pragma unroll
                        for (int bj = 0; bj < 2; ++bj) { const f32x4 v0 = acc[ai][bj][m][0] * r1, v1 = acc[ai][bj][m][1] * r1;
                            u32x4 w; w.x = cvt_pk_bf16(v0[0], v0[1]); w.y = cvt_pk_bf16(v0[2], v0[3]); w.z = cvt_pk_bf16(v1[0], v1[1]); w.w = cvt_pk_bf16(v1[2], v1[3]);
                            st16_sc1(O + (size_t)row * ldc + col0 + bj * HALF, w); } }
            }
        } else {
            const int col0 = u.pn * BM + wc * 32 + 8 * fq;
#pragma unroll
            for (int ai = 0; ai < 2; ++ai)
#pragma unroll
                for (int m = 0; m < 4; ++m) { const int row = row0 + ai * HALF + m * 16; float s2 = 0.f;
#pragma unroll
                    for (int bj = 0; bj < 2; ++bj) { const size_t o = (size_t)row * D_ + col0 + bj * HALF;
                        const f32x4 h0 = acc[ai][bj][m][0], h1 = acc[ai][bj][m][1];
                        u32x4 w; w.x = cvt_pk_bf16(h0[0], h0[1]); w.y = cvt_pk_bf16(h0[2], h0[3]); w.z = cvt_pk_bf16(h1[0], h1[1]); w.w = cvt_pk_bf16(h1[2], h1[3]);
                        st16_sc1(O + o, w);
                        s2 += h0[0] * h0[0] + h0[1] * h0[1] + h0[2] * h0[2] + h0[3] * h0[3] + h1[0] * h1[0] + h1[1] * h1[1] + h1[2] * h1[2] + h1[3] * h1[3]; }
                    s2 += __shfl_xor(s2, 16); s2 += __shfl_xor(s2, 32);
                    if (fq == 0) ssn[(size_t)row * 16 + u.pn * 4 + wc] = s2; }
        }
    }
};
}

struct TileDesc { const float* src; const float* gain; bf16_t* dst; float base; };
__device__ __forceinline__ int dim_of(int code) { return code == 0 ? FF_ : (code == 1 ? D_ : (code == 2 ? INW : OUTW)); }
__device__ __forceinline__ TileDesc tile_desc(CP& p, int g, int tid) {
    constexpr int TPL = 5888;
    const int l = g / TPL, r = g % TPL;
    const int seg = (r >= 704) + (r >= 1408) + (r >= 2112) + (r >= 3008) + (r >= 3264) + (r >= 3776) + (r >= 4480) + (r >= 5184);
    const int start = seg < 3 ? seg * 704 : (seg == 3 ? 2112 : (seg == 4 ? 3008 : (seg == 5 ? 3264 : 3776 + (seg - 6) * 704)));
    const int sh = 4 * seg;
    const int in_idx = (int)((0xEDCA97543ull >> sh) & 15), gidx = (int)((0x0CC097033ull >> sh) & 15), mode = (int)((0x021000021ull >> sh) & 15);
    const int N = dim_of((int)((0x100112100ull >> sh) & 15)), K = dim_of((int)((0x011311011ull >> sh) & 15));
    const size_t wl = seg < 2 ? WL_GU1 : (seg == 2 ? WL_D1 : (seg == 3 ? WL_IN : (seg == 4 ? WL_KV : (seg == 5 ? WL_OUT : (seg < 8 ? WL_GU2 : WL_D2)))));
    const int rr = r - start, ntn = N >> 6, kt = rr / ntn, nt = rr - kt * ntn;
    const float* W = p.in[in_idx] + (size_t)l * K * N;
    TileDesc d;
    d.src = W + (size_t)(kt * 64 + (tid >> 3)) * N + nt * 64 + (tid & 7) * 8;
    d.gain = gidx ? p.in[gidx - 1] + l * D_ + kt * 64 + (tid >> 3) : nullptr;
    const int nn = nt * 64 + (tid >> 3); const int drow = mode == 0 ? nn : ((nn >> 7) * 256 + (mode == 2 ? 128 : 0) + (nn & 127));
    d.dst = (bf16_t*)(p.ws + WS_WB + (size_t)l * WL_LAYER + wl) + (size_t)drow * K + kt * 64 + 8 * (tid & 7);
    d.base = (seg == 2 || seg == 8) ? 0.5f : 1.0f;
    return d;
}
__device__ __forceinline__ void transpose_range(CP& p, lds_t L, int g0, int gend, int stride) {
    int tid_ = threadIdx.x; asm volatile("" : "+v"(tid_)); const int tid = tid_;
    int g = g0; asm volatile("" : "+s"(g));
    f32x4 a = (f32x4){0.f, 0.f, 0.f, 0.f}, b = a; float gn = 1.f; TileDesc cur; cur.dst = nullptr;
    __syncthreads();
    if (g < gend) { cur = tile_desc(p, g, tid); a = *(const f32x4*)cur.src; b = *(const f32x4*)(cur.src + 4); gn = cur.base * (cur.gain ? *cur.gain : 1.0f); }
    for (; g < gend; g += stride) {
        const int gnx = g + stride; TileDesc nxt; nxt.dst = nullptr; f32x4 na = a, nb = b; float ng = 1.f;
        if (gnx < gend) { nxt = tile_desc(p, gnx, tid); na = *(const f32x4*)nxt.src; nb = *(const f32x4*)(nxt.src + 4); ng = nxt.base * (nxt.gain ? *nxt.gain : 1.0f); }
        { const int r = tid >> 3, c8 = (tid & 7) * 8, o = (r * 65 + c8) * 4;
          lds_st<float>(L, o, a[0] * gn); lds_st<float>(L, o + 4, a[1] * gn); lds_st<float>(L, o + 8, a[2] * gn); lds_st<float>(L, o + 12, a[3] * gn);
          lds_st<float>(L, o + 16, b[0] * gn); lds_st<float>(L, o + 20, b[1] * gn); lds_st<float>(L, o + 24, b[2] * gn); lds_st<float>(L, o + 28, b[3] * gn); }
        __syncthreads();
        { const int n = tid >> 3, kc = tid & 7; float v[8];
#pragma unroll
          for (int j = 0; j < 8; ++j) v[j] = lds_ld<float>(L, ((8 * kc + j) * 65 + n) * 4);
          u32x4 w; w.x = cvt_pk_bf16(v[0], v[1]); w.y = cvt_pk_bf16(v[2], v[3]); w.z = cvt_pk_bf16(v[4], v[5]); w.w = cvt_pk_bf16(v[6], v[7]);
          *(u32x4*)cur.dst = w; }
        __syncthreads();
        cur = nxt; a = na; b = nb; gn = ng;
    }
}

__device__ __forceinline__ void phase_prologue(CP& p, lds_t L) {
    int tid_ = threadIdx.x; asm volatile("" : "+v"(tid_)); const int tid = tid_, lane = tid & 63, wid = tid >> 6;
    unsigned char* ws = p.ws;
    { bf16_t* HB = (bf16_t*)(ws + WS_HB); float* ss = (float*)(ws + WS_SS); bf16_t* MB = (bf16_t*)(ws + WS_MEMB); float* ssm = (float*)(ws + WS_SSM);
      for (int row = blockIdx.x * 8 + wid; row < T_ + MEMT; row += gridDim.x * 8) {
          const bool isx = row < T_; const int r = isx ? row : row - T_;
          const float* src = (isx ? p.in[0] : p.in[1]) + (size_t)r * D_; float s2 = 0.f;
#pragma unroll
          for (int i = 0; i < 4; ++i) { const int c = i * 256 + lane * 4; const f32x4 v = *(const f32x4*)(src + c);
              s2 += v[0] * v[0] + v[1] * v[1] + v[2] * v[2] + v[3] * v[3];
              u32x2 w; w.x = cvt_pk_bf16(v[0], v[1]); w.y = cvt_pk_bf16(v[2], v[3]);
              if (isx) { *(u32x2*)(HB + (size_t)r * D_ + c) = w; } else { *(u32x2*)(MB + (size_t)r * D_ + c) = w; } }
          s2 = wave_sum(s2);
          if (lane < 16) { const float v = lane == 0 ? s2 : 0.f; if (isx) ss[(size_t)r * 16 + lane] = v; else ssm[(size_t)r * 16 + lane] = v; } } }
    transpose_range(p, L, blockIdx.x, 5888, gridDim.x);
}

__device__ __forceinline__ void lru_output(lds_t L, bf16_t* U, int b, int n, int q4, int t0, int w) {
    constexpr int UUo = 114176;
    u32x4 g[6];
#pragma unroll
    for (int k = 0; k < 6; ++k) { const int e = w + 128 * k, t = e / 6, c8 = e % 6; g[k] = *(const u32x4*)(U + (size_t)(b * SEQ_ + t0 + t) * INW + MIXW + n * 192 + 48 * q4 + 8 * c8); }
#pragma unroll
    for (int k = 0; k < 6; ++k) { const int e = w + 128 * k, t = e / 6, c8 = e % 6;
        const f32x4 h0 = lds_ld<f32x4>(L, UUo + (t * 48 + 8 * c8) * 4), h1 = lds_ld<f32x4>(L, UUo + (t * 48 + 8 * c8 + 4) * 4);
        u32x4 wv; wv.x = cvt_pk_bf16(h0[0] * gelu_tanh_(bflo(g[k].x)), h0[1] * gelu_tanh_(bfhi(g[k].x))); wv.y = cvt_pk_bf16(h0[2] * gelu_tanh_(bflo(g[k].y)), h0[3] * gelu_tanh_(bfhi(g[k].y)));
        wv.z = cvt_pk_bf16(h1[0] * gelu_tanh_(bflo(g[k].z)), h1[1] * gelu_tanh_(bfhi(g[k].z))); wv.w = cvt_pk_bf16(h1[2] * gelu_tanh_(bflo(g[k].w)), h1[3] * gelu_tanh_(bfhi(g[k].w)));
        st16_sc1(U + (size_t)(b * SEQ_ + t0 + t) * INW + MIXW + n * 192 + 48 * q4 + 8 * c8, wv); }
}

__device__ __forceinline__ void lru_item(CP& p, int jl, int item, lds_t L) {
    constexpr int WLo = 0, XCo = 38400, AAo = 89600, UUo = 114176, SEGo = 138752, CARo = 141824;
    int tid_ = threadIdx.x; asm volatile("" : "+v"(tid_)); const int tid = tid_, lane = tid & 63, wid = tid >> 6, fr = lane & 15, fq = lane >> 4;
    const int pair_ = (item & 7) * 8 + (item >> 5), b = pair_ >> 3, n = pair_ & 7, q4 = (item >> 3) & 3;
    bf16_t* U = (bf16_t*)(p.ws + WS_U);
    const float* w_r = p.in[17] + ((size_t)(jl * 8 + n) * 192) * 192; const float* w_i = p.in[19] + ((size_t)(jl * 8 + n) * 192) * 192;
    __syncthreads();
#pragma unroll 1
    for (int r3 = 0; r3 < 3; ++r3) {
        float v[12];
#pragma unroll
        for (int k = 0; k < 12; ++k) { const int idx = tid + NTHR * (12 * r3 + k), i = idx / 96, oo = idx % 96; v[k] = (oo < 48 ? w_r : w_i)[(size_t)i * 192 + 48 * q4 + (oo % 48)]; }
#pragma unroll
        for (int k = 0; k < 12; ++k) { const int idx = tid + NTHR * (12 * r3 + k), i = idx / 96, oo = idx % 96; lds_st<bf16_t>(L, WLo + oo * 400 + i * 2, (bf16_t)(cvt_pk_bf16(v[k], 0.f) & 0xffffu)); }
    }
    if (tid < 96) lds_st<float>(L, CARo + tid * 4, 0.f);
    float br[3], bi[3], sp[3];
#pragma unroll
    for (int t3 = 0; t3 < 3; ++t3) { const int c = jl * MIXW + n * 192 + 48 * q4 + 16 * t3 + fr; br[t3] = p.in[18][c]; bi[t3] = p.in[20][c]; sp[t3] = softplusf_(-p.in[21][c]); }
    const int cg = tid % 24, trow = tid / 24; float cw[4][8], cb[8];
    { const int c0 = jl * MIXW + n * 192 + 8 * cg;
#pragma unroll
      for (int j = 0; j < 4; ++j)
#pragma unroll
          for (int e = 0; e < 8; ++e) cw[j][e] = p.in[15][(size_t)jl * 4 * MIXW + (size_t)j * MIXW + n * 192 + 8 * cg + e];
#pragma unroll
      for (int e = 0; e < 8; ++e) cb[e] = p.in[16][c0 + e]; }
    for (int ck = 0; ck < 16; ++ck) {
        const int t0 = ck * 128;
        if (tid >= 384 && ck > 0) lru_output(L, U, b, n, q4, t0 - 128, tid - 384);
        if (tid < 384) {
            u32x4 raw[11];
#pragma unroll
            for (int j = 0; j < 11; ++j) { const int tt = t0 + trow * 8 - 3 + j;
                raw[j] = tt >= 0 ? *(const u32x4*)(U + (size_t)(b * SEQ_ + tt) * INW + n * 192 + 8 * cg) : (u32x4){0u, 0u, 0u, 0u}; }
#pragma unroll
            for (int it = 0; it < 8; ++it) { const int t = trow * 8 + it; float acc[8];
#pragma unroll
                for (int e = 0; e < 8; ++e) acc[e] = cb[e];
#pragma unroll
                for (int j = 0; j < 4; ++j) { const u32x4 rw = raw[it + j];
                    acc[0] += cw[j][0] * bflo(rw.x); acc[1] += cw[j][1] * bfhi(rw.x); acc[2] += cw[j][2] * bflo(rw.y); acc[3] += cw[j][3] * bfhi(rw.y);
                    acc[4] += cw[j][4] * bflo(rw.z); acc[5] += cw[j][5] * bfhi(rw.z); acc[6] += cw[j][6] * bflo(rw.w); acc[7] += cw[j][7] * bfhi(rw.w); }
                u32x4 w; w.x = cvt_pk_bf16(acc[0], acc[1]); w.y = cvt_pk_bf16(acc[2], acc[3]); w.z = cvt_pk_bf16(acc[4], acc[5]); w.w = cvt_pk_bf16(acc[6], acc[7]);
                lds_st<u32x4>(L, XCo + t * 400 + cg * 16, w); }
        }
        __syncthreads();
        {
            f32x4 acc[6];
#pragma unroll
            for (int i = 0; i < 6; ++i) acc[i] = (f32x4){0.f, 0.f, 0.f, 0.f};
#pragma unroll
            for (int ks = 0; ks < 6; ++ks) { const bf16x8 a = lds_ld<bf16x8>(L, XCo + (16 * wid + fr) * 400 + (32 * ks + 8 * fq) * 2);
#pragma unroll
                for (int nt = 0; nt < 6; ++nt) { const bf16x8 bb = lds_ld<bf16x8>(L, WLo + (16 * nt + fr) * 400 + (32 * ks + 8 * fq) * 2); acc[nt] = MFMA16(a, bb, acc[nt]); } }
#pragma unroll
            for (int t3 = 0; t3 < 3; ++t3) { const int oc = 16 * t3 + fr;
#pragma unroll
                for (int rg = 0; rg < 4; ++rg) { const int t = 16 * wid + 4 * fq + rg;
                    const float r = sigmoidf_(acc[t3][rg] + br[t3]), gi = sigmoidf_(acc[t3 + 3][rg] + bi[t3]);
                    const float la = -8.0f * r * sp[t3], a = __expf(la), mult = __builtin_amdgcn_sqrtf(fmaxf(1.0f - a * a, 0.f));
                    const float xc = bf2f(lds_ld<bf16_t>(L, XCo + t * 400 + (48 * q4 + oc) * 2));
                    lds_st<float>(L, AAo + (t * 48 + oc) * 4, a); lds_st<float>(L, UUo + (t * 48 + oc) * 4, mult * gi * xc); } }
        }
        __syncthreads();
        const int ch = tid % 48, sg = tid / 48;
        if (tid < 384) { float A = 1.f, Hh = 0.f;
#pragma unroll
            for (int i = 0; i < 16; ++i) { const int t = 16 * sg + i; const float a = lds_ld<float>(L, AAo + (t * 48 + ch) * 4), uu = lds_ld<float>(L, UUo + (t * 48 + ch) * 4); Hh = a * Hh + uu; A *= a; }
            lds_st<float>(L, SEGo + (sg * 48 + ch) * 4, A); lds_st<float>(L, SEGo + 1536 + (sg * 48 + ch) * 4, Hh); }
        __syncthreads();
        if (tid < 384) { float h = lds_ld<float>(L, CARo + ((ck & 1) * 48 + ch) * 4);
            for (int s2 = 0; s2 < sg; ++s2) h = lds_ld<float>(L, SEGo + (s2 * 48 + ch) * 4) * h + lds_ld<float>(L, SEGo + 1536 + (s2 * 48 + ch) * 4);
#pragma unroll
            for (int i = 0; i < 16; ++i) { const int t = 16 * sg + i; const float a = lds_ld<float>(L, AAo + (t * 48 + ch) * 4), uu = lds_ld<float>(L, UUo + (t * 48 + ch) * 4); h = a * h + uu; lds_st<float>(L, UUo + (t * 48 + ch) * 4, h); }
            if (sg == 7) lds_st<float>(L, CARo + (((ck + 1) & 1) * 48 + ch) * 4, h); }
        __syncthreads();
    }
    if (tid >= 384) lru_output(L, U, b, n, q4, 15 * 128, tid - 384);
}

__device__ __forceinline__ void xattn_item(CP& p, int item, lds_t L, const bool reuse_kv) {
    constexpr int KMo = 0, VMo = 69632;
    int tid_ = threadIdx.x; asm volatile("" : "+v"(tid_)); const int tid = tid_, lane = tid & 63, wid = tid >> 6, fr = lane & 15, fq = lane >> 4;
    const int pp_ = item >> 1, wq_ = pp_ >> 3, pairx_ = (pp_ & 7) * 4 + (wq_ >> 3), b = pairx_ >> 2, hx = pairx_ & 3, qt = (wq_ & 7) * 2 + (item & 1);
    bf16_t* U = (bf16_t*)(p.ws + WS_U); const bf16_t* KV = (const bf16_t*)(p.ws + WS_KVM);
    if (!reuse_kv) {
    __syncthreads();
    for (int e = tid; e < 4096; e += NTHR) { const int key = e >> 4, ch = e & 15; const bf16_t* src = KV + (size_t)(b * 256 + key) * 1024 + hx * 128 + ch * 8;
        lds_st<u32x4>(L, KMo + key * 272 + ch * 16, *(const u32x4*)src); lds_st<u32x4>(L, VMo + key * 288 + ch * 16, *(const u32x4*)(src + 512)); }
    }
    bf16_t* qrow = U + (size_t)(b * SEQ_ + qt * 128 + 16 * wid + fr) * INW + 2 * MIXW + hx * 128;
    bf16x8 Bq[4];
#pragma unroll
    for (int ks = 0; ks < 4; ++ks) Bq[ks] = *(const bf16x8*)(qrow + 32 * ks + 8 * fq);
    if (!reuse_kv) __syncthreads();
    f32x4 S[16];
#pragma unroll
    for (int kt = 0; kt < 16; ++kt) { f32x4 a = (f32x4){0.f, 0.f, 0.f, 0.f};
#pragma unroll
        for (int ks = 0; ks < 4; ++ks) a = MFMA16(lds_ld<bf16x8>(L, KMo + (16 * kt + fr) * 272 + (32 * ks + 8 * fq) * 2), Bq[ks], a);
        S[kt] = a; }
    float mx = -3.0e38f;
#pragma unroll
    for (int kt = 0; kt < 16; ++kt)
#pragma unroll
        for (int j = 0; j < 4; ++j) mx = fmaxf(mx, S[kt][j]);
    mx = fmaxf(mx, __shfl_xor(mx, 16)); mx = fmaxf(mx, __shfl_xor(mx, 32));
    const float sc = 0.08838834764831845f; float lsum = 0.f;
#pragma unroll
    for (int kt = 0; kt < 16; ++kt)
#pragma unroll
        for (int j = 0; j < 4; ++j) { const float e = __expf((S[kt][j] - mx) * sc); S[kt][j] = e; lsum += e; }
    lsum += __shfl_xor(lsum, 16); lsum += __shfl_xor(lsum, 32);
    f32x4 O[8];
#pragma unroll
    for (int dt = 0; dt < 8; ++dt) O[dt] = (f32x4){0.f, 0.f, 0.f, 0.f};
#pragma unroll
    for (int i = 0; i < 8; ++i) { const bf16x8 bp = pack8(S[2 * i], S[2 * i + 1]);
#pragma unroll
        for (int dt = 0; dt < 8; ++dt) { const int o0 = VMo + (32 * i + 4 * fq + (fr >> 2)) * 288 + (16 * dt + 4 * (fr & 3)) * 2;
#ifdef DBG_NOTR
            u32x4 af;
            { unsigned e[8];
#pragma unroll
              for (int j = 0; j < 8; ++j) { const int key = 32 * i + (j < 4 ? 4 * fq + j : 16 + 4 * fq + (j - 4)); e[j] = lds_ld<bf16_t>(L, VMo + key * 288 + (16 * dt + fr) * 2); }
              af.x = e[0] | (e[1] << 16); af.y = e[2] | (e[3] << 16); af.z = e[4] | (e[5] << 16); af.w = e[6] | (e[7] << 16); }
            (void)o0; O[dt] = MFMA16(__builtin_bit_cast(bf16x8, af), bp, O[dt]); } }
#else
            O[dt] = MFMA16(tr_pair(L, o0, o0 + 16 * 288), bp, O[dt]); } }
#endif
    float inv = frcp_(lsum);
#ifdef DBG_IDENT
    { const u32x4 q0 = __builtin_bit_cast(u32x4, Bq[0]);
#pragma unroll
      for (int dt = 0; dt < 8; ++dt) { O[dt][0] = bflo(q0.x) + dt; O[dt][1] = bfhi(q0.x); O[dt][2] = bflo(q0.y); O[dt][3] = bfhi(q0.y); } inv = 1.0f; }
#endif
#pragma unroll
    for (int dt = 0; dt < 8; ++dt) { u32x2 w; w.x = cvt_pk_bf16(O[dt][0] * inv, O[dt][1] * inv); w.y = cvt_pk_bf16(O[dt][2] * inv, O[dt][3] * inv);
        *(u32x2*)(qrow + 16 * dt + 4 * fq) = w; }
}

__device__ __forceinline__ void ml1_item(CP& p, int jl, int item, lds_t L) {
    int tid_ = threadIdx.x; asm volatile("" : "+v"(tid_)); const int tid = tid_, lane = tid & 63, wid = tid >> 6;
    const bf16_t* U = (const bf16_t*)(p.ws + WS_U); bf16_t* QB = (bf16_t*)(p.ws + WS_XC); bf16_t* KB = (bf16_t*)p.out; float* G = (float*)(p.ws + WS_G);
    const int j = tid < 384 ? tid : 0;
    float cw[4][4], cb[4], Wx[4][8], Wm[4][8];
    f32x4 wq4[4], wk4[4];
    { const float* wqp = p.in[24] + ((size_t)jl * 384 + j) * 16; const float* wkp = p.in[25] + ((size_t)jl * 384 + j) * 16;
#pragma unroll
      for (int i = 0; i < 4; ++i) { wq4[i] = *(const f32x4*)(wqp + 4 * i); wk4[i] = *(const f32x4*)(wkp + 4 * i); } }
    {
#pragma unroll
        for (int k = 0; k < 4; ++k)
#pragma unroll
            for (int c = 0; c < 4; ++c) cw[k][c] = p.in[22][(size_t)jl * 4 * MIXW + (size_t)k * MIXW + 4 * j + c];
#pragma unroll
        for (int c = 0; c < 4; ++c) cb[c] = p.in[23][jl * MIXW + 4 * j + c];
        const float* wq = p.in[24] + ((size_t)jl * 384 + j) * 16; const float* wk = p.in[25] + ((size_t)jl * 384 + j) * 16; const float* wv = p.in[26] + ((size_t)jl * 384 + j) * 16;
        const float* Wg = p.in[27] + (size_t)jl * 4608 * 8;
#pragma unroll
        for (int i = 0; i < 4; ++i)
#pragma unroll
            for (int g = 0; g < 8; ++g) { Wx[i][g] = 0.f; Wm[i][g] = 0.f; }
#pragma unroll 1
        for (int o = 0; o < 4; ++o) {
            float gq[8], gk[8], gv[8];
#pragma unroll
            for (int g = 0; g < 8; ++g) { gq[g] = Wg[(size_t)(4 * j + o) * 8 + g]; gk[g] = Wg[(size_t)(MIXW + 4 * j + o) * 8 + g]; gv[g] = Wg[(size_t)(2 * MIXW + 4 * j + o) * 8 + g]; }
#pragma unroll
            for (int i = 0; i < 4; ++i) { const float a = wq[i * 4 + o], bk = wk[i * 4 + o], cv = wv[i * 4 + o];
#pragma unroll
                for (int g = 0; g < 8; ++g) { Wx[i][g] += a * gq[g] + bk * gk[g]; Wm[i][g] += cv * gv[g]; } } }
    }
    const int r0 = item * 64, tm0 = r0 % SEQ_;
    float x3[4], x2[4], x1[4], x0[4];
    auto ldx = [&](int row, float* x) { const u32x2 raw = *(const u32x2*)(U + (size_t)row * INW + 4 * j); x[0] = bflo(raw.x); x[1] = bfhi(raw.x); x[2] = bflo(raw.y); x[3] = bfhi(raw.y); };
#pragma unroll
    for (int c = 0; c < 4; ++c) { x3[c] = 0.f; x2[c] = 0.f; x1[c] = 0.f; }
    if (tm0 > 0) { ldx(r0 - 3, x3); ldx(r0 - 2, x2); ldx(r0 - 1, x1); }
    for (int tb = 0; tb < 8; ++tb) {
        __syncthreads();
        if (tid < 384) {
            u32x2 xraw[8];
#pragma unroll
            for (int tt = 0; tt < 8; ++tt) xraw[tt] = *(const u32x2*)(U + (size_t)(r0 + tb * 8 + tt) * INW + 4 * j);
#pragma unroll
            for (int tt = 0; tt < 8; ++tt) { const int row = r0 + tb * 8 + tt; x0[0] = bflo(xraw[tt].x); x0[1] = bfhi(xraw[tt].x); x0[2] = bflo(xraw[tt].y); x0[3] = bfhi(xraw[tt].y); float xc[4];
#pragma unroll
                for (int c = 0; c < 4; ++c) xc[c] = siluf_(cb[c] + cw[0][c] * x3[c] + cw[1][c] * x2[c] + cw[2][c] * x1[c] + cw[3][c] * x0[c]);
                { const f32x4 q = wq4[0] * xc[0] + wq4[1] * xc[1] + wq4[2] * xc[2] + wq4[3] * xc[3];
                  const f32x4 k = (wk4[0] * xc[0] + wk4[1] * xc[1] + wk4[2] * xc[2] + wk4[3] * xc[3]) * 0.05103103630798288f;
                  u32x2 w; w.x = cvt_pk_bf16(q[0], q[1]); w.y = cvt_pk_bf16(q[2], q[3]); *(u32x2*)(QB + (size_t)row * MIXW + 4 * j) = w;
                  w.x = cvt_pk_bf16(k[0], k[1]); w.y = cvt_pk_bf16(k[2], k[3]); *(u32x2*)(KB + (size_t)row * MIXW + 4 * j) = w; }
#pragma unroll
                for (int g = 0; g < 8; ++g) { float s = 0.f;
#pragma unroll
                    for (int i = 0; i < 4; ++i) s += xc[i] * Wx[i][g] + x0[i] * Wm[i][g];
                    lds_st<float>(L, ((tt * 8 + g) * 388 + tid) * 4, s); }
#pragma unroll
                for (int c = 0; c < 4; ++c) { x3[c] = x2[c]; x2[c] = x1[c]; x1[c] = x0[c]; } }
        }
        __syncthreads();
        {
            const int row = tid >> 3, part = tid & 7; float s = 0.f;
#pragma unroll
            for (int i = 0; i < 12; ++i) { const f32x4 v = lds_ld<f32x4>(L, (row * 388 + part * 48 + 4 * i) * 4); s += (v[0] + v[1]) + (v[2] + v[3]); }
            s += __shfl_xor(s, 1); s += __shfl_xor(s, 2); s += __shfl_xor(s, 4);
            if (part == 0) { const int g = row & 7; const float v = s + p.in[28][jl * 8 + g]; G[(size_t)(r0 + tb * 8 + (row >> 3)) * 8 + g] = g < 4 ? v : -softplusf_(-v); }
        }
    }
}

__device__ __forceinline__ void ml2_item(CP& p, int jl, int item, lds_t L) {
    constexpr int QIo = 0, KIo = 50176, VIo = 100352, PTo = 109568, WQKo = 118784, WVo = 131072, SCo = 132096, NSo = 134144, OXo = 0;
    constexpr int IBo = SCo, MTo = SCo + 256, WIo = SCo + 512, EMo = SCo + 768, WSo = SCo + 1024, DNo = SCo + 1280, NQo = SCo + 1536, MIo = SCo + 1792;
    int tid_ = threadIdx.x; asm volatile("" : "+v"(tid_)); const int tid = tid_, lane = tid & 63, wid = tid >> 6, fr = lane & 15, fq = lane >> 4;
    const int slot_ = item >> 3, pair_ = (item & 7) * 4 + slot_ / 6, b = pair_ >> 2, hh = pair_ & 3, vb = slot_ % 6;
    const int vt = wid & 3, kh = wid >> 2;
    const bf16_t* U = (const bf16_t*)(p.ws + WS_U); const bf16_t* QB = (const bf16_t*)(p.ws + WS_XC); const bf16_t* KB = (const bf16_t*)p.out; const float* G = (const float*)(p.ws + WS_G); bf16_t* HO = (bf16_t*)(p.ws + WS_HOUT);
    __syncthreads();
    if (tid < 256) lds_st<float>(L, WVo + tid * 4, p.in[26][((size_t)jl * 384 + hh * 96 + vb * 16 + (tid >> 4)) * 16 + (tid & 15)]);
    if (tid < 384) lds_st<float>(L, NSo + tid * 4, 0.f);
    f32x4 CT[12];
#pragma unroll
    for (int i = 0; i < 12; ++i) CT[i] = (f32x4){0.f, 0.f, 0.f, 0.f};
    float m_cur = 0.f;
    const int cg = tid % 48, rg = (tid / 48) & 7;
    u32x4 pre[8]; float pli = 0.f, plf = 0.f;
    if (tid < 384) {
#pragma unroll
        for (int it = 0; it < 4; ++it) { pre[it] = *(const u32x4*)(QB + (size_t)(b * SEQ_ + rg * 8 + it) * MIXW + hh * 384 + 8 * cg); pre[4 + it] = *(const u32x4*)(KB + (size_t)(b * SEQ_ + rg * 8 + it) * MIXW + hh * 384 + 8 * cg); }
    } else {
#pragma unroll
        for (int it = 0; it < 4; ++it) { const int e = (tid - 384) + 128 * it; pre[it] = *(const u32x4*)(U + (size_t)(b * SEQ_ + (e >> 3)) * INW + hh * 384 + vb * 64 + 8 * (e & 7)); }
    }
    if (wid == 0) { pli = G[(size_t)(b * SEQ_ + lane) * 8 + hh]; plf = G[(size_t)(b * SEQ_ + lane) * 8 + 4 + hh]; }
    for (int c = 0; c < 32; ++c) {
        const int r0 = b * SEQ_ + 64 * c;
        __syncthreads();
        if (wid == 0) {
            const float li = pli, lf = plf;
            float bc = lf;
#pragma unroll
            for (int d = 1; d < 64; d <<= 1) { const float v = __shfl_up(bc, d); if (lane >= d) bc += v; }
            const float ib = li - bc; float pm = ib;
#pragma unroll
            for (int d = 1; d < 64; d <<= 1) { const float v = __shfl_up(pm, d); if (lane >= d) pm = fmaxf(pm, v); }
            const float Mt = fmaxf(m_cur, pm), M63 = __shfl(Mt, 63), bl = __shfl(bc, 63);
            lds_st<float>(L, IBo + lane * 4, ib); lds_st<float>(L, MTo + lane * 4, Mt); lds_st<float>(L, WIo + lane * 4, __expf(m_cur - Mt)); lds_st<float>(L, EMo + lane * 4, __expf(-(bc + Mt)));
            lds_st<float>(L, WSo + lane * 4, __expf(ib - M63)); lds_st<float>(L, DNo + lane * 4, 0.f);
            if (lane == 0) { lds_st<float>(L, MIo, __expf(m_cur - M63)); lds_st<float>(L, MIo + 4, bl + M63); }
        }
        if (tid < 384) {
            u32x4 lq[4], lk[4];
#pragma unroll
            for (int it = 0; it < 4; ++it) { lq[it] = *(const u32x4*)(QB + (size_t)(r0 + rg * 8 + 4 + it) * MIXW + hh * 384 + 8 * cg); lk[it] = *(const u32x4*)(KB + (size_t)(r0 + rg * 8 + 4 + it) * MIXW + hh * 384 + 8 * cg); }
#pragma unroll
            for (int it = 0; it < 8; ++it) { const int t = rg * 8 + it;
                lds_st<u32x4>(L, QIo + t * 784 + cg * 16, it < 4 ? pre[it] : lq[it - 4]); lds_st<u32x4>(L, KIo + t * 784 + cg * 16, it < 4 ? pre[4 + it] : lk[it - 4]); }
        } else {
#pragma unroll
            for (int it = 0; it < 4; ++it) { const int e = (tid - 384) + 128 * it, t = e >> 3, cp = e & 7; const u32x4 raw = pre[it];
                const float x[8] = {bflo(raw.x), bfhi(raw.x), bflo(raw.y), bfhi(raw.y), bflo(raw.z), bfhi(raw.z), bflo(raw.w), bfhi(raw.w)};
                f32x4 av0 = lds_ld<f32x4>(L, WVo + (2 * cp) * 64) * x[0], av1 = lds_ld<f32x4>(L, WVo + (2 * cp + 1) * 64) * x[4];
#pragma unroll
                for (int i = 1; i < 4; ++i) { av0 = av0 + lds_ld<f32x4>(L, WVo + (2 * cp) * 64 + i * 16) * x[i]; av1 = av1 + lds_ld<f32x4>(L, WVo + (2 * cp + 1) * 64 + i * 16) * x[4 + i]; }
                lds_st<bf16x8>(L, VIo + t * 144 + cp * 16, pack8(av0, av1)); }
        }
        __syncthreads();
        const float decay = lds_ld<float>(L, MIo), m_new = lds_ld<float>(L, MIo + 4);
        {
            const int tt = wid & 3, hf = wid >> 2;
            f32x4 s0 = (f32x4){0.f, 0.f, 0.f, 0.f}, s1 = s0;
            const bool do0 = (2 * hf) <= tt, do1 = (2 * hf + 1) <= tt;
            if (do0) {
#pragma unroll
                for (int ks = 0; ks < 12; ++ks) { const bf16x8 bq = lds_ld<bf16x8>(L, QIo + (16 * tt + fr) * 784 + (32 * ks + 8 * fq) * 2);
                    s0 = MFMA16(lds_ld<bf16x8>(L, KIo + (32 * hf + fr) * 784 + (32 * ks + 8 * fq) * 2), bq, s0);
                    if (do1) s1 = MFMA16(lds_ld<bf16x8>(L, KIo + (32 * hf + 16 + fr) * 784 + (32 * ks + 8 * fq) * 2), bq, s1);
                    if ((ks & 3) == 3) __builtin_amdgcn_sched_barrier(0); } }
            const int t = 16 * tt + fr; const float Mt = lds_ld<float>(L, MTo + t * 4); float psum = 0.f;
#pragma unroll
            for (int sti = 0; sti < 2; ++sti) { const int sb = 32 * hf + 16 * sti + 4 * fq; const f32x4 ibv = lds_ld<f32x4>(L, IBo + sb * 4); f32x4 sv = sti ? s1 : s0; float pv[4];
#pragma unroll
                for (int rg = 0; rg < 4; ++rg) { const int s = sb + rg; pv[rg] = (s <= t) ? sv[rg] * __expf(ibv[rg] - Mt) : 0.f; psum += pv[rg]; }
                u32x2 w; w.x = cvt_pk_bf16(pv[0], pv[1]); w.y = cvt_pk_bf16(pv[2], pv[3]); lds_st<u32x2>(L, PTo + t * 144 + sb * 2, w); }
            psum += __shfl_xor(psum, 16); psum += __shfl_xor(psum, 32);
            if (fq == 0) __hip_atomic_fetch_add((LAS float*)(L + DNo + t * 4), psum, __ATOMIC_RELAXED, __HIP_MEMORY_SCOPE_WORKGROUP);
        }
        f32x4 ao[4];
#pragma unroll
        for (int i = 0; i < 4; ++i) ao[i] = (f32x4){0.f, 0.f, 0.f, 0.f};
#pragma unroll
        for (int i = 0; i < 6; ++i) { const bf16x8 af = pack8(CT[2 * i], CT[2 * i + 1]);
#pragma unroll
            for (int t2 = 0; t2 < 4; ++t2) { const int qo = QIo + (16 * t2 + fr) * 784 + (192 * kh + 32 * i + 4 * fq) * 2;
                const s16x4 lo = lds_ld<s16x4>(L, qo), hi = lds_ld<s16x4>(L, qo + 32);
                ao[t2] = MFMA16(af, __builtin_shufflevector(lo, hi, 0, 1, 2, 3, 4, 5, 6, 7), ao[t2]); }
            __builtin_amdgcn_sched_barrier(0); }
#pragma unroll
        for (int t2 = 0; t2 < 4; ++t2) { const float wi = lds_ld<float>(L, WIo + (16 * t2 + fr) * 4); ao[t2] = ao[t2] * wi; }
        {
            const int t = tid >> 3, part = tid & 7; float s = 0.f;
#pragma unroll
            for (int i = 0; i < 6; ++i) { const u32x4 raw = lds_ld<u32x4>(L, QIo + t * 784 + part * 96 + i * 16);
                const f32x4 n0 = lds_ld<f32x4>(L, NSo + (part * 48 + i * 8) * 4), n1 = lds_ld<f32x4>(L, NSo + (part * 48 + i * 8 + 4) * 4);
                s += bflo(raw.x) * n0[0] + bfhi(raw.x) * n0[1] + bflo(raw.y) * n0[2] + bfhi(raw.y) * n0[3] + bflo(raw.z) * n1[0] + bfhi(raw.z) * n1[1] + bflo(raw.w) * n1[2] + bfhi(raw.w) * n1[3]; }
            s += __shfl_xor(s, 1); s += __shfl_xor(s, 2); s += __shfl_xor(s, 4);
            if (part == 0) lds_st<float>(L, NQo + t * 4, s);
        }
        __syncthreads();
        if (c + 1 < 32) {
            if (tid < 384) {
#pragma unroll
                for (int it = 0; it < 4; ++it) { pre[it] = *(const u32x4*)(QB + (size_t)(r0 + 64 + rg * 8 + it) * MIXW + hh * 384 + 8 * cg); pre[4 + it] = *(const u32x4*)(KB + (size_t)(r0 + 64 + rg * 8 + it) * MIXW + hh * 384 + 8 * cg); }
            } else {
#pragma unroll
                for (int it = 0; it < 4; ++it) { const int e = (tid - 384) + 128 * it; pre[it] = *(const u32x4*)(U + (size_t)(r0 + 64 + (e >> 3)) * INW + hh * 384 + vb * 64 + 8 * (e & 7)); }
            }
            if (wid == 0) { pli = G[(size_t)(r0 + 64 + lane) * 8 + hh]; plf = G[(size_t)(r0 + 64 + lane) * 8 + 4 + hh]; }
        }
        {
            const int o0 = VIo + (32 * kh + 8 * fq + (fr >> 2)) * 144 + (16 * vt + 4 * (fr & 3)) * 2;
            const bf16x8 av = tr_pair(L, o0, o0 + 4 * 144);
#pragma unroll
            for (int t2 = 0; t2 < 4; ++t2) ao[t2] = MFMA16(av, lds_ld<bf16x8>(L, PTo + (16 * t2 + fr) * 144 + (32 * kh + 8 * fq) * 2), ao[t2]);
        }
        if (kh == 1) {
#pragma unroll
            for (int t2 = 0; t2 < 4; ++t2)
#pragma unroll
                for (int rg = 0; rg < 4; ++rg) lds_st<float>(L, OXo + ((vt * 16 + 4 * fq + rg) * 64 + 16 * t2 + fr) * 4, ao[t2][rg]);
        }
        {
            bf16x8 bv[2];
#pragma unroll
            for (int ks = 0; ks < 2; ++ks) { const int o0 = VIo + (32 * ks + 8 * fq + (fr >> 2)) * 144 + (16 * vt + 4 * (fr & 3)) * 2;
                const bf16x8 raw = tr_pair(L, o0, o0 + 4 * 144); const u32x4 rw = __builtin_bit_cast(u32x4, raw);
                const f32x4 w0 = lds_ld<f32x4>(L, WSo + (32 * ks + 8 * fq) * 4), w1 = lds_ld<f32x4>(L, WSo + (32 * ks + 8 * fq + 4) * 4);
                u32x4 o; o.x = cvt_pk_bf16(bflo(rw.x) * w0[0], bfhi(rw.x) * w0[1]); o.y = cvt_pk_bf16(bflo(rw.y) * w0[2], bfhi(rw.y) * w0[3]);
                o.z = cvt_pk_bf16(bflo(rw.z) * w1[0], bfhi(rw.z) * w1[1]); o.w = cvt_pk_bf16(bflo(rw.w) * w1[2], bfhi(rw.w) * w1[3]);
                bv[ks] = __builtin_bit_cast(bf16x8, o); }
#pragma unroll
            for (int kt = 0; kt < 12; ++kt) { f32x4 a = CT[kt] * decay;
#pragma unroll
                for (int ks = 0; ks < 2; ++ks) { const int o0 = KIo + (32 * ks + 8 * fq + (fr >> 2)) * 784 + (192 * kh + 16 * kt + 4 * (fr & 3)) * 2;
                    a = MFMA16(tr_pair(L, o0, o0 + 4 * 784), bv[ks], a); }
                CT[kt] = a; if ((kt & 1) == 1) __builtin_amdgcn_sched_barrier(0); }
        }
        if (tid < 192) { float n0 = decay * lds_ld<float>(L, NSo + tid * 8), n1 = decay * lds_ld<float>(L, NSo + tid * 8 + 4);
#pragma unroll 4
            for (int s4 = 0; s4 < 16; ++s4) { const f32x4 w4 = lds_ld<f32x4>(L, WSo + s4 * 16);
#pragma unroll
                for (int j = 0; j < 4; ++j) { const unsigned kk = lds_ld<unsigned>(L, KIo + (4 * s4 + j) * 784 + tid * 4); n0 += w4[j] * bflo(kk); n1 += w4[j] * bfhi(kk); } }
            lds_st<float>(L, NSo + tid * 8, n0); lds_st<float>(L, NSo + tid * 8 + 4, n1); }
        __syncthreads();
        if (kh == 0) {
#pragma unroll
            for (int t2 = 0; t2 < 4; ++t2) { const int t = 16 * t2 + fr;
                const float dn = fmaxf(fabsf(lds_ld<float>(L, DNo + t * 4) + lds_ld<float>(L, WIo + t * 4) * lds_ld<float>(L, NQo + t * 4)), lds_ld<float>(L, EMo + t * 4));
                const float inv = frcp_(dn); float hv[4];
#pragma unroll
                for (int rg = 0; rg < 4; ++rg) hv[rg] = (ao[t2][rg] + lds_ld<float>(L, OXo + ((vt * 16 + 4 * fq + rg) * 64 + t) * 4)) * inv;
                u32x2 w; w.x = cvt_pk_bf16(hv[0], hv[1]); w.y = cvt_pk_bf16(hv[2], hv[3]);
                *(u32x2*)(HO + (size_t)(r0 + t) * MIXW + hh * 384 + vb * 64 + 16 * vt + 4 * fq) = w; }
        }
        m_cur = m_new;
    }
}

__device__ __forceinline__ void phase_ml3(CP& p, int jl) {
    int tid_ = threadIdx.x; asm volatile("" : "+v"(tid_)); const int tid = tid_, lane = tid & 63, wid = tid >> 6;
    bf16_t* U = (bf16_t*)(p.ws + WS_U); const bf16_t* HO = (const bf16_t*)(p.ws + WS_HOUT);
    const int gw = blockIdx.x * 8 + wid, nw = gridDim.x * 8, hh = gw & 3;
    float lg[6], sk[6], cw[4][6], cb[6];
#pragma unroll
    for (int i = 0; i < 3; ++i) { const int c = jl * MIXW + hh * 384 + 128 * i + 2 * lane; lg[2 * i] = p.in[29][c]; lg[2 * i + 1] = p.in[29][c + 1]; sk[2 * i] = p.in[30][c]; sk[2 * i + 1] = p.in[30][c + 1];
        cb[2 * i] = p.in[23][c]; cb[2 * i + 1] = p.in[23][c + 1];
#pragma unroll
        for (int k = 0; k < 4; ++k) { cw[k][2 * i] = p.in[22][(size_t)jl * 4 * MIXW + (size_t)k * MIXW + hh * 384 + 128 * i + 2 * lane]; cw[k][2 * i + 1] = p.in[22][(size_t)jl * 4 * MIXW + (size_t)k * MIXW + hh * 384 + 128 * i + 2 * lane + 1]; } }
    for (int rb = (gw >> 2) * 4; rb < T_; rb += (nw >> 2) * 4) {
        unsigned hr[4][3], gr[4][3], mr[7][3];
        const int tm = rb % SEQ_;
#pragma unroll
        for (int r = 0; r < 4; ++r)
#pragma unroll
            for (int i = 0; i < 3; ++i) { const int c = hh * 384 + 128 * i + 2 * lane; const size_t row = (size_t)(rb + r);
                hr[r][i] = *(const unsigned*)(HO + row * MIXW + c); gr[r][i] = *(const unsigned*)(U + row * INW + MIXW + c); }
#pragma unroll
        for (int q = 0; q < 7; ++q)
#pragma unroll
            for (int i = 0; i < 3; ++i) { const int c = hh * 384 + 128 * i + 2 * lane;
                mr[q][i] = (tm + q - 3 >= 0) ? *(const unsigned*)(U + (size_t)(rb + q - 3) * INW + c) : 0u; }
#pragma unroll
        for (int r = 0; r < 4; ++r) { float h[6]; float s = 0.f;
#pragma unroll
            for (int i = 0; i < 3; ++i) { h[2 * i] = bflo(hr[r][i]); h[2 * i + 1] = bfhi(hr[r][i]); s += h[2 * i] + h[2 * i + 1]; }
            const float mu = wave_sum(s) * (1.0f / 384.0f); float v2 = 0.f;
#pragma unroll
            for (int i = 0; i < 6; ++i) { h[i] -= mu; v2 += h[i] * h[i]; }
            const float rstd = rsqrtf(wave_sum(v2) * (1.0f / 384.0f) + EPS_);
#pragma unroll
            for (int i = 0; i < 3; ++i) { const int c = hh * 384 + 128 * i + 2 * lane;
                float x0 = cb[2 * i], x1 = cb[2 * i + 1];
#pragma unroll
                for (int k = 0; k < 4; ++k) { x0 += cw[k][2 * i] * bflo(mr[r + k][i]); x1 += cw[k][2 * i + 1] * bfhi(mr[r + k][i]); }
                x0 = siluf_(x0); x1 = siluf_(x1);
                const float y0 = (h[2 * i] * rstd * lg[2 * i] + sk[2 * i] * x0) * siluf_(bflo(gr[r][i]));
                const float y1 = (h[2 * i + 1] * rstd * lg[2 * i + 1] + sk[2 * i + 1] * x1) * siluf_(bfhi(gr[r][i]));
                *(unsigned*)(U + (size_t)(rb + r) * INW + MIXW + c) = cvt_pk_bf16(y0, y1); } }
    }
}

__device__ __forceinline__ void phase_final(CP& p) {
    int tid_ = threadIdx.x; asm volatile("" : "+v"(tid_)); const int tid = tid_, lane = tid & 63, wid = tid >> 6; float* out = p.out; const float* g = p.in[31]; const bf16_t* HB = (const bf16_t*)(p.ws + WS_HB);
    for (int row = blockIdx.x * 8 + wid; row < T_; row += gridDim.x * 8) { float v[16]; float s2 = 0.f;
#pragma unroll
        for (int i = 0; i < 2; ++i) { const u32x4 hw = *(const u32x4*)(HB + (size_t)row * D_ + i * 512 + lane * 8);
            v[8 * i + 0] = bflo(hw.x); v[8 * i + 1] = bfhi(hw.x); v[8 * i + 2] = bflo(hw.y); v[8 * i + 3] = bfhi(hw.y); v[8 * i + 4] = bflo(hw.z); v[8 * i + 5] = bfhi(hw.z); v[8 * i + 6] = bflo(hw.w); v[8 * i + 7] = bfhi(hw.w); }
#pragma unroll
        for (int i = 0; i < 16; ++i) s2 += v[i] * v[i];
        const float rs = rsqrtf(wave_sum(s2) * (1.0f / 1024.0f) + EPS_);
#pragma unroll
        for (int i = 0; i < 2; ++i) { const int c = i * 512 + lane * 8; const f32x4 g0 = *(const f32x4*)(g + c), g1 = *(const f32x4*)(g + c + 4);
            *(f32x4*)(out + (size_t)row * D_ + c) = (f32x4){v[8 * i] * rs * g0[0], v[8 * i + 1] * rs * g0[1], v[8 * i + 2] * rs * g0[2], v[8 * i + 3] * rs * g0[3]};
            *(f32x4*)(out + (size_t)row * D_ + c + 4) = (f32x4){v[8 * i + 4] * rs * g1[0], v[8 * i + 5] * rs * g1[1], v[8 * i + 6] * rs * g1[2], v[8 * i + 7] * rs * g1[3]}; } }
}

constexpr int MK_PRO = 1, MK_GEMM = 2, MK_LRU = 4, MK_XA = 8, MK_ML1 = 16, MK_ML2 = 32, MK_ML3 = 64, MK_FIN = 128, MK_ALL = 255;
template <int MASK>
__global__ void __launch_bounds__(NTHR, 2) mega(P p_arg) {
    extern __shared__ __attribute__((aligned(16))) unsigned char shm[];
    lds_t L = (lds_t)shm;
    cg::grid_group grid = cg::this_grid();
    CP* kp0 = (CP*)__builtin_amdgcn_kernarg_segment_ptr();
    const int G = (int)gridDim.x, bid = (int)blockIdx.x;
    const int ph_lo = p_arg.ph_lo, ph_hi = p_arg.ph_hi, coop = p_arg.coop, sub = p_arg.pad;
    __builtin_amdgcn_fence(__ATOMIC_ACQUIRE, "agent");
    if (threadIdx.x < 4) *(volatile LAS unsigned*)(L + LDS_BYTES - 16 + 4 * threadIdx.x) = 0u;
    __syncthreads();
    XcdBarrier xbar = xcd_barrier_post((unsigned*)(p_arg.ws + WS_BAR), (volatile LAS unsigned*)(L + LDS_BYTES - 16));
    for (int ph = ph_lo; ph < ph_hi; ++ph) {
        CP* kp = kp0; asm volatile("" : "+s"(kp)); CP& p = *kp; unsigned char* ws = p.ws;
        int type, l = 0;
        if (ph == 0) type = 0; else if (ph == 33) type = 11;
        else { const int q = ph - 1, pr = q >> 4, r = q & 15;
            if (r < 7) { l = 2 * pr; type = r < 3 ? r + 1 : (r == 3 ? 4 : r + 4); }
            else { l = 2 * pr + 1; const int r2 = r - 7; type = r2 < 3 ? r2 + 1 : r2 + 2; } }
        const unsigned char* wb = ws + WS_WB + (size_t)l * WL_LAYER; const int jl = l >> 1;
        float* SS = (float*)(ws + WS_SS); bf16_t* HB = (bf16_t*)(ws + WS_HB); bf16_t* U = (bf16_t*)(ws + WS_U);
#ifdef PROBE_REP_TYPES
        const int nrep = ((PROBE_REP_TYPES >> type) & 1) ? 2 : 1;
#else
        const int nrep = 1;
#endif
        for (int rep = 0; rep < nrep; ++rep) {
        if (type == 0) { if constexpr ((MASK & MK_PRO) != 0) phase_prologue(p, L); }
        else {
        const bool split = (l == 3) && coop && G == 256;
        const int tbase = (l + 1) * 5888;
        const bool gemm_now = (type == 1 || type == 9 || type == 2 || type == 8 || type == 10 || type == 3) || (type == 6 && split && bid >= 192);
        if (gemm_now) {
            if constexpr ((MASK & MK_GEMM) != 0) {
            const int npass = ((type == 3 && !split) || (type == 1 && split)) ? 2 : 1;
            for (int pass = 0; pass < npass; ++pass) {
                pg8::Gemm g; pg8::EpiAll E; int c = bid, Ge = G, sf = 1 << 30, sl = 0;
                g.M = T_; g.N = 1024; g.K = 1024; g.lda = 1024; g.A = HB; E.O = U; E.ldc = INW; E.H = p.out; E.ssn = SS; E.ss = SS;
                const bool kvpass = (type == 3 && !split && pass == 0) || (type == 1 && split && pass == 1);
                if (kvpass) { E.mode = 1; g.A = (const bf16_t*)(ws + WS_MEMB); g.Bt = (const bf16_t*)(wb + WL_KV); g.M = MEMT; E.O = (bf16_t*)(ws + WS_KVM); E.ldc = 1024; E.ss = (const float*)(ws + WS_SSM);
                    if (type == 1) c = bid >= 128 ? bid - 128 : (1 << 20); }
                else if (type == 1 || type == 9) { g.Bt = (const bf16_t*)(wb + (type == 1 ? WL_GU1 : WL_GU2)); g.N = 5632; E.mode = 0; }
                else if (type == 3) { E.mode = 1; g.Bt = (const bf16_t*)(wb + WL_IN);
                    if (split) { g.N = 2048; sf = 6; sl = 6; }
                    else { g.N = INW; c = (bid + (G / 16) * 8) % G; } }
                else if (type == 6) { E.mode = 1; g.Bt = (const bf16_t*)(wb + WL_IN); g.N = 1536; sf = 0; sl = 6; Ge = 64; c = bid - 192; }
                else { E.mode = 2; E.O = HB; E.ssn = SS;
                    if (type == 8) { g.A = U + MIXW; g.Bt = (const bf16_t*)(wb + WL_OUT); g.K = OUTW; g.lda = INW; }
                    else { g.A = U; g.Bt = (const bf16_t*)(wb + (type == 2 ? WL_D1 : WL_D2)); g.K = FF_; g.lda = FF_; } }
                pg8::StaticOrder S; S.init(g.M, g.N, Ge, c); S.sf = sf; S.sl = sl; pg8::gemm_phase(L, g, S, E);
            }
            if constexpr ((MASK & MK_PRO) != 0) {
                if (l < 3 && G == 256) {
                    if (type == 1 && bid >= 128) transpose_range(p, L, tbase + (bid - 128), tbase + 2200, 128);
                    else if (type == 3 && bid >= 32 && bid < 128) transpose_range(p, L, tbase + 2200 + (bid - 32), tbase + 3688, 96);
                    else if (type == 9 && bid >= 128) transpose_range(p, L, tbase + 3688 + (bid - 128), tbase + 5888, 128);
                } else if (l < 3 && type == 9) transpose_range(p, L, tbase + bid, tbase + 5888, G);
            } }
        }
        if (type == 4) {

            if constexpr ((MASK & MK_LRU) != 0) { if (sub != 2) for (int it = bid; it < 256; it += G) lru_item(p, jl, it, L); }
            if constexpr ((MASK & MK_XA) != 0) { if (sub != 1) { for (int it = bid; it < 256; it += G) { xattn_item(p, 2 * it, L, false); xattn_item(p, 2 * it + 1, L, true); }
#ifdef DBG_THRASH
                { const u32x4* src = (const u32x4*)(ws + WS_WB) + (size_t)bid * 131072; unsigned acc = 0;
                  for (int i = threadIdx.x; i < 131072; i += NTHR) { const u32x4 v = src[i]; acc ^= v.x ^ v.y ^ v.z ^ v.w; }
                  if (acc == 0x12345u) ((unsigned*)(ws + WS_G))[0] = acc; }
#endif
            } }
        } else if (type == 5) { if constexpr ((MASK & MK_ML1) != 0) for (int it = bid; it < 256; it += G) ml1_item(p, jl, it, L); }
        else if (type == 6) {
            if (sub == 0 && G > 192) {
                if (bid < 192) { if constexpr ((MASK & MK_ML2) != 0) for (int r2_ = 0; r2_ < PROBE_ML2_REP; ++r2_) ml2_item(p, jl, bid, L); }
                else { if constexpr ((MASK & MK_XA) != 0) for (int it = bid - 192; it < 256; it += G - 192) { xattn_item(p, 2 * it, L, false); xattn_item(p, 2 * it + 1, L, true); }
                }
            } else {
                if constexpr ((MASK & MK_ML2) != 0) { if (sub != 2) for (int it = bid; it < 192; it += G) ml2_item(p, jl, it, L); }
                if constexpr ((MASK & MK_XA) != 0) { if (sub != 1) for (int it = bid; it < 256; it += G) { xattn_item(p, 2 * it, L, false); xattn_item(p, 2 * it + 1, L, true); } }
            }
        } else if (type == 7) { if constexpr ((MASK & MK_ML3) != 0) phase_ml3(p, jl); }
        else if (type == 11) { if constexpr ((MASK & MK_FIN) != 0) phase_final(p); }
        }
        }
#ifdef PROBE_XSYNC
        if (coop) for (int xs = 0; xs < PROBE_XSYNC; ++xs) grid.sync();
#endif
        if (coop && ph + 1 < ph_hi) {
            if (coop == 2) grid.sync();
            else xcd_barrier(xbar);
        }
    }
    __builtin_amdgcn_fence(__ATOMIC_RELEASE, "agent");
}
constexpr int NPH = 1 + 4 * 7 + 2 * 2 + 1;

#define DBG_NOXA 0
#define DBG_NOLRU 0
#define DBG_SKIP 0x0
#ifndef MK_LAUNCHES
#define MK_LAUNCHES 1
#endif

template <int MASK> static bool prep(int& per_cu) {
    if (hipFuncSetAttribute((const void*)mega<MASK>, hipFuncAttributeMaxDynamicSharedMemorySize, LDS_BYTES) != hipSuccess) { fprintf(stderr, "kernel_launch: hipFuncSetAttribute failed (mask %d)\n", MASK); return false; }
    if (hipOccupancyMaxActiveBlocksPerMultiprocessor(&per_cu, (const void*)mega<MASK>, NTHR, LDS_BYTES) != hipSuccess || per_cu < 1) { fprintf(stderr, "kernel_launch: occupancy query says %d (mask %d)\n", per_cu, MASK); per_cu = 1; }
    (void)hipGetLastError();
    return true;
}
template <int MASK> static void launch1(const P& p, int grid, hipStream_t stream) { hipLaunchKernelGGL(mega<MASK>, dim3(grid), dim3(NTHR), LDS_BYTES, stream, p); }

extern "C" void kernel_launch(void* const* d_in, const int* in_sizes, int n_in, void* d_out, int out_size, void* d_ws, size_t ws_size, hipStream_t stream) {
    static int grid = 0;
    if (grid == 0) {
        if (n_in != 32 || out_size != T_ * D_ || ws_size < WS_END) { fprintf(stderr, "kernel_launch: unexpected shapes (n_in %d out %d ws %zu need %zu)\n", n_in, out_size, ws_size, (size_t)WS_END); grid = -1; return; }
        int dev = 0, cus = 0, per_cu = 0;
        (void)hipGetDevice(&dev); (void)hipDeviceGetAttribute(&cus, hipDeviceAttributeMultiprocessorCount, dev);
        bool ok = true;
#if MK_LAUNCHES == 1
        ok = prep<MK_ALL>(per_cu);
#else
        ok = prep<MK_PRO>(per_cu) && prep<MK_GEMM>(per_cu) && prep<MK_LRU>(per_cu) && prep<MK_XA>(per_cu) && prep<MK_ML1>(per_cu) && prep<MK_ML2>(per_cu) && prep<MK_ML3>(per_cu) && prep<MK_FIN>(per_cu);
#endif
        if (!ok) { grid = -1; return; }
        grid = cus > 0 ? cus : 256;
    }
    if (grid < 0) return;
    P p{};
    for (int i = 0; i < 32; ++i) p.in[i] = (const float*)d_in[i];
    p.out = (float*)d_out; p.ws = (unsigned char*)d_ws;
#if MK_LAUNCHES == 1
    p.ph_lo = 0; p.ph_hi = NPH; p.coop = 1; p.pad = 0;
    (void)hipMemsetAsync((unsigned char*)d_ws + WS_BAR, 0, XCD_BAR_WORDS * 4, stream);
    void* args[] = {&p};
    hipError_t e = hipLaunchCooperativeKernel((const void*)mega<MK_ALL>, dim3(grid), dim3(NTHR), args, LDS_BYTES, stream);
    if (e != hipSuccess) fprintf(stderr, "cooperative launch failed: %s (grid %d)\n", hipGetErrorString(e), grid);
#else
    for (int i = 0; i < NPH; ++i) { p.ph_lo = i; p.ph_hi = i + 1; p.coop = 0; p.pad = 0;
        int type;
        if (i == 0) type = 0; else if (i == 33) type = 11; else { const int q = i - 1, r = q & 15; if (r < 7) type = r < 3 ? r + 1 : (r == 3 ? 4 : r + 4); else { const int r2 = r - 7; type = r2 < 3 ? r2 + 1 : r2 + 2; } }
        if (type == 0) launch1<MK_PRO>(p, grid, stream);
#ifdef DBG_SKIP
        else if (((DBG_SKIP >> type) & 1) != 0) {}
#endif
        else if (type == 4) { p.pad = 1; if (!DBG_NOLRU) launch1<MK_LRU>(p, grid, stream); p.pad = 2; if (!DBG_NOXA) launch1<MK_XA>(p, grid, stream); }
        else if (type == 5) launch1<MK_ML1>(p, grid, stream);
        else if (type == 6) { p.pad = 1; launch1<MK_ML2>(p, grid, stream); p.pad = 2; launch1<MK_XA>(p, grid, stream); }
        else if (type == 7) launch1<MK_ML3>(p, grid, stream);
        else if (type == 11) launch1<MK_FIN>(p, grid, stream);
        else launch1<MK_GEMM>(p, grid, stream);
    }
#endif
}
```
